# Optimizing an MI355X kernel written in HIP

```python
import math
import jax, jax.numpy as jnp
from jax import lax
import numpy as np

D_MODEL = 1024
BATCH = 8
SEQ = 4096
DEPTH = 4

PLE_DIM = 256
CHUNK = 128
A_WIDTH = D_MODEL
A_GROUPS = 8
A_GROUP_DIM = A_WIDTH // A_GROUPS
B_HEAD_DIM = 64
B_HEADS = D_MODEL // (2 * B_HEAD_DIM)
B_WIDTH = B_HEADS * 2 * B_HEAD_DIM
Q_BLOCK = 128
EPS = 1e-6
NEG = -1e30
IN_WIDTHS = (A_WIDTH, A_WIDTH, A_WIDTH, B_WIDTH, B_WIDTH, B_WIDTH, B_WIDTH, D_MODEL, D_MODEL)
IN_TOTAL = sum(IN_WIDTHS)
SPLIT_POINTS = tuple(int(c) for c in np.cumsum(IN_WIDTHS)[:-1])

kernel_name = "hybrid_gmlp_diffattn_gated_block"


def rmsnorm(x, g):
    xf = x.astype(jnp.float32)
    y = xf * lax.rsqrt(jnp.mean(xf * xf, axis=-1, keepdims=True) + EPS)
    return (y * g.astype(jnp.float32)).astype(x.dtype)


def layernorm(x, g, b):
    xf = x.astype(jnp.float32)
    mu = jnp.mean(xf, axis=-1, keepdims=True)
    xc = xf - mu
    y = xc * lax.rsqrt(jnp.mean(xc * xc, axis=-1, keepdims=True) + EPS)
    return (y * g.astype(jnp.float32) + b.astype(jnp.float32)).astype(x.dtype)


def lambda_init(layer_idx):
    return 0.8 - 0.6 * math.exp(-0.3 * layer_idx)


def gmlp_branch(u, v, z, ln_g, ln_b, ws, bs):
    B, S, _ = v.shape
    n_chunks = S // CHUNK
    u = jax.nn.gelu(u, approximate=False)
    v = layernorm(jax.nn.gelu(v, approximate=False), ln_g, ln_b)
    vc = v.reshape(B, n_chunks, CHUNK, A_GROUPS, A_GROUP_DIM)
    w = jnp.tril(ws)
    y = jnp.einsum('gts,bcsgd->bctgd', w, vc) + bs.T[None, None, :, :, None]
    y = y.reshape(B, S, A_WIDTH)
    return u * y * jax.nn.silu(z)


def diff_attn_branch(q, k, v, z, lam_q, lam_k, subln_g, lam_init):
    B, S, _ = q.shape
    q = q.reshape(B, S, B_HEADS, 2, B_HEAD_DIM)
    k = k.reshape(B, S, B_HEADS, 2, B_HEAD_DIM)
    v = v.reshape(B, S, B_HEADS, 2 * B_HEAD_DIM)
    lq = lam_q.astype(jnp.float32)
    lk = lam_k.astype(jnp.float32)
    lam = jnp.exp(jnp.sum(lq[0] * lk[0])) - jnp.exp(jnp.sum(lq[1] * lk[1])) + lam_init
    scale = B_HEAD_DIM ** -0.5
    n_q = S // Q_BLOCK
    q_blocks = q.reshape(B, n_q, Q_BLOCK, B_HEADS, 2, B_HEAD_DIM).transpose(1, 0, 2, 3, 4, 5)
    k_pos = jnp.arange(S)

    def one_block(args):
        q_blk, qi = args
        s = jnp.einsum('bqhmd,bkhmd->bhmqk', q_blk, k).astype(jnp.float32) * scale
        q_pos = qi * Q_BLOCK + jnp.arange(Q_BLOCK)
        s = jnp.where((q_pos[:, None] >= k_pos[None, :])[None, None, None], s, NEG)
        pm = jax.nn.softmax(s, axis=-1)
        a = pm[:, :, 0] - lam * pm[:, :, 1]
        return jnp.einsum('bhqk,bkhe->bqhe', a.astype(v.dtype), v)

    o = lax.map(one_block, (q_blocks, jnp.arange(n_q)))
    o = o.transpose(1, 0, 2, 3, 4).reshape(B, S, B_HEADS, 2 * B_HEAD_DIM)
    o = rmsnorm(o, subln_g) * (1.0 - lam_init)
    o = o.reshape(B, S, B_WIDTH)
    return o * jax.nn.silu(z)


def setup_inputs(seed: int = 0) -> dict:
    key = jax.random.key(seed)
    ks = jax.random.split(key, 20)

    def nrm(k, shape, scale):
        return jax.random.normal(k, shape, jnp.float32) * scale

    return {
        "x": nrm(ks[0], (BATCH, SEQ, D_MODEL), 1.0),
        "p": nrm(ks[1], (DEPTH, BATCH, SEQ, PLE_DIM), 1.0),
        "norm_g": 1.0 + nrm(ks[2], (DEPTH, D_MODEL), 0.05),
        "w_in": nrm(ks[3], (DEPTH, D_MODEL, IN_TOTAL), D_MODEL ** -0.5),
        "a_ln_g": 1.0 + nrm(ks[4], (DEPTH, A_WIDTH), 0.05),
        "a_ln_b": nrm(ks[5], (DEPTH, A_WIDTH), 0.02),
        "a_ws": nrm(ks[6], (DEPTH, A_GROUPS, CHUNK, CHUNK), CHUNK ** -0.5),
        "a_bs": 1.0 + nrm(ks[7], (DEPTH, A_GROUPS, CHUNK), 0.05),
        "lam_q": nrm(ks[8], (DEPTH, 2, B_HEAD_DIM), 0.1),
        "lam_k": nrm(ks[9], (DEPTH, 2, B_HEAD_DIM), 0.1),
        "subln_g": 1.0 + nrm(ks[10], (DEPTH, 2 * B_HEAD_DIM), 0.05),
        "w_a_out": nrm(ks[11], (DEPTH, A_WIDTH, D_MODEL), A_WIDTH ** -0.5),
        "w_b_out": nrm(ks[12], (DEPTH, B_WIDTH, D_MODEL), B_WIDTH ** -0.5),
        "w_o": nrm(ks[13], (DEPTH, D_MODEL, D_MODEL), D_MODEL ** -0.5),
        "ple_norm_g": 1.0 + nrm(ks[14], (DEPTH, D_MODEL), 0.05),
        "w_ple": nrm(ks[15], (DEPTH, PLE_DIM, D_MODEL), PLE_DIM ** -0.5),
        "w_ple_gate": nrm(ks[16], (DEPTH, D_MODEL, D_MODEL), D_MODEL ** -0.5),
        "final_g": 1.0 + nrm(ks[17], (D_MODEL,), 0.05),
    }


def reference(x, p, norm_g, w_in, a_ln_g, a_ln_b, a_ws, a_bs, lam_q, lam_k, subln_g,
              w_a_out, w_b_out, w_o, ple_norm_g, w_ple, w_ple_gate, final_g):
    for i in range(DEPTH):
        h = rmsnorm(x, norm_g[i])
        proj = h @ w_in[i]
        u_a, v_a, z_a, q, k, v_b, z_b, g_a, g_b = jnp.split(proj, SPLIT_POINTS, axis=-1)
        y_a = gmlp_branch(u_a, v_a, z_a, a_ln_g[i], a_ln_b[i], a_ws[i], a_bs[i]) @ w_a_out[i]
        y_b = diff_attn_branch(q, k, v_b, z_b, lam_q[i], lam_k[i], subln_g[i],
                               lambda_init(i)) @ w_b_out[i]
        merged = jax.nn.sigmoid(g_a) * y_a + jax.nn.sigmoid(g_b) * y_b
        x = x + merged @ w_o[i]
        ple_gate = jax.nn.sigmoid(rmsnorm(x, ple_norm_g[i]) @ w_ple_gate[i])
        x = x + (p[i] @ w_ple[i]) * ple_gate
    return rmsnorm(x, final_g)
```

```cpp
#include <hip/hip_runtime.h>
#include <hip/hip_cooperative_groups.h>
#include <cstdio>
#include <cstdint>
namespace cg = cooperative_groups;
namespace pg8 {
#define PG8_LAS __attribute__((address_space(3)))
typedef unsigned short bf16_t;
typedef short bf16x8 __attribute__((ext_vector_type(8)));
typedef float f32x4 __attribute__((ext_vector_type(4)));
typedef unsigned u32x4 __attribute__((ext_vector_type(4)));
constexpr int BM = 256, BK = 64, HALF = 128, HTB = HALF * BK * 2  , STAGE_BYTES = 8 * HTB, NXCD = 8, WGM = 8;

__host__ __device__ __forceinline__ int lds_byte(int r, int c) { const int st = (r >> 4) * 2 + (c >> 5), rr = r & 15, cc = c & 31, ob = rr * 64 + cc * 2; return st * 1024 + (ob ^ (((ob >> 9) & 1) << 5)); }
__host__ __device__ __forceinline__ void stage_rc(int b, int& R, int& C) { const int st = b / 1024, sb = b % 1024, swz = sb ^ (((sb >> 9) & 1) << 5); R = (st >> 1) * 16 + swz / 64; C = (st & 1) * 32 + (swz % 64) / 2; }
__host__ __device__ __forceinline__ int perm32(int rho) { const int n = rho >> 4, i = rho & 15; return 8 * (i >> 2) + 4 * n + (i & 3); }

struct Unit { int pm, pn; };
struct Gemm { const bf16_t* A; const bf16_t* Bt; int M, N, K; };

struct StaticOrder {
    int nM, nN, nwg, G, c;
    __host__ __device__ void init(int M, int N, int G_, int c_) { nM = M / BM; nN = N / BM; nwg = nM * nN; G = G_; c = c_; }
    __host__ __device__ bool next(int i, Unit& u) const {
        const long L = (long)i * G + c; if (L >= nwg) return false;
        int wgid = (int)L; { const int q = nwg / NXCD, r = nwg % NXCD, xcd = wgid % NXCD, off = wgid / NXCD; wgid = (xcd < r ? xcd * (q + 1) : r * (q + 1) + (xcd - r) * q) + off; }
        const int nig = WGM * nN, gid = wgid / nig, fm = gid * WGM, gsz = (nM - fm) < WGM ? (nM - fm) : WGM;
        u.pm = fm + ((wgid % nig) % gsz); u.pn = (wgid % nig) / gsz; return true;
    }
    __device__ __forceinline__ void a_ready(const Unit&) const {}
    __device__ __forceinline__ void done(const Unit&) const {}
};

__device__ __forceinline__ unsigned cvt_pk_bf16(float lo, float hi) { unsigned r; asm volatile("v_cvt_pk_bf16_f32 %0, %1, %2" : "=v"(r) : "v"(lo), "v"(hi)); return r; }
typedef float f32x2 __attribute__((ext_vector_type(2)));
__device__ __forceinline__ f32x2 gelu_pk(f32x2 v) {
    const f32x2 av = __builtin_elementwise_abs(v), d = av * 0.2316418882f + 1.0f;
    f32x2 t; t.x = __builtin_amdgcn_rcpf(d.x); t.y = __builtin_amdgcn_rcpf(d.y);
    f32x2 q = t * 0.5307027145f + (-0.7265760135f); q = q * t + 0.7107068705f; q = q * t + (-0.142248368f); q = q * t + 0.127414796f; q = q * t;
    const f32x2 s = (v * v) * (-0.72134752044f);
    f32x2 e; e.x = __builtin_amdgcn_exp2f(s.x); e.y = __builtin_amdgcn_exp2f(s.y);
    const f32x2 m = v * (q * e), r = v - m;
    f32x2 o; o.x = v.x < 0.f ? m.x : r.x; o.y = v.y < 0.f ? m.y : r.y; return o;
}

typedef float f32x2_t __attribute__((ext_vector_type(2))); typedef __bf16 bf16x2_t __attribute__((ext_vector_type(2)));
__device__ __forceinline__ unsigned cvtpk(float lo, float hi) { f32x2_t v = {lo, hi}; bf16x2_t b = __builtin_convertvector(v, bf16x2_t); return __builtin_bit_cast(unsigned, b); }
__device__ __forceinline__ u32x4 pack8(f32x4 a, f32x4 b) { u32x4 w; w.x = cvtpk(a[0], a[1]); w.y = cvtpk(a[2], a[3]); w.z = cvtpk(b[0], b[1]); w.w = cvtpk(b[2], b[3]); return w; }
__device__ __forceinline__ void unpack8(u32x4 w, f32x4& a, f32x4& b) {
    a[0] = __uint_as_float(w.x << 16); a[1] = __uint_as_float(w.x & 0xffff0000u); a[2] = __uint_as_float(w.y << 16); a[3] = __uint_as_float(w.y & 0xffff0000u);
    b[0] = __uint_as_float(w.z << 16); b[1] = __uint_as_float(w.z & 0xffff0000u); b[2] = __uint_as_float(w.w << 16); b[3] = __uint_as_float(w.w & 0xffff0000u); }
__device__ __forceinline__ float sigm(float x) { return __builtin_amdgcn_rcpf(1.0f + __builtin_amdgcn_exp2f(-1.4426950408889634f * x)); }
__device__ __forceinline__ f32x4 sigm4(f32x4 v) { f32x4 o; o[0] = sigm(v[0]); o[1] = sigm(v[1]); o[2] = sigm(v[2]); o[3] = sigm(v[3]); return o; }
__device__ __forceinline__ f32x4 gelu4(f32x4 v) { f32x2 a = gelu_pk((f32x2){v[0], v[1]}), b = gelu_pk((f32x2){v[2], v[3]}); return (f32x4){a.x, a.y, b.x, b.y}; }
__device__ __forceinline__ float row_rstd(const float* S, int row) {
    const f32x4* p = (const f32x4*)(S + (size_t)row * 16); const f32x4 s = (p[0] + p[1]) + (p[2] + p[3]);
    return rsqrtf(((s[0] + s[1]) + (s[2] + s[3])) * (1.0f / 1024.0f) + 1e-6f); }
constexpr float QSCALE = 0.125f * 1.4426950408889634f;
struct Epi {
    static constexpr bool PERM = true, AFTER_DRAIN = false;
    int mode; bf16_t* Ob; int ldo; float* Of; int ldf; const float* Fin; int ldi; const bf16_t* G; const float* S; float* Sn;
    __device__ __forceinline__ void operator()(const f32x4 (&acc)[2][2][4][2], const Unit& u, int wr, int wc, int fr, int fq) const {
        const int row0 = u.pm * BM + wr * 64 + fr, col0 = u.pn * BM + wc * 32 + 8 * fq;
        if (mode == 1) {
            const int sec = u.pm >> 2; f32x4 rc[2][2];
            { const int lane_ = fq * 16 + fr; const float mine = row_rstd(S, col0 + (fr >> 3) * HALF + (fr & 7));
#pragma unroll
              for (int bj = 0; bj < 2; ++bj)
#pragma unroll
                  for (int n = 0; n < 2; ++n)
#pragma unroll
                      for (int j = 0; j < 4; ++j) rc[bj][n][j] = __shfl(mine, (lane_ & 48) + bj * 8 + n * 4 + j); }
#pragma unroll
            for (int ai = 0; ai < 2; ++ai)
#pragma unroll
                for (int m = 0; m < 4; ++m) { const int row = row0 + ai * HALF + m * 16;
#pragma unroll
                    for (int bj = 0; bj < 2; ++bj) { f32x4 v0 = acc[ai][bj][m][0] * rc[bj][0], v1 = acc[ai][bj][m][1] * rc[bj][1];
                        if (sec == 0) { v0 = gelu4(v0); v1 = gelu4(v1); }
                        *(u32x4*)(Ob + (size_t)row * ldo + col0 + bj * HALF) = pack8(v0, v1); }
                    if (m & 1) asm volatile("" ::: "memory"); }
            return;
        }
        const int sec = u.pn >> 2;
#pragma unroll
        for (int ai = 0; ai < 2; ++ai) {
            float rsr[4];
            if (mode == 0 || mode == 5) {
#pragma unroll
                for (int m = 0; m < 4; ++m) { const f32x4 p = ((const f32x4*)(S + (size_t)(row0 + ai * HALF + m * 16) * 16))[fq]; float s_ = (p[0] + p[1]) + (p[2] + p[3]);
                    s_ += __shfl_xor(s_, 16); s_ += __shfl_xor(s_, 32); rsr[m] = rsqrtf(s_ * (1.0f / 1024.0f) + 1e-6f); }
            }
#pragma unroll
            for (int m = 0; m < 4; ++m) { const int row = row0 + ai * HALF + m * 16;
                float rs = 1.f; if (mode == 0 || mode == 5) rs = rsr[m];
                float ss = 0.f;
#pragma unroll
                for (int bj = 0; bj < 2; ++bj) { const int col = col0 + bj * HALF; f32x4 v0 = acc[ai][bj][m][0], v1 = acc[ai][bj][m][1];
                    if (mode == 0) { v0 = v0 * rs; v1 = v1 * rs;
                        if (sec == 0) { v0 = gelu4(v0); v1 = gelu4(v1); }
                        else if (sec == 1 || sec == 4) { v0 = v0 * sigm4(v0); v1 = v1 * sigm4(v1); }
                        else if (sec == 2) { v0 = v0 * QSCALE; v1 = v1 * QSCALE; }
                        else if (sec >= 5) { v0 = sigm4(v0); v1 = sigm4(v1); }
                        *(u32x4*)(Ob + (size_t)row * ldo + col) = pack8(v0, v1);
                    } else if (mode == 2) { f32x4 g0, g1; unpack8(*(const u32x4*)(G + (size_t)row * 7168 + col), g0, g1);
                        float* t = Of + (size_t)row * ldf + col; *(f32x4*)t = v0 * g0; *(f32x4*)(t + 4) = v1 * g1;
                    } else if (mode == 3) { f32x4 g0, g1; unpack8(*(const u32x4*)(G + (size_t)row * 7168 + col), g0, g1);
                        const float* t = Fin + (size_t)row * ldi + col;
#ifdef EXP_NOTMP
                        v0 = v0 * g0; v1 = v1 * g1;
#else
                        v0 = *(const f32x4*)t + v0 * g0; v1 = *(const f32x4*)(t + 4) + v1 * g1;
#endif
                        *(u32x4*)(Ob + (size_t)row * ldo + col) = pack8(v0, v1);
                    } else if (mode == 4) { const float* t = Fin + (size_t)row * ldi + col; v0 = *(const f32x4*)t + v0; v1 = *(const f32x4*)(t + 4) + v1;
                        float* o = Of + (size_t)row * ldf + col; *(f32x4*)o = v0; *(f32x4*)(o + 4) = v1;
                        *(u32x4*)(Ob + (size_t)row * ldo + col) = pack8(v0, v1);
                        ss += (v0[0] * v0[0] + v0[1] * v0[1]) + (v0[2] * v0[2] + v0[3] * v0[3]) + (v1[0] * v1[0] + v1[1] * v1[1]) + (v1[2] * v1[2] + v1[3] * v1[3]);
                    } else if (mode == 5) { float* t = Of + (size_t)row * ldf + col; *(f32x4*)t = sigm4(v0 * rs); asm volatile("" ::: "memory"); *(f32x4*)(t + 4) = sigm4(v1 * rs); asm volatile("" ::: "memory");
                    } else { const float* t = Fin + (size_t)row * ldi + col; float* o = Of + (size_t)row * ldf + col;
                        v0 = *(const f32x4*)o + v0 * *(const f32x4*)t; v1 = *(const f32x4*)(o + 4) + v1 * *(const f32x4*)(t + 4);
                        *(f32x4*)o = v0; *(f32x4*)(o + 4) = v1;
                        *(u32x4*)(Ob + (size_t)row * ldo + col) = pack8(v0, v1);
                        ss += (v0[0] * v0[0] + v0[1] * v0[1]) + (v0[2] * v0[2] + v0[3] * v0[3]) + (v1[0] * v1[0] + v1[1] * v1[1]) + (v1[2] * v1[2] + v1[3] * v1[3]);
                        asm volatile("" ::: "memory");
                    } }
                if (mode == 4 || mode == 6) { ss += __shfl_xor(ss, 16); ss += __shfl_xor(ss, 32); if (fq == 0) Sn[(size_t)row * 16 + u.pn * 4 + wc] = ss; }
                asm volatile("" ::: "memory");
            }
        }
    }
};
template <class Epi, class Sched, bool ALIGN_EPI = false, bool SP2 = false>
__device__ __forceinline__ void gemm_phase(PG8_LAS unsigned char* lds, const Gemm g, const Sched& S, const Epi& E) {
    int tid_ = threadIdx.x; asm volatile("" : "+v"(tid_)); const int tid = tid_, wid = __builtin_amdgcn_readfirstlane(tid >> 6), lane = tid & 63, wr = wid >> 2, wc = wid & 3, fr = lane & 15, fq = lane >> 4;
    int K_ = g.K; asm volatile("" : "+s"(K_)); const int K = K_, nt = K / BK;
    unsigned voffA[2], voffB[2];
#pragma unroll
    for (int i = 0; i < 2; ++i) { int R, C; stage_rc(tid * 16 + i * 8192, R, C); const int Rb = Epi::PERM ? ((R & ~31) + perm32(R & 31)) : R;
        voffA[i] = (unsigned)(R * K + C) * 2u; voffB[i] = (unsigned)(Rb * K + C) * 2u; }
    const size_t kstep = (size_t)(BK * 2);
    const size_t hstep = (size_t)HALF * K * 2;
    const size_t tstep = 2 * hstep;
    const unsigned ldsw = (unsigned)wid * 1024u;
    const int aoff = lds_byte(wr * 64 + fr, fq * 8), boff = lds_byte(wc * 32 + fr, fq * 8);
#define PG8_SA(b, h) (((b) * 2 + (h)) * HTB)
#define PG8_SB(b, h) ((4 + (b) * 2 + (h)) * HTB)
#define PG8_STAGE(bufoff, gbase, voff) do { _Pragma("unroll") for (int _i = 0; _i < 2; ++_i) \
        __builtin_amdgcn_global_load_lds((const unsigned*)((const char*)(gbase) + (voff)[_i]), (PG8_LAS unsigned*)(lds + (bufoff) + ldsw + _i * 8192), 16, 0, 0); } while (0)
#define PG8_LDA(dst, b, h) do { _Pragma("unroll") for (int m = 0; m < 4; ++m) _Pragma("unroll") for (int k = 0; k < 2; ++k) dst[m][k] = *(const PG8_LAS bf16x8*)(lds + PG8_SA(b, h) + aoff + m * 2048 + k * 1024); } while (0)
#define PG8_LDB(dst, b, h) do { _Pragma("unroll") for (int n = 0; n < 2; ++n) _Pragma("unroll") for (int k = 0; k < 2; ++k) dst[n][k] = *(const PG8_LAS bf16x8*)(lds + PG8_SB(b, h) + boff + n * 2048 + k * 1024); } while (0)
#define PG8_MMA(ai, bj, At, Bt) do { __builtin_amdgcn_s_setprio(1); _Pragma("unroll") for (int m = 0; m < 4; ++m) _Pragma("unroll") for (int n = 0; n < 2; ++n) _Pragma("unroll") for (int k = 0; k < 2; ++k) \
        acc[ai][bj][m][n] = __builtin_amdgcn_mfma_f32_16x16x32_bf16(Bt[n][k], At[m][k], acc[ai][bj][m][n], 0, 0, 0); __builtin_amdgcn_s_setprio(0); } while (0)
#define PG8_WAIT_V(n) asm volatile("s_waitcnt vmcnt(" #n ")" ::: "memory")
#define PG8_WAIT_L(n) asm volatile("s_waitcnt lgkmcnt(" #n ")" ::: "memory")
#define PG8_BAR __builtin_amdgcn_s_barrier()
#define PG8_SCHED __builtin_amdgcn_sched_barrier(0)
    Unit cur, nxt; int ui = 0;
    if (!S.next(0, cur)) return;
    f32x4 acc[2][2][4][2];
#pragma unroll
    for (int a = 0; a < 2; ++a)
#pragma unroll
        for (int b = 0; b < 2; ++b)
#pragma unroll
            for (int m = 0; m < 4; ++m)
#pragma unroll
                for (int n = 0; n < 2; ++n) acc[a][b][m][n] = (f32x4){0.f, 0.f, 0.f, 0.f};
    bf16x8 At[4][2], B0[2][2], B1[2][2];
    const char* cA = (const char*)g.A + (size_t)cur.pm * tstep; const char* cB = (const char*)g.Bt + (size_t)cur.pn * tstep;
    S.a_ready(cur);
    if constexpr (SP2) {
        PG8_STAGE(PG8_SB(0, 0), cB, voffB); PG8_STAGE(PG8_SB(0, 1), cB + hstep, voffB); PG8_STAGE(PG8_SA(0, 0), cA, voffA); PG8_STAGE(PG8_SA(0, 1), cA + hstep, voffA);
        if (wr == 1) PG8_BAR;
        PG8_WAIT_V(2); PG8_BAR;
        PG8_STAGE(PG8_SB(1, 0), cB + kstep, voffB); PG8_STAGE(PG8_SA(1, 0), cA + kstep, voffA); PG8_STAGE(PG8_SB(1, 1), cB + hstep + kstep, voffB);
        PG8_WAIT_V(6); PG8_BAR;
    } else {
        PG8_STAGE(PG8_SB(0, 0), cB, voffB); PG8_STAGE(PG8_SA(0, 0), cA, voffA); PG8_STAGE(PG8_SB(0, 1), cB + hstep, voffB); PG8_STAGE(PG8_SA(0, 1), cA + hstep, voffA);
        if (wr == 1) PG8_BAR;
        PG8_WAIT_V(4); PG8_BAR;
        PG8_STAGE(PG8_SB(1, 0), cB + kstep, voffB); PG8_STAGE(PG8_SA(1, 0), cA + kstep, voffA); PG8_STAGE(PG8_SB(1, 1), cB + hstep + kstep, voffB);
        PG8_WAIT_V(6); PG8_BAR;
    }
    for (;;) {
        const bool has_next = S.next(ui + 1, nxt);
        const char* nA = has_next ? (const char*)g.A + (size_t)nxt.pm * tstep : cA; const char* nB = has_next ? (const char*)g.Bt + (size_t)nxt.pn * tstep : cB;
        for (int t = 0; t < nt; t += 2) {
            const bool last = (t == nt - 2);
            const char* a1 = cA + (size_t)(t + 1) * kstep;
            const char* a2 = last ? nA : cA + (size_t)(t + 2) * kstep; const char* b2 = last ? nB : cB + (size_t)(t + 2) * kstep;
            const char* a3 = a2 + kstep; const char* b3 = b2 + kstep;
            if (last && has_next) S.a_ready(nxt);
            if constexpr (SP2) {
            PG8_LDB(B0, 0, 0); PG8_LDB(B1, 0, 1); PG8_SCHED; PG8_LDA(At, 0, 0); PG8_STAGE(PG8_SA(1, 1), a1 + hstep, voffA);
            PG8_WAIT_V(8); PG8_WAIT_L(0); PG8_BAR; PG8_MMA(0, 0, At, B0); PG8_MMA(0, 1, At, B1); PG8_BAR; PG8_SCHED;
            PG8_LDA(At, 0, 1); PG8_STAGE(PG8_SB(0, 0), b2, voffB); PG8_STAGE(PG8_SB(0, 1), b2 + hstep, voffB); PG8_STAGE(PG8_SA(0, 0), a2, voffA);
            PG8_WAIT_V(8); PG8_WAIT_L(0); PG8_BAR; PG8_MMA(1, 0, At, B0); PG8_MMA(1, 1, At, B1); PG8_BAR; PG8_SCHED;
            PG8_LDB(B0, 1, 0); PG8_LDB(B1, 1, 1); PG8_SCHED; PG8_LDA(At, 1, 0); PG8_STAGE(PG8_SA(0, 1), a2 + hstep, voffA);
            PG8_WAIT_V(8); PG8_WAIT_L(0); PG8_BAR; PG8_MMA(0, 0, At, B0); PG8_MMA(0, 1, At, B1); PG8_BAR; PG8_SCHED;
            PG8_LDA(At, 1, 1); PG8_STAGE(PG8_SB(1, 0), b3, voffB); PG8_STAGE(PG8_SB(1, 1), b3 + hstep, voffB); PG8_STAGE(PG8_SA(1, 0), a3, voffA);
            PG8_WAIT_V(8); PG8_WAIT_L(0); PG8_BAR; PG8_MMA(1, 0, At, B0); PG8_MMA(1, 1, At, B1); PG8_BAR; PG8_SCHED;
            } else {
            PG8_LDB(B0, 0, 0); PG8_SCHED; PG8_LDA(At, 0, 0); PG8_STAGE(PG8_SA(1, 1), a1 + hstep, voffA);
            PG8_WAIT_L(8); PG8_BAR; PG8_WAIT_L(0); PG8_MMA(0, 0, At, B0); PG8_BAR; PG8_SCHED;
            PG8_LDB(B1, 0, 1); PG8_STAGE(PG8_SB(0, 0), b2, voffB);
            PG8_BAR; PG8_WAIT_L(0); PG8_MMA(0, 1, At, B1); PG8_BAR;
            PG8_LDA(At, 0, 1); PG8_STAGE(PG8_SA(0, 0), a2, voffA);
            PG8_BAR; PG8_WAIT_L(0); PG8_MMA(1, 0, At, B0); PG8_BAR; PG8_SCHED;
            PG8_STAGE(PG8_SB(0, 1), b2 + hstep, voffB);
            PG8_WAIT_V(6); PG8_BAR; PG8_MMA(1, 1, At, B1); PG8_BAR;
            PG8_LDB(B0, 1, 0); PG8_SCHED; PG8_LDA(At, 1, 0); PG8_STAGE(PG8_SA(0, 1), a2 + hstep, voffA);
            PG8_WAIT_L(8); PG8_BAR; PG8_WAIT_L(0); PG8_MMA(0, 0, At, B0); PG8_BAR; PG8_SCHED;
            PG8_LDB(B1, 1, 1); PG8_STAGE(PG8_SB(1, 0), b3, voffB);
            PG8_BAR; PG8_WAIT_L(0); PG8_MMA(0, 1, At, B1); PG8_BAR;
            PG8_LDA(At, 1, 1); PG8_STAGE(PG8_SA(1, 0), a3, voffA);
            PG8_BAR; PG8_WAIT_L(0); PG8_MMA(1, 0, At, B0); PG8_BAR; PG8_SCHED;
            PG8_STAGE(PG8_SB(1, 1), b3 + hstep, voffB);
            PG8_WAIT_V(6); PG8_BAR; PG8_MMA(1, 1, At, B1); PG8_BAR;
            }
        }
        if constexpr (ALIGN_EPI) { if (wr == 0) PG8_BAR; }
        if constexpr (!Epi::AFTER_DRAIN) { E(acc, cur, wr, wc, fr, fq); S.done(cur); }
        if (!has_next) break;
#pragma unroll
        for (int a = 0; a < 2; ++a)
#pragma unroll
            for (int b = 0; b < 2; ++b)
#pragma unroll
                for (int m = 0; m < 4; ++m)
#pragma unroll
                    for (int n = 0; n < 2; ++n) acc[a][b][m][n] = (f32x4){0.f, 0.f, 0.f, 0.f};
        cur = nxt; cA = nA; cB = nB; ++ui;
        if constexpr (ALIGN_EPI) { if (wr == 1) PG8_BAR; }
    }
    PG8_WAIT_V(0);
    if constexpr (!ALIGN_EPI) { if (wr == 0) PG8_BAR; }
    PG8_BAR;
    if constexpr (Epi::AFTER_DRAIN) { E.fused(acc, cur, wr, wc, fr, fq, lds, wid, lane); S.done(cur); }
#undef PG8_SA
#undef PG8_SB
#undef PG8_STAGE
#undef PG8_LDA
#undef PG8_LDB
#undef PG8_MMA
#undef PG8_WAIT_V
#undef PG8_WAIT_L
#undef PG8_BAR
#undef PG8_SCHED
}
}

#define LAS __attribute__((address_space(3)))
typedef unsigned short bf16_t;
typedef short bf16x8 __attribute__((ext_vector_type(8)));
typedef float f32x4 __attribute__((ext_vector_type(4)));
typedef float f32x16 __attribute__((ext_vector_type(16)));
typedef unsigned u32x4 __attribute__((ext_vector_type(4)));
typedef unsigned u32x2 __attribute__((ext_vector_type(2)));
using pg8::cvtpk; using pg8::pack8; using pg8::unpack8;
constexpr int NTHREADS = 512, NWAVES = 8;
constexpr int MH = 16384, DM = 1024, SEQ = 4096, NB_H = 4, NLAYER = 4, NP1 = 7168, NV2 = 2048, PLE = 256, NHEAD = 8;
constexpr size_t MiB = 1u << 20;
constexpr size_t LW_IN = 0, LW_A = (size_t)9216 * 1024, LW_B = LW_A + 1048576, LW_O = LW_B + 1048576, LW_G = LW_O + 1048576, LW_P = LW_G + 1048576, LW_TOTAL = LW_P + 262144;
constexpr size_t WS_W = 1 * MiB, WS_PROJ = 108 * MiB, WS_VT2 = 332 * MiB, WS_X0 = 396 * MiB, WS_X1 = 428 * MiB, WS_BRA = 460 * MiB, WS_BRB = 492 * MiB, WS_PB = 524 * MiB, WS_S0 = 532 * MiB, WS_S1 = 533 * MiB, WS_END = 534 * MiB;
static_assert(WS_W + LW_TOTAL * 2 * NLAYER <= WS_PROJ, "weights fit");
constexpr int TMP_LD = NP1 / 2;
constexpr int LDS_BYTES = 147456;
constexpr float EPS = 1e-6f;

struct Args {
    const float *x, *p, *norm_g, *w_in, *a_ln_g, *a_ln_b, *a_ws, *a_bs, *lam_q, *lam_k, *subln_g, *w_a_out, *w_b_out, *w_o, *ple_norm_g, *w_ple, *w_ple_gate, *final_g;
    float* out; unsigned char* ws;
};

__device__ __forceinline__ float wave_sum(float v) {
#pragma unroll
    for (int o = 1; o < 64; o <<= 1) v += __shfl_xor(v, o);
    return v;
}
#define LDS_WAIT() asm volatile("s_waitcnt lgkmcnt(0)" ::: "memory")

__device__ __forceinline__ void tr_item(const float* W, int K, int N, const float* scale, bf16_t* WT, int dst_row0, LAS float* scr, int k0, int n0, int lane) {
#pragma unroll 8
    for (int i = 0; i < 32; ++i) { const int kk = 2 * i + (lane >> 5); float v = W[(size_t)(k0 + kk) * N + n0 + (lane & 31)]; if (scale) v *= scale[k0 + kk]; scr[kk * 33 + (lane & 31)] = v; }
    LDS_WAIT(); asm volatile("" ::: "memory");
    const int c = lane & 7;
#pragma unroll
    for (int j = 0; j < 4; ++j) { const int n = (lane >> 3) + 8 * j; const LAS float* s = scr + (8 * c) * 33 + n;
        u32x4 o; o.x = cvtpk(s[0 * 33], s[1 * 33]); o.y = cvtpk(s[2 * 33], s[3 * 33]); o.z = cvtpk(s[4 * 33], s[5 * 33]); o.w = cvtpk(s[6 * 33], s[7 * 33]);
        *(u32x4*)(WT + (size_t)(dst_row0 + n) * K + k0 + 8 * c) = o; }
    LDS_WAIT(); asm volatile("" ::: "memory");
}
typedef const __attribute__((address_space(4))) Args* cargs_t;
__device__ __forceinline__ void weights_prologue(cargs_t ap, LAS unsigned char* lds, int gw, int ngw, int wave, int lane) {
    LAS float* scr = (LAS float*)(lds + wave * 16384);
    bf16_t* WT = (bf16_t*)(ap->ws + WS_W);
    constexpr int I_IN = 16 * 288, I_SQ = 16 * 32, I_P = 4 * 32, I_L = I_IN + 4 * I_SQ + I_P;
    for (int it = gw; it < I_L * NLAYER; it += ngw) {
        const int l = it / I_L; int r = it % I_L; bf16_t* wl = WT + (size_t)l * LW_TOTAL;
        if (r < I_IN) { const int kb = r / 288, nb = r % 288, n0 = nb * 32; const int osec = n0 >> 10;
            const int nsec = (int)((0x654832170ull >> (4 * osec)) & 0xFull);
            tr_item(ap->w_in + (size_t)l * 1024 * 9216, 1024, 9216, ap->norm_g + l * 1024, wl + LW_IN, nsec * 1024 + (n0 & 1023) - 0, scr, kb * 64, n0, lane);
            continue; }
        r -= I_IN;
        if (r < 4 * I_SQ) { const int which = r / I_SQ; const int rr = r % I_SQ; const int kb = rr / 32, nb = rr % 32;
            const float* src = which == 0 ? ap->w_a_out : which == 1 ? ap->w_b_out : which == 2 ? ap->w_o : ap->w_ple_gate;
            const size_t off = which == 0 ? LW_A : which == 1 ? LW_B : which == 2 ? LW_O : LW_G;
            tr_item(src + (size_t)l * 1048576, 1024, 1024, which == 3 ? ap->ple_norm_g + l * 1024 : nullptr, wl + off, nb * 32, scr, kb * 64, nb * 32, lane);
            continue; }
        r -= 4 * I_SQ;
        { const int kb = r / 32, nb = r % 32; tr_item(ap->w_ple + (size_t)l * 262144, 256, 1024, nullptr, wl + LW_P, nb * 32, scr, kb * 64, nb * 32, lane); }
    }
}

__device__ __forceinline__ void init_rows(const float* x, bf16_t* XB, float* S, int gw, int ngw, int lane) {
    asm volatile("" : "+v"(lane)); asm volatile("" : "+s"(gw));
    for (int m = gw; m < MH; m += ngw) {
        const f32x4* xr = (const f32x4*)(x + (size_t)m * DM) + lane; float s = 0.f; f32x4 v[4];
#pragma unroll
        for (int j = 0; j < 4; ++j) { v[j] = xr[64 * j]; s += (v[j][0] * v[j][0] + v[j][1] * v[j][1]) + (v[j][2] * v[j][2] + v[j][3] * v[j][3]); }
        s = wave_sum(s);
        u32x2* o = (u32x2*)(XB + (size_t)m * DM) + lane;
#pragma unroll
        for (int j = 0; j < 4; ++j) { u32x2 w; w.x = cvtpk(v[j][0], v[j][1]); w.y = cvtpk(v[j][2], v[j][3]); o[64 * j] = w; }
        if (lane < 16) S[(size_t)m * 16 + lane] = lane == 0 ? s : 0.f;
    }
}
__device__ __forceinline__ void final_rows(float* out, const float* g, int gw, int ngw, int lane) {
    asm volatile("" : "+v"(lane)); asm volatile("" : "+s"(gw));
    for (int m = gw; m < MH; m += ngw) {
        f32x4* xr = (f32x4*)(out + (size_t)m * DM) + lane; float s = 0.f; f32x4 v[4];
#pragma unroll
        for (int j = 0; j < 4; ++j) { v[j] = xr[64 * j]; s += (v[j][0] * v[j][0] + v[j][1] * v[j][1]) + (v[j][2] * v[j][2] + v[j][3] * v[j][3]); }
        const float rs = rsqrtf(wave_sum(s) * (1.0f / DM) + EPS);
#pragma unroll
        for (int j = 0; j < 4; ++j) { const f32x4 gg = ((const f32x4*)g)[64 * j + lane]; xr[64 * j] = v[j] * rs * gg; }
    }
}
__device__ __forceinline__ void convert_p(const float* p, bf16_t* PB, int gtid, int nthr) {
    asm volatile("" : "+v"(gtid));
    for (int i = gtid; i < MH * PLE / 8; i += nthr) { const f32x4 a = ((const f32x4*)p)[2 * i], b = ((const f32x4*)p)[2 * i + 1]; ((u32x4*)PB)[i] = pack8(a, b); }
}

__device__ __forceinline__ void gmlp_unit(LAS unsigned char* lds, const bf16_t* PROJ, const bf16_t* VT2, bf16_t* BRA, const float* lng, const float* lnb, const float* ws, const float* bs, int c, int gh) {
    int tid_ = threadIdx.x; asm volatile("" : "+v"(tid_)); const int tid = tid_, lane = tid & 63, l32 = lane & 31, hi = lane >> 5; const int w = __builtin_amdgcn_readfirstlane(tid >> 6);
    const int tok0 = c * 128;
    LAS float* red = (LAS float*)lds;
    LAS float* stat = (LAS float*)(lds + 32768);
    LAS unsigned char* T = lds + 34816;
    { const int sc = tid & 15, rg = tid >> 4; float s[8], q[8];
#pragma unroll
      for (int j = 0; j < 8; ++j) { s[j] = 0.f; q[j] = 0.f; }
      for (int i = 0; i < 32; ++i) { const u32x4 wv = *(const u32x4*)(VT2 + (size_t)(rg + 32 * i) * MH + tok0 + sc * 8); f32x4 a, b; unpack8(wv, a, b);
#pragma unroll
          for (int j = 0; j < 4; ++j) { s[j] += a[j]; q[j] += a[j] * a[j]; s[4 + j] += b[j]; q[4 + j] += b[j] * b[j]; } }
#pragma unroll
      for (int j = 0; j < 8; ++j) { red[rg * 256 + sc * 8 + j] = s[j]; red[rg * 256 + 128 + sc * 8 + j] = q[j]; } }
    __syncthreads();
    if (tid < 128) { float s = 0.f, q = 0.f;
        for (int i = 0; i < 32; ++i) { s += red[i * 256 + tid]; q += red[i * 256 + 128 + tid]; }
        const float mean = s * (1.0f / 1024.0f); const float var = q * (1.0f / 1024.0f) - mean * mean;
        stat[2 * tid] = mean; stat[2 * tid + 1] = rsqrtf(var + EPS); }
    __syncthreads();
    const int tb = w & 3, dh = w >> 2;
    for (int gi = 0; gi < 4; ++gi) { const int g = gh * 4 + gi;
#pragma unroll
        for (int i = 0; i < 4; ++i) { const int p = tid + 512 * i, d = p >> 4, sc = p & 15;
            const u32x4 wv = *(const u32x4*)(VT2 + (size_t)(g * 128 + d) * MH + tok0 + sc * 8); f32x4 a, b; unpack8(wv, a, b);
            const float gg = lng[g * 128 + d], bb = lnb[g * 128 + d];
#pragma unroll
            for (int j = 0; j < 4; ++j) { a[j] = (a[j] - stat[2 * (sc * 8 + j)]) * stat[2 * (sc * 8 + j) + 1] * gg + bb; b[j] = (b[j] - stat[2 * (sc * 8 + 4 + j)]) * stat[2 * (sc * 8 + 4 + j) + 1] * gg + bb; }
            *(LAS u32x4*)(T + d * 272 + sc * 16) = pack8(a, b); }
        __syncthreads();
        f32x16 acc0 = {}, acc1 = {};
        const float* wrow = ws + (size_t)g * 16384 + (size_t)(32 * tb + l32) * 128 + 8 * hi;
        const int trow = 32 * tb + l32;
        for (int ks = 0; ks < 2 * tb + 2; ++ks) {
            f32x4 wa = *(const f32x4*)(wrow + 16 * ks), wb = *(const f32x4*)(wrow + 16 * ks + 4); const int s0 = 16 * ks + 8 * hi;
#pragma unroll
            for (int j = 0; j < 4; ++j) { if (s0 + j > trow) wa[j] = 0.f; if (s0 + 4 + j > trow) wb[j] = 0.f; }
            const bf16x8 A = __builtin_bit_cast(bf16x8, pack8(wa, wb));
            const bf16x8 B0 = *(const LAS bf16x8*)(T + (64 * dh + l32) * 272 + (16 * ks + 8 * hi) * 2);
            const bf16x8 B1 = *(const LAS bf16x8*)(T + (64 * dh + 32 + l32) * 272 + (16 * ks + 8 * hi) * 2);
            acc0 = __builtin_amdgcn_mfma_f32_32x32x16_bf16(A, B0, acc0, 0, 0, 0);
            acc1 = __builtin_amdgcn_mfma_f32_32x32x16_bf16(A, B1, acc1, 0, 0, 0);
        }
#pragma unroll
        for (int r = 0; r < 16; ++r) { const int t = 32 * tb + (r & 3) + 8 * (r >> 2) + 4 * hi; const float bv = bs[g * 128 + t];
            const size_t tok = (size_t)(tok0 + t);
#pragma unroll
            for (int db = 0; db < 2; ++db) { const int col = g * 128 + 64 * dh + 32 * db + l32;
                const float uu = __uint_as_float((unsigned)PROJ[tok * NP1 + col] << 16), zz = __uint_as_float((unsigned)PROJ[tok * NP1 + 1024 + col] << 16);
                const float y = (db == 0 ? acc0[r] : acc1[r]) + bv;
                BRA[tok * DM + col] = (bf16_t)(cvtpk(uu * y * zz, 0.f) & 0xffffu); } }
        __syncthreads();
    }
}

constexpr int AT_KS = 17408, AT_VS = 18432, AT_VOFF = 2 * AT_KS;
__device__ __forceinline__ void attn_unit(LAS unsigned char* lds, const bf16_t* PROJ, const bf16_t* VT2, bf16_t* BRB, const float* subg, float lam, float lam_init, int b, int h, int qb) {
    int tid_ = threadIdx.x; asm volatile("" : "+v"(tid_)); const int tid = tid_, lane = tid & 63, l32 = lane & 31, hi = lane >> 5; const int w = __builtin_amdgcn_readfirstlane(tid >> 6); const int map = w >> 2, wq = w & 3;
    const int rowbase = b * SEQ, q0 = qb * 128, myq = q0 + wq * 32 + l32, NT = 2 * qb + 2;
    bf16x8 qf[4];
    { const bf16_t* qp = PROJ + (size_t)(rowbase + myq) * NP1 + 2048 + h * 128 + map * 64 + hi * 8;
#pragma unroll
      for (int ks = 0; ks < 4; ++ks) qf[ks] = *(const bf16x8*)(qp + ks * 16); }
    const bf16_t* ksrc[2]; const bf16_t* vsrc[2]; int kdst[2], vdst[2];
#pragma unroll
    for (int i = 0; i < 2; ++i) { const int p = tid + 512 * i;
        ksrc[i] = PROJ + (size_t)(rowbase + (p >> 4)) * NP1 + 3072 + h * 128 + (p & 15) * 8; kdst[i] = (p >> 4) * 272 + (p & 15) * 16;
        vsrc[i] = VT2 + (size_t)(1024 + h * 128 + (p >> 3)) * MH + rowbase + (p & 7) * 8; vdst[i] = AT_VOFF + (p >> 3) * 144 + (p & 7) * 16; }
    u32x4 kr[2], vr[2];
#pragma unroll
    for (int i = 0; i < 2; ++i) { kr[i] = *(const u32x4*)(ksrc[i]); vr[i] = *(const u32x4*)(vsrc[i]); }
#pragma unroll
    for (int i = 0; i < 2; ++i) { *(LAS u32x4*)(lds + kdst[i]) = kr[i]; *(LAS u32x4*)(lds + vdst[i]) = vr[i]; }
    __syncthreads();
    f32x16 O[4]; O[0] = f32x16{}; O[1] = f32x16{}; O[2] = f32x16{}; O[3] = f32x16{};
    float m_run = -1e30f, l_run = 0.f;
    for (int t = 0; t < NT; ++t) {
        const int buf = t & 1, kv0 = 64 * t;
        if (t + 1 < NT) {
#pragma unroll
            for (int i = 0; i < 2; ++i) { kr[i] = *(const u32x4*)(ksrc[i] + (size_t)(kv0 + 64) * NP1); vr[i] = *(const u32x4*)(vsrc[i] + kv0 + 64); } }
        if (kv0 <= q0 + wq * 32 + 31) {
            LAS unsigned char* Kb = lds + buf * AT_KS + l32 * 272 + map * 128 + hi * 16;
            f32x16 S0 = {}, S1 = {};
#pragma unroll
            for (int ks = 0; ks < 4; ++ks) { const bf16x8 a0 = *(const LAS bf16x8*)(Kb + ks * 32), a1 = *(const LAS bf16x8*)(Kb + 32 * 272 + ks * 32);
                S0 = __builtin_amdgcn_mfma_f32_32x32x16_bf16(a0, qf[ks], S0, 0, 0, 0); S1 = __builtin_amdgcn_mfma_f32_32x32x16_bf16(a1, qf[ks], S1, 0, 0, 0); }
            if (t >= NT - 2) {
#pragma unroll
                for (int r = 0; r < 16; ++r) { const int kv = kv0 + (r & 3) + 8 * (r >> 2) + 4 * hi; if (kv > myq) S0[r] = -1e30f; if (kv + 32 > myq) S1[r] = -1e30f; } }
            float mx = fmaxf(S0[0], S1[0]);
#pragma unroll
            for (int r = 1; r < 16; ++r) mx = fmaxf(mx, fmaxf(S0[r], S1[r]));
            mx = fmaxf(mx, __shfl_xor(mx, 32));
            if (__any(mx > m_run)) { const float mnew = fmaxf(m_run, mx), alpha = __builtin_amdgcn_exp2f(m_run - mnew); m_run = mnew; l_run *= alpha;
#pragma unroll
                for (int db = 0; db < 4; ++db)
#pragma unroll
                    for (int r = 0; r < 16; ++r) O[db][r] *= alpha; }
            float ps = 0.f;
#pragma unroll
            for (int r = 0; r < 16; ++r) { S0[r] = __builtin_amdgcn_exp2f(S0[r] - m_run); S1[r] = __builtin_amdgcn_exp2f(S1[r] - m_run); ps += S0[r] + S1[r]; }
            l_run += ps;
            bf16x8 pf[4];
#pragma unroll
            for (int j = 0; j < 4; ++j) { u32x4 pw;
#pragma unroll
                for (int i = 0; i < 4; ++i) pw[i] = (j < 2) ? cvtpk(S0[8 * (j & 1) + 2 * i], S0[8 * (j & 1) + 2 * i + 1]) : cvtpk(S1[8 * (j & 1) + 2 * i], S1[8 * (j & 1) + 2 * i + 1]);
                pf[j] = __builtin_bit_cast(bf16x8, pw); }
            LAS unsigned char* Vb = lds + AT_VOFF + buf * AT_VS + l32 * 144 + hi * 8;
#pragma unroll
            for (int db = 0; db < 4; ++db)
#pragma unroll
                for (int j = 0; j < 4; ++j) { const u32x2 lo = *(const LAS u32x2*)(Vb + db * 32 * 144 + j * 32), hh = *(const LAS u32x2*)(Vb + db * 32 * 144 + j * 32 + 16);
                    const u32x4 av = {lo.x, lo.y, hh.x, hh.y};
                    O[db] = __builtin_amdgcn_mfma_f32_32x32x16_bf16(__builtin_bit_cast(bf16x8, av), pf[j], O[db], 0, 0, 0); }
        }
        if (t + 1 < NT) {
#pragma unroll
            for (int i = 0; i < 2; ++i) { *(LAS u32x4*)(lds + (buf ^ 1) * AT_KS + kdst[i]) = kr[i]; *(LAS u32x4*)(lds + (buf ^ 1) * AT_VS + vdst[i]) = vr[i]; } }
        __syncthreads();
    }
    const float inv = 1.0f / (l_run + __shfl_xor(l_run, 32));
    LAS float* X = (LAS float*)lds + wq * 4096 + lane;
    if (map == 1) { const float sc = -lam * inv;
#pragma unroll
        for (int db = 0; db < 4; ++db)
#pragma unroll
            for (int r = 0; r < 16; ++r) X[(db * 16 + r) * 64] = O[db][r] * sc; }
    __syncthreads();
    if (map == 0) { float ss = 0.f;
#pragma unroll
        for (int db = 0; db < 4; ++db)
#pragma unroll
            for (int r = 0; r < 16; ++r) { const float o = O[db][r] * inv + X[(db * 16 + r) * 64]; O[db][r] = o; ss += o * o; }
        ss += __shfl_xor(ss, 32);
        const float rs = rsqrtf(ss * (1.0f / 128.0f) + EPS) * (1.0f - lam_init);
        const size_t row = (size_t)(rowbase + myq);
#pragma unroll
        for (int db = 0; db < 4; ++db)
#pragma unroll
            for (int rg = 0; rg < 4; ++rg) { const int d = 32 * db + 8 * rg + 4 * hi; const f32x4 gg = *(const f32x4*)(subg + d);
                const u32x2 zw = *(const u32x2*)(PROJ + row * NP1 + 4096 + h * 128 + d);
                const float z0 = __uint_as_float(zw.x << 16), z1 = __uint_as_float(zw.x & 0xffff0000u), z2 = __uint_as_float(zw.y << 16), z3 = __uint_as_float(zw.y & 0xffff0000u);
                u32x2 ow; ow.x = cvtpk(O[db][4 * rg] * rs * gg[0] * z0, O[db][4 * rg + 1] * rs * gg[1] * z1); ow.y = cvtpk(O[db][4 * rg + 2] * rs * gg[2] * z2, O[db][4 * rg + 3] * rs * gg[3] * z3);
                *(u32x2*)(BRB + row * DM + h * 128 + d) = ow; } }
    __syncthreads();
}

#define RLX_AGENT __ATOMIC_RELAXED, __HIP_MEMORY_SCOPE_AGENT
#define XB_TMO      128
#define XB_XCNT(j)  (256  + 64 * (j))
#define XB_XSUB(j)  (1280 + 64 * (j))
#define XB_XGEN(j)  (2304 + 64 * (j))
#define XB_TOP      3328
#define XB_TOPGEN   3392
#define XCD_BAR_WORDS 3456
#define XB_SPIN_CAP (1u << 18)

__device__ __forceinline__ unsigned xb_ld(unsigned* p)              { return __hip_atomic_load(p, __ATOMIC_RELAXED, __HIP_MEMORY_SCOPE_AGENT); }
__device__ __forceinline__ unsigned xb_add(unsigned* p, unsigned v) { return __hip_atomic_fetch_add(p, v, __ATOMIC_RELAXED, __HIP_MEMORY_SCOPE_AGENT); }
__device__ __forceinline__ unsigned xb_xcc_id() { return (unsigned)__builtin_amdgcn_s_getreg((3 << 11) | 20) & 0xFu; }
#define XB_SPIN(cond, bar) do { unsigned _sp = 0; while (cond) { __builtin_amdgcn_s_sleep(1); \
    if ((++_sp & 255u) == 0u) { if (xb_ld(&(bar)[XB_TMO])) break; if (_sp > XB_SPIN_CAP) { atomicAdd(&(bar)[XB_TMO], 1u); break; } } } } while (0)

struct XcdBarrier {
    unsigned* bar; unsigned x;
    volatile LAS unsigned* st;
};

__device__ __forceinline__ XcdBarrier xcd_barrier_post(unsigned* bar, volatile LAS unsigned* st) {
    XcdBarrier b; b.bar = bar; b.x = xb_xcc_id(); b.st = st;
    if (threadIdx.x == 0) (void)xb_add(&bar[XB_XCNT(b.x)], 1u);
    return b;
}
__device__ __forceinline__ void xcd_barrier_complete(unsigned* bar, unsigned x, unsigned& nloc, unsigned& nx) {
    const unsigned G = gridDim.x * gridDim.y * gridDim.z;
    unsigned sum, cnt, mine, sp = 0u;
    for (;;) {
        sum = 0u; cnt = 0u; mine = 0u;
#pragma unroll
        for (unsigned j = 0; j < 16; ++j) { const unsigned c = xb_ld(&bar[XB_XCNT(j)]); sum += c; cnt += (c > 0u) ? 1u : 0u; mine = (j == x) ? c : mine; }
        if (sum == G) break;
        __builtin_amdgcn_s_sleep(1);
        if ((++sp & 255u) == 0u) { if (xb_ld(&bar[XB_TMO])) break; if (sp > XB_SPIN_CAP) { atomicAdd(&bar[XB_TMO], 1u); break; } }
    }
    nloc = mine > 0u ? mine : 1u; nx = cnt > 0u ? cnt : 1u;
}

__device__ __forceinline__ void xcd_barrier(const XcdBarrier& b) {
    asm volatile("s_waitcnt vmcnt(0)" ::: "memory");
    __syncthreads();
    if (threadIdx.x == 0) {
        unsigned* bar = b.bar;
        __builtin_amdgcn_s_waitcnt(0);
        unsigned nloc = b.st[0], nx = b.st[1];
        if (nloc == 0u) { xcd_barrier_complete(bar, b.x, nloc, nx); b.st[0] = nloc; b.st[1] = nx; }
        const unsigned old = xb_add(&bar[XB_XSUB(b.x)], 1u);
        const unsigned gen = old / nloc;
        if (old + 1u == (gen + 1u) * nloc) {
            __builtin_amdgcn_fence(__ATOMIC_RELEASE, "agent");
            asm volatile("s_waitcnt vmcnt(0)" ::: "memory");
            const unsigned og = xb_add(&bar[XB_TOP], 1u);
            const unsigned tg = og / nx;
            if (og + 1u == (tg + 1u) * nx) xb_add(&bar[XB_TOPGEN], 1u);
            else XB_SPIN(xb_ld(&bar[XB_TOPGEN]) == tg, bar);
            __builtin_amdgcn_fence(__ATOMIC_ACQUIRE, "agent");
            xb_add(&bar[XB_XGEN(b.x)], 1u);
            asm volatile("s_waitcnt vmcnt(0)" ::: "memory");
        } else {
            XB_SPIN(xb_ld(&bar[XB_XGEN(b.x)]) == gen, bar);
            __builtin_amdgcn_fence(__ATOMIC_ACQUIRE, "agent");
            asm volatile("s_waitcnt vmcnt(0)" ::: "memory");
        }
    }
    __syncthreads();
}


__global__ void __launch_bounds__(NTHREADS, 2) mega_fwd(Args a_unused) {
    extern __shared__ __attribute__((aligned(16))) unsigned char lds_raw[];
    LAS unsigned char* lds = (LAS unsigned char*)lds_raw;
    cg::grid_group grid = cg::this_grid();
    const int tid = threadIdx.x, lane = tid & 63, wave = __builtin_amdgcn_readfirstlane(tid >> 6);
    const int G = gridDim.x, bx = blockIdx.x;
    const int vcu = (G % 8 == 0) ? (bx % 8) * (G / 8) + bx / 8 : bx;
    const int gw = vcu * NWAVES + wave, ngw = G * NWAVES;
#define ARGS() cargs_t ap = (cargs_t)__builtin_amdgcn_kernarg_segment_ptr(); asm volatile("" : "+s"(ap)); unsigned char* const ws = ap->ws
#define GSYNC() xcd_barrier(xbar)
#define WSP(T, off) ((T*)(ws + (off)))
#define XBP(ci) ((bf16_t*)(ws + ((ci) ? WS_X1 : WS_X0)))
#define SXP(ci) ((float*)(ws + ((ci) ? WS_S1 : WS_S0)))
#define TMPP ((float*)(ws + WS_PROJ + 4096))
    if (tid < 64) ((LAS unsigned*)(lds + 131072))[tid] = 0u;
    __syncthreads();
    grid.sync();
    XcdBarrier xbar;
    { ARGS(); xbar = xcd_barrier_post((unsigned*)ws, (volatile LAS unsigned*)(lds + 131072)); }
    { ARGS(); weights_prologue(ap, lds, gw, ngw, wave, lane); }

#define DUMP_BF16(buf_off, nelem) do { ARGS(); const bf16_t* B_ = WSP(bf16_t, buf_off); float* o_ = ap->out; \
    for (size_t i_ = (size_t)bx * NTHREADS + tid; i_ < (size_t)2 * MH * DM; i_ += (size_t)G * NTHREADS) o_[i_] = __uint_as_float((unsigned)B_[i_ % (size_t)(nelem)] << 16); } while (0)
    for (int hf = 0; hf < 2; ++hf) {
        { ARGS(); init_rows(ap->x + (size_t)hf * MH * DM, XBP(0), SXP(0), gw, ngw, lane); }
        GSYNC();
        int c = 0;
        for (int l = 0; l < NLAYER; ++l) {
            { ARGS(); convert_p(ap->p + ((size_t)l * 2 * MH + (size_t)hf * MH) * PLE, WSP(bf16_t, WS_PB), bx * NTHREADS + tid, G * NTHREADS); }
#if !defined(ONLY) || ONLY == 0
            { ARGS(); const bf16_t* wl = WSP(bf16_t, WS_W) + (size_t)l * LW_TOTAL;
              pg8::Gemm g{XBP(c), wl + LW_IN, MH, NP1, DM}; pg8::StaticOrder S; S.init(MH, NP1, G, bx);
              pg8::Epi E{0, WSP(bf16_t, WS_PROJ), NP1, nullptr, 0, nullptr, 0, nullptr, SXP(c), nullptr};
              pg8::gemm_phase<pg8::Epi, pg8::StaticOrder, true, true>(lds, g, S, E); }
#endif
#if !defined(ONLY) || ONLY == 1
            { ARGS(); const bf16_t* wl = WSP(bf16_t, WS_W) + (size_t)l * LW_TOTAL;
              pg8::Gemm g{wl + LW_IN + (size_t)NP1 * DM, XBP(c), NV2, MH, DM}; pg8::StaticOrder S; S.init(NV2, MH, G, bx);
              pg8::Epi E{1, WSP(bf16_t, WS_VT2), MH, nullptr, 0, nullptr, 0, nullptr, SXP(c), nullptr};
              pg8::gemm_phase<pg8::Epi, pg8::StaticOrder, true, true>(lds, g, S, E); }
#endif
            GSYNC();
#if defined(STOP_AFTER) && STOP_AFTER == 1
            DUMP_BF16(WS_PROJ, (size_t)MH * NP1); return;
#endif
#if defined(STOP_AFTER) && STOP_AFTER == 11
            DUMP_BF16(WS_VT2, (size_t)MH * NV2); return;
#endif
#ifndef NO_GMLP
            { ARGS();
              for (int u = vcu; u < 256; u += G)
                gmlp_unit(lds, WSP(bf16_t, WS_PROJ), WSP(bf16_t, WS_VT2), WSP(bf16_t, WS_BRA), ap->a_ln_g + l * 1024, ap->a_ln_b + l * 1024, ap->a_ws + (size_t)l * 131072, ap->a_bs + l * 1024, u >> 1, u & 1); }
#endif
#ifdef NO_ATTN
            { ARGS(); const bf16_t* PR = WSP(bf16_t, WS_PROJ); bf16_t* B = WSP(bf16_t, WS_BRB);
              for (int i = bx * NTHREADS + tid; i < MH * DM / 8; i += G * NTHREADS) { const int row = i >> 7, c8 = i & 127; *(u32x4*)(B + (size_t)row * DM + c8 * 8) = *(const u32x4*)(PR + (size_t)row * NP1 + 4096 + c8 * 8); } }
#endif
#ifdef NO_GMLP
            { ARGS(); const bf16_t* PR = WSP(bf16_t, WS_PROJ); bf16_t* B = WSP(bf16_t, WS_BRA);
              for (int i = bx * NTHREADS + tid; i < MH * DM / 8; i += G * NTHREADS) { const int row = i >> 7, c8 = i & 127; *(u32x4*)(B + (size_t)row * DM + c8 * 8) = *(const u32x4*)(PR + (size_t)row * NP1 + c8 * 8); } }
#endif
#ifndef NO_ATTN
            { ARGS();
              const float lam_init = 0.8f - 0.6f * expf(-0.3f * (float)l);
              const float d0 = wave_sum(ap->lam_q[l * 128 + lane] * ap->lam_k[l * 128 + lane]), d1 = wave_sum(ap->lam_q[l * 128 + 64 + lane] * ap->lam_k[l * 128 + 64 + lane]);
              const float lam = expf(d0) - expf(d1) + lam_init;
              for (int pu = vcu; pu < 512; pu += G) { const int bh = pu >> 4, s = pu & 15;
                  attn_unit(lds, WSP(bf16_t, WS_PROJ), WSP(bf16_t, WS_VT2), WSP(bf16_t, WS_BRB), ap->subln_g + l * 128, lam, lam_init, bh >> 3, bh & 7, 31 - s);
                  attn_unit(lds, WSP(bf16_t, WS_PROJ), WSP(bf16_t, WS_VT2), WSP(bf16_t, WS_BRB), ap->subln_g + l * 128, lam, lam_init, bh >> 3, bh & 7, s); } }
#endif
            GSYNC();
#if !defined(ONLY) || ONLY == 2
            { ARGS(); const bf16_t* wl = WSP(bf16_t, WS_W) + (size_t)l * LW_TOTAL;
              pg8::Gemm g{WSP(bf16_t, WS_BRA), wl + LW_A, MH, DM, DM}; pg8::StaticOrder S; S.init(MH, DM, G, bx);
              pg8::Epi E{2, nullptr, 0, TMPP, TMP_LD, nullptr, 0, WSP(bf16_t, WS_PROJ) + 5120, nullptr, nullptr};
              pg8::gemm_phase<pg8::Epi, pg8::StaticOrder, true, true>(lds, g, S, E); }
#endif
#if !defined(ONLY) || ONLY == 3
            { ARGS(); const bf16_t* wl = WSP(bf16_t, WS_W) + (size_t)l * LW_TOTAL;
              pg8::Gemm g{WSP(bf16_t, WS_BRB), wl + LW_B, MH, DM, DM}; pg8::StaticOrder S; S.init(MH, DM, G, bx);
              pg8::Epi E{3, XBP(1 - c), DM, nullptr, 0, TMPP, TMP_LD, WSP(bf16_t, WS_PROJ) + 6144, nullptr, nullptr};
              pg8::gemm_phase<pg8::Epi, pg8::StaticOrder, true, true>(lds, g, S, E); }
#endif
            GSYNC();
#if defined(STOP_AFTER) && STOP_AFTER == 3
            if (c == 0) DUMP_BF16(WS_X1, (size_t)MH * DM); else DUMP_BF16(WS_X0, (size_t)MH * DM); return;
#endif
#if !defined(ONLY) || ONLY == 4
            { ARGS(); const bf16_t* wl = WSP(bf16_t, WS_W) + (size_t)l * LW_TOTAL; float* out = ap->out + (size_t)hf * MH * DM;
              pg8::Gemm g{XBP(1 - c), wl + LW_O, MH, DM, DM}; pg8::StaticOrder S; S.init(MH, DM, G, bx);
              pg8::Epi E{4, XBP(c), DM, out, DM, l == 0 ? ap->x + (size_t)hf * MH * DM : out, DM, nullptr, nullptr, SXP(c)};
              pg8::gemm_phase<pg8::Epi, pg8::StaticOrder, true, true>(lds, g, S, E); }
#endif
            GSYNC();
#if defined(STOP_AFTER) && STOP_AFTER == 4
            if (c == 0) DUMP_BF16(WS_X0, (size_t)MH * DM); else DUMP_BF16(WS_X1, (size_t)MH * DM); return;
#endif
#if !defined(ONLY) || ONLY == 5
            { ARGS(); const bf16_t* wl = WSP(bf16_t, WS_W) + (size_t)l * LW_TOTAL;
              pg8::Gemm g{XBP(c), wl + LW_G, MH, DM, DM}; pg8::StaticOrder S; S.init(MH, DM, G, bx);
              pg8::Epi E{5, nullptr, 0, TMPP, TMP_LD, nullptr, 0, nullptr, SXP(c), nullptr};
              pg8::gemm_phase<pg8::Epi, pg8::StaticOrder, true, true>(lds, g, S, E); }
#endif
#if !defined(ONLY) || ONLY == 6
            { ARGS(); const bf16_t* wl = WSP(bf16_t, WS_W) + (size_t)l * LW_TOTAL; float* out = ap->out + (size_t)hf * MH * DM;
              pg8::Gemm g{WSP(bf16_t, WS_PB), wl + LW_P, MH, DM, PLE}; pg8::StaticOrder S; S.init(MH, DM, G, bx);
              pg8::Epi E{6, XBP(1 - c), DM, out, DM, TMPP, TMP_LD, nullptr, nullptr, SXP(1 - c)};
              pg8::gemm_phase<pg8::Epi, pg8::StaticOrder, true, true>(lds, g, S, E); }
#endif
            GSYNC();
#if defined(STOP_AFTER) && STOP_AFTER == 5
            if (c == 0) DUMP_BF16(WS_X1, (size_t)MH * DM); else DUMP_BF16(WS_X0, (size_t)MH * DM); return;
#endif
            c ^= 1;
        }
        { ARGS(); final_rows(ap->out + (size_t)hf * MH * DM, ap->final_g, gw, ngw, lane); }
    }
}

extern "C" void kernel_launch(void* const* d_in, const int* in_sizes, int n_in, void* d_out, int out_size, void* d_ws, size_t ws_size, hipStream_t stream) {
    static int grid = 0;
    if (grid == 0) {
        if (n_in != 18 || ws_size < WS_END) { fprintf(stderr, "kernel_launch: unexpected n_in %d / ws_size %zu (need %zu)\n", n_in, ws_size, (size_t)WS_END); grid = -1; return; }
        int dev = 0, cus = 0, per_cu = 0;
        hipGetDevice(&dev); hipDeviceGetAttribute(&cus, hipDeviceAttributeMultiprocessorCount, dev);
        if (hipFuncSetAttribute((const void*)mega_fwd, hipFuncAttributeMaxDynamicSharedMemorySize, LDS_BYTES) != hipSuccess) { fprintf(stderr, "kernel_launch: hipFuncSetAttribute failed\n"); grid = -1; return; }
        if (hipOccupancyMaxActiveBlocksPerMultiprocessor(&per_cu, (const void*)mega_fwd, NTHREADS, LDS_BYTES) != hipSuccess || per_cu < 1) { fprintf(stderr, "kernel_launch: occupancy query gives %d\n", per_cu); per_cu = 1; }
        (void)hipGetLastError();
        grid = cus;
    }
    if (grid < 0) return;
    if (hipMemsetAsync(d_ws, 0, 16384, stream) != hipSuccess) { fprintf(stderr, "kernel_launch: memset failed\n"); return; }
    Args a{};
    const float** f = (const float**)&a;
    for (int i = 0; i < 18; ++i) f[i] = (const float*)d_in[i];
    a.out = (float*)d_out; a.ws = (unsigned char*)d_ws;
    void* args[] = {&a};
    hipError_t e = hipLaunchCooperativeKernel((const void*)mega_fwd, dim3(grid), dim3(NTHREADS), args, LDS_BYTES, stream);
    if (e != hipSuccess) fprintf(stderr, "cooperative launch failed: %s (grid %d)\n", hipGetErrorString(e), grid);
}
```

```cpp
#include <hip/hip_runtime.h>
#include <hip/hip_cooperative_groups.h>
#include <cstdio>
#include <cstdint>
namespace cg = cooperative_groups;
namespace pg8 {
#define PG8_LAS __attribute__((address_space(3)))
typedef unsigned short bf16_t;
typedef short bf16x8 __attribute__((ext_vector_type(8)));
typedef float f32x4 __attribute__((ext_vector_type(4)));
typedef unsigned u32x4 __attribute__((ext_vector_type(4)));
constexpr int BM = 256, BK = 64, HALF = 128, HTB = HALF * BK * 2  , STAGE_BYTES = 8 * HTB, NXCD = 8, WGM = 8;

__host__ __device__ __forceinline__ int lds_byte(int r, int c) { const int st = (r >> 4) * 2 + (c >> 5), rr = r & 15, cc = c & 31, ob = rr * 64 + cc * 2; return st * 1024 + (ob ^ (((ob >> 9) & 1) << 5)); }
__host__ __device__ __forceinline__ void stage_rc(int b, int& R, int& C) { const int st = b / 1024, sb = b % 1024, swz = sb ^ (((sb >> 9) & 1) << 5); R = (st >> 1) * 16 + swz / 64; C = (st & 1) * 32 + (swz % 64) / 2; }
__host__ __device__ __forceinline__ int perm32(int rho) { const int n = rho >> 4, i = rho & 15; return 8 * (i >> 2) + 4 * n + (i & 3); }

struct Unit { int pm, pn; };
struct Gemm { const bf16_t* A; const bf16_t* Bt; int M, N, K; };

struct StaticOrder {
    int nM, nN, nwg, G, c;
    __host__ __device__ void init(int M, int N, int G_, int c_) { nM = M / BM; nN = N / BM; nwg = nM * nN; G = G_; c = c_; }
    __host__ __device__ bool next(int i, Unit& u) const {
        const long L = (long)i * G + c; if (L >= nwg) return false;
        int wgid = (int)L; { const int q = nwg / NXCD, r = nwg % NXCD, xcd = wgid % NXCD, off = wgid / NXCD; wgid = (xcd < r ? xcd * (q + 1) : r * (q + 1) + (xcd - r) * q) + off; }
        const int nig = WGM * nN, gid = wgid / nig, fm = gid * WGM, gsz = (nM - fm) < WGM ? (nM - fm) : WGM;
        u.pm = fm + ((wgid % nig) % gsz); u.pn = (wgid % nig) / gsz; return true;
    }
    __device__ __forceinline__ void a_ready(const Unit&) const {}
    __device__ __forceinline__ void done(const Unit&) const {}
};

__device__ __forceinline__ unsigned cvt_pk_bf16(float lo, float hi) { unsigned r; asm volatile("v_cvt_pk_bf16_f32 %0, %1, %2" : "=v"(r) : "v"(lo), "v"(hi)); return r; }
typedef float f32x2 __attribute__((ext_vector_type(2)));
__device__ __forceinline__ f32x2 gelu_pk(f32x2 v) {
    const f32x2 av = __builtin_elementwise_abs(v), d = av * 0.2316418882f + 1.0f;
    f32x2 t; t.x = __builtin_amdgcn_rcpf(d.x); t.y = __builtin_amdgcn_rcpf(d.y);
    f32x2 q = t * 0.5307027145f + (-0.7265760135f); q = q * t + 0.7107068705f; q = q * t + (-0.142248368f); q = q * t + 0.127414796f; q = q * t;
    const f32x2 s = (v * v) * (-0.72134752044f);
    f32x2 e; e.x = __builtin_amdgcn_exp2f(s.x); e.y = __builtin_amdgcn_exp2f(s.y);
    const f32x2 m = v * (q * e), r = v - m;
    f32x2 o; o.x = v.x < 0.f ? m.x : r.x; o.y = v.y < 0.f ? m.y : r.y; return o;
}

typedef float f32x2_t __attribute__((ext_vector_type(2))); typedef __bf16 bf16x2_t __attribute__((ext_vector_type(2)));
__device__ __forceinline__ unsigned cvtpk(float lo, float hi) { f32x2_t v = {lo, hi}; bf16x2_t b = __builtin_convertvector(v, bf16x2_t); return __builtin_bit_cast(unsigned, b); }
__device__ __forceinline__ u32x4 pack8(f32x4 a, f32x4 b) { u32x4 w; w.x = cvtpk(a[0], a[1]); w.y = cvtpk(a[2], a[3]); w.z = cvtpk(b[0], b[1]); w.w = cvtpk(b[2], b[3]); return w; }
__device__ __forceinline__ void unpack8(u32x4 w, f32x4& a, f32x4& b) {
    a[0] = __uint_as_float(w.x << 16); a[1] = __uint_as_float(w.x & 0xffff0000u); a[2] = __uint_as_float(w.y << 16); a[3] = __uint_as_float(w.y & 0xffff0000u);
    b[0] = __uint_as_float(w.z << 16); b[1] = __uint_as_float(w.z & 0xffff0000u); b[2] = __uint_as_float(w.w << 16); b[3] = __uint_as_float(w.w & 0xffff0000u); }
__device__ __forceinline__ float sigm(float x) { return __builtin_amdgcn_rcpf(1.0f + __builtin_amdgcn_exp2f(-1.4426950408889634f * x)); }
__device__ __forceinline__ f32x4 sigm4(f32x4 v) { f32x4 o; o[0] = sigm(v[0]); o[1] = sigm(v[1]); o[2] = sigm(v[2]); o[3] = sigm(v[3]); return o; }
__device__ __forceinline__ f32x4 gelu4(f32x4 v) { f32x2 a = gelu_pk((f32x2){v[0], v[1]}), b = gelu_pk((f32x2){v[2], v[3]}); return (f32x4){a.x, a.y, b.x, b.y}; }
__device__ __forceinline__ float row_rstd(const float* S, int row) {
    const f32x4* p = (const f32x4*)(S + (size_t)row * 16); const f32x4 s = (p[0] + p[1]) + (p[2] + p[3]);
    return rsqrtf(((s[0] + s[1]) + (s[2] + s[3])) * (1.0f / 1024.0f) + 1e-6f); }
constexpr float QSCALE = 0.125f * 1.4426950408889634f;
struct Epi {
    static constexpr bool PERM = true, AFTER_DRAIN = false;
    int mode; bf16_t* Ob; int ldo; float* Of; int ldf; const float* Fin; int ldi; const bf16_t* G; const float* S; float* Sn; const bf16_t* T16; const bf16_t* Xin;
    __device__ __forceinline__ void operator()(const f32x4 (&acc)[2][2][4][2], const Unit& u, int wr, int wc, int fr, int fq) const {
        const int row0 = u.pm * BM + wr * 64 + fr, col0 = u.pn * BM + wc * 32 + 8 * fq;
        if (mode == 1) {
            const int sec = u.pm >> 2; f32x4 rc[2][2];
            { const int lane_ = fq * 16 + fr; const float mine = row_rstd(S, col0 + (fr >> 3) * HALF + (fr & 7));
#pragma unroll
              for (int bj = 0; bj < 2; ++bj)
#pragma unroll
                  for (int n = 0; n < 2; ++n)
#pragma unroll
                      for (int j = 0; j < 4; ++j) rc[bj][n][j] = __shfl(mine, (lane_ & 48) + bj * 8 + n * 4 + j); }
#pragma unroll
            for (int ai = 0; ai < 2; ++ai)
#pragma unroll
                for (int m = 0; m < 4; ++m) { const int row = row0 + ai * HALF + m * 16;
#pragma unroll
                    for (int bj = 0; bj < 2; ++bj) { f32x4 v0 = acc[ai][bj][m][0] * rc[bj][0], v1 = acc[ai][bj][m][1] * rc[bj][1];
                        if (sec == 0) { v0 = gelu4(v0); v1 = gelu4(v1); }
                        *(u32x4*)(Ob + (size_t)row * ldo + col0 + bj * HALF) = pack8(v0, v1); }
                    if (m & 1) asm volatile("" ::: "memory"); }
            return;
        }
        const int sec = u.pn >> 2;
        if (mode == 0 || mode == 5) {
#pragma unroll
            for (int ai = 0; ai < 2; ++ai) {
                float rsr[4];
#pragma unroll
                for (int m = 0; m < 4; ++m) { const f32x4 p = ((const f32x4*)(S + (size_t)(row0 + ai * HALF + m * 16) * 16))[fq]; float s_ = (p[0] + p[1]) + (p[2] + p[3]);
                    s_ += __shfl_xor(s_, 16); s_ += __shfl_xor(s_, 32); rsr[m] = rsqrtf(s_ * (1.0f / 1024.0f) + 1e-6f); }
#pragma unroll
                for (int m = 0; m < 4; ++m) { const int row = row0 + ai * HALF + m * 16; const float rs = rsr[m];
#pragma unroll
                    for (int bj = 0; bj < 2; ++bj) { const int col = col0 + bj * HALF; f32x4 v0 = acc[ai][bj][m][0] * rs, v1 = acc[ai][bj][m][1] * rs;
                        if (mode == 0) {
                            if (sec == 0) { v0 = gelu4(v0); v1 = gelu4(v1); }
                            else if (sec == 1 || sec == 4) { v0 = v0 * sigm4(v0); v1 = v1 * sigm4(v1); }
                            else if (sec == 2) { v0 = v0 * QSCALE; v1 = v1 * QSCALE; }
                            else if (sec >= 5) { v0 = sigm4(v0); v1 = sigm4(v1); }
                            *(u32x4*)(Ob + (size_t)row * ldo + col) = pack8(v0, v1);
                        } else { *(u32x4*)(Ob + (size_t)row * ldo + col) = pack8(sigm4(v0), sigm4(v1)); } }
                    asm volatile("" ::: "memory"); }
            }
            return;
        }
#pragma unroll
        for (int ai = 0; ai < 2; ++ai)
#pragma unroll
            for (int mh = 0; mh < 2; ++mh) {
                u32x4 gq[2][2], tq[2][2], xq[2][2]; f32x4 ta[2][2][2];
#pragma unroll
                for (int mm = 0; mm < 2; ++mm)
#pragma unroll
                    for (int bj = 0; bj < 2; ++bj) { const int row = row0 + ai * HALF + (2 * mh + mm) * 16, col = col0 + bj * HALF;
                        if (mode == 2 || mode == 3) gq[mm][bj] = *(const u32x4*)(G + (size_t)row * 7168 + col);
                        if (mode == 4 && Fin) { const float* t = Fin + (size_t)row * ldi + col; ta[mm][bj][0] = *(const f32x4*)t; ta[mm][bj][1] = *(const f32x4*)(t + 4); }
                        if ((mode == 4 && !Fin) || mode == 6) xq[mm][bj] = *(const u32x4*)(Xin + (size_t)row * 1024 + col);
                        if (mode == 3 || mode == 6) tq[mm][bj] = *(const u32x4*)(T16 + (size_t)row * 7168 + col);
                    }
#pragma unroll
                for (int mm = 0; mm < 2; ++mm) { const int m = 2 * mh + mm; const int row = row0 + ai * HALF + m * 16; float ss = 0.f;
#pragma unroll
                    for (int bj = 0; bj < 2; ++bj) { const int col = col0 + bj * HALF; f32x4 v0 = acc[ai][bj][m][0], v1 = acc[ai][bj][m][1];
                        if (mode == 2) { f32x4 g0, g1; unpack8(gq[mm][bj], g0, g1); *(u32x4*)(Ob + (size_t)row * ldo + col) = pack8(v0 * g0, v1 * g1); }
                        else if (mode == 3) { f32x4 g0, g1, t0, t1; unpack8(gq[mm][bj], g0, g1); unpack8(tq[mm][bj], t0, t1); v0 = t0 + v0 * g0; v1 = t1 + v1 * g1; *(u32x4*)(Ob + (size_t)row * ldo + col) = pack8(v0, v1); }
                        else { if (mode == 4) { if (Fin) { v0 = ta[mm][bj][0] + v0; v1 = ta[mm][bj][1] + v1; } else { f32x4 x0, x1; unpack8(xq[mm][bj], x0, x1); v0 = x0 + v0; v1 = x1 + v1; } }
                            else { f32x4 t0, t1, x0, x1; unpack8(tq[mm][bj], t0, t1); unpack8(xq[mm][bj], x0, x1); v0 = x0 + v0 * t0; v1 = x1 + v1 * t1; }
                            if (Of) { float* o = Of + (size_t)row * ldf + col; *(f32x4*)o = v0; *(f32x4*)(o + 4) = v1; }
                            *(u32x4*)(Ob + (size_t)row * ldo + col) = pack8(v0, v1);
                            ss += (v0[0] * v0[0] + v0[1] * v0[1]) + (v0[2] * v0[2] + v0[3] * v0[3]) + (v1[0] * v1[0] + v1[1] * v1[1]) + (v1[2] * v1[2] + v1[3] * v1[3]); } }
                    if (mode == 4 || mode == 6) { ss += __shfl_xor(ss, 16); ss += __shfl_xor(ss, 32); if (fq == 0) Sn[(size_t)row * 16 + u.pn * 4 + wc] = ss; } }
                asm volatile("" ::: "memory");
            }
    }
};
template <class Epi, class Sched, bool ALIGN_EPI = false, bool SP2 = false>
__device__ __forceinline__ void gemm_phase(PG8_LAS unsigned char* lds, const Gemm g, const Sched& S, const Epi& E) {
    int tid_ = threadIdx.x; asm volatile("" : "+v"(tid_)); const int tid = tid_, wid = __builtin_amdgcn_readfirstlane(tid >> 6), lane = tid & 63, wr = wid >> 2, wc = wid & 3, fr = lane & 15, fq = lane >> 4;
    int K_ = g.K; asm volatile("" : "+s"(K_)); const int K = K_, nt = K / BK;
    unsigned voffA[2], voffB[2];
#pragma unroll
    for (int i = 0; i < 2; ++i) { int R, C; stage_rc(tid * 16 + i * 8192, R, C); const int Rb = Epi::PERM ? ((R & ~31) + perm32(R & 31)) : R;
        voffA[i] = (unsigned)(R * K + C) * 2u; voffB[i] = (unsigned)(Rb * K + C) * 2u; }
    const size_t kstep = (size_t)(BK * 2);
    const size_t hstep = (size_t)HALF * K * 2;
    const size_t tstep = 2 * hstep;
    const unsigned ldsw = (unsigned)wid * 1024u;
    const int aoff = lds_byte(wr * 64 + fr, fq * 8), boff = lds_byte(wc * 32 + fr, fq * 8);
#define PG8_SA(b, h) (((b) * 2 + (h)) * HTB)
#define PG8_SB(b, h) ((4 + (b) * 2 + (h)) * HTB)
#define PG8_STAGE(bufoff, gbase, voff) do { _Pragma("unroll") for (int _i = 0; _i < 2; ++_i) \
        __builtin_amdgcn_global_load_lds((const unsigned*)((const char*)(gbase) + (voff)[_i]), (PG8_LAS unsigned*)(lds + (bufoff) + ldsw + _i * 8192), 16, 0, 0); } while (0)
#define PG8_LDA(dst, b, h) do { _Pragma("unroll") for (int m = 0; m < 4; ++m) _Pragma("unroll") for (int k = 0; k < 2; ++k) dst[m][k] = *(const PG8_LAS bf16x8*)(lds + PG8_SA(b, h) + aoff + m * 2048 + k * 1024); } while (0)
#define PG8_LDB(dst, b, h) do { _Pragma("unroll") for (int n = 0; n < 2; ++n) _Pragma("unroll") for (int k = 0; k < 2; ++k) dst[n][k] = *(const PG8_LAS bf16x8*)(lds + PG8_SB(b, h) + boff + n * 2048 + k * 1024); } while (0)
#define PG8_MMA(ai, bj, At, Bt) do { __builtin_amdgcn_s_setprio(1); _Pragma("unroll") for (int m = 0; m < 4; ++m) _Pragma("unroll") for (int n = 0; n < 2; ++n) _Pragma("unroll") for (int k = 0; k < 2; ++k) \
        acc[ai][bj][m][n] = __builtin_amdgcn_mfma_f32_16x16x32_bf16(Bt[n][k], At[m][k], acc[ai][bj][m][n], 0, 0, 0); __builtin_amdgcn_s_setprio(0); } while (0)
#define PG8_WAIT_V(n) asm volatile("s_waitcnt vmcnt(" #n ")" ::: "memory")
#define PG8_WAIT_L(n) asm volatile("s_waitcnt lgkmcnt(" #n ")" ::: "memory")
#define PG8_BAR __builtin_amdgcn_s_barrier()
#define PG8_SCHED __builtin_amdgcn_sched_barrier(0)
    Unit cur, nxt; int ui = 0;
    if (!S.next(0, cur)) return;
    f32x4 acc[2][2][4][2];
#pragma unroll
    for (int a = 0; a < 2; ++a)
#pragma unroll
        for (int b = 0; b < 2; ++b)
#pragma unroll
            for (int m = 0; m < 4; ++m)
#pragma unroll
                for (int n = 0; n < 2; ++n) acc[a][b][m][n] = (f32x4){0.f, 0.f, 0.f, 0.f};
    bf16x8 At[4][2], B0[2][2], B1[2][2];
    const char* cA = (const char*)g.A + (size_t)cur.pm * tstep; const char* cB = (const char*)g.Bt + (size_t)cur.pn * tstep;
    S.a_ready(cur);
    if constexpr (SP2) {
        PG8_STAGE(PG8_SB(0, 0), cB, voffB); PG8_STAGE(PG8_SB(0, 1), cB + hstep, voffB); PG8_STAGE(PG8_SA(0, 0), cA, voffA); PG8_STAGE(PG8_SA(0, 1), cA + hstep, voffA);
        if (wr == 1) PG8_BAR;
        PG8_WAIT_V(2); PG8_BAR;
        PG8_STAGE(PG8_SB(1, 0), cB + kstep, voffB); PG8_STAGE(PG8_SA(1, 0), cA + kstep, voffA); PG8_STAGE(PG8_SB(1, 1), cB + hstep + kstep, voffB);
        PG8_WAIT_V(6); PG8_BAR;
    } else {
        PG8_STAGE(PG8_SB(0, 0), cB, voffB); PG8_STAGE(PG8_SA(0, 0), cA, voffA); PG8_STAGE(PG8_SB(0, 1), cB + hstep, voffB); PG8_STAGE(PG8_SA(0, 1), cA + hstep, voffA);
        if (wr == 1) PG8_BAR;
        PG8_WAIT_V(4); PG8_BAR;
        PG8_STAGE(PG8_SB(1, 0), cB + kstep, voffB); PG8_STAGE(PG8_SA(1, 0), cA + kstep, voffA); PG8_STAGE(PG8_SB(1, 1), cB + hstep + kstep, voffB);
        PG8_WAIT_V(6); PG8_BAR;
    }
    for (;;) {
        const bool has_next = S.next(ui + 1, nxt);
        const char* nA = has_next ? (const char*)g.A + (size_t)nxt.pm * tstep : cA; const char* nB = has_next ? (const char*)g.Bt + (size_t)nxt.pn * tstep : cB;
        for (int t = 0; t < nt; t += 2) {
            const bool last = (t == nt - 2);
            const char* a1 = cA + (size_t)(t + 1) * kstep;
            const char* a2 = last ? nA : cA + (size_t)(t + 2) * kstep; const char* b2 = last ? nB : cB + (size_t)(t + 2) * kstep;
            const char* a3 = a2 + kstep; const char* b3 = b2 + kstep;
            if (last && has_next) S.a_ready(nxt);
            if constexpr (SP2) {
            PG8_LDB(B0, 0, 0); PG8_LDB(B1, 0, 1); PG8_SCHED; PG8_LDA(At, 0, 0); PG8_STAGE(PG8_SA(1, 1), a1 + hstep, voffA);
            PG8_WAIT_V(8); PG8_WAIT_L(0); PG8_BAR; PG8_MMA(0, 0, At, B0); PG8_MMA(0, 1, At, B1); PG8_BAR; PG8_SCHED;
            PG8_LDA(At, 0, 1); PG8_STAGE(PG8_SB(0, 0), b2, voffB); PG8_STAGE(PG8_SB(0, 1), b2 + hstep, voffB); PG8_STAGE(PG8_SA(0, 0), a2, voffA);
            PG8_WAIT_V(8); PG8_WAIT_L(0); PG8_BAR; PG8_MMA(1, 0, At, B0); PG8_MMA(1, 1, At, B1); PG8_BAR; PG8_SCHED;
            PG8_LDB(B0, 1, 0); PG8_LDB(B1, 1, 1); PG8_SCHED; PG8_LDA(At, 1, 0); PG8_STAGE(PG8_SA(0, 1), a2 + hstep, voffA);
            PG8_WAIT_V(8); PG8_WAIT_L(0); PG8_BAR; PG8_MMA(0, 0, At, B0); PG8_MMA(0, 1, At, B1); PG8_BAR; PG8_SCHED;
            PG8_LDA(At, 1, 1); PG8_STAGE(PG8_SB(1, 0), b3, voffB); PG8_STAGE(PG8_SB(1, 1), b3 + hstep, voffB); PG8_STAGE(PG8_SA(1, 0), a3, voffA);
            PG8_WAIT_V(8); PG8_WAIT_L(0); PG8_BAR; PG8_MMA(1, 0, At, B0); PG8_MMA(1, 1, At, B1); PG8_BAR; PG8_SCHED;
            } else {
            PG8_LDB(B0, 0, 0); PG8_SCHED; PG8_LDA(At, 0, 0); PG8_STAGE(PG8_SA(1, 1), a1 + hstep, voffA);
            PG8_WAIT_L(8); PG8_BAR; PG8_WAIT_L(0); PG8_MMA(0, 0, At, B0); PG8_BAR; PG8_SCHED;
            PG8_LDB(B1, 0, 1); PG8_STAGE(PG8_SB(0, 0), b2, voffB);
            PG8_BAR; PG8_WAIT_L(0); PG8_MMA(0, 1, At, B1); PG8_BAR;
            PG8_LDA(At, 0, 1); PG8_STAGE(PG8_SA(0, 0), a2, voffA);
            PG8_BAR; PG8_WAIT_L(0); PG8_MMA(1, 0, At, B0); PG8_BAR; PG8_SCHED;
            PG8_STAGE(PG8_SB(0, 1), b2 + hstep, voffB);
            PG8_WAIT_V(6); PG8_BAR; PG8_MMA(1, 1, At, B1); PG8_BAR;
            PG8_LDB(B0, 1, 0); PG8_SCHED; PG8_LDA(At, 1, 0); PG8_STAGE(PG8_SA(0, 1), a2 + hstep, voffA);
            PG8_WAIT_L(8); PG8_BAR; PG8_WAIT_L(0); PG8_MMA(0, 0, At, B0); PG8_BAR; PG8_SCHED;
            PG8_LDB(B1, 1, 1); PG8_STAGE(PG8_SB(1, 0), b3, voffB);
            PG8_BAR; PG8_WAIT_L(0); PG8_MMA(0, 1, At, B1); PG8_BAR;
            PG8_LDA(At, 1, 1); PG8_STAGE(PG8_SA(1, 0), a3, voffA);
            PG8_BAR; PG8_WAIT_L(0); PG8_MMA(1, 0, At, B0); PG8_BAR; PG8_SCHED;
            PG8_STAGE(PG8_SB(1, 1), b3 + hstep, voffB);
            PG8_WAIT_V(6); PG8_BAR; PG8_MMA(1, 1, At, B1); PG8_BAR;
            }
        }
        if constexpr (ALIGN_EPI) { if (wr == 0) PG8_BAR; }
        if constexpr (!Epi::AFTER_DRAIN) { E(acc, cur, wr, wc, fr, fq); S.done(cur); }
        if (!has_next) break;
#pragma unroll
        for (int a = 0; a < 2; ++a)
#pragma unroll
            for (int b = 0; b < 2; ++b)
#pragma unroll
                for (int m = 0; m < 4; ++m)
#pragma unroll
                    for (int n = 0; n < 2; ++n) acc[a][b][m][n] = (f32x4){0.f, 0.f, 0.f, 0.f};
        cur = nxt; cA = nA; cB = nB; ++ui;
        if constexpr (ALIGN_EPI) { if (wr == 1) PG8_BAR; }
    }
    PG8_WAIT_V(0);
    if constexpr (!ALIGN_EPI) { if (wr == 0) PG8_BAR; }
    PG8_BAR;
    if constexpr (Epi::AFTER_DRAIN) { E.fused(acc, cur, wr, wc, fr, fq, lds, wid, lane); S.done(cur); }
#undef PG8_SA
#undef PG8_SB
#undef PG8_STAGE
#undef PG8_LDA
#undef PG8_LDB
#undef PG8_MMA
#undef PG8_WAIT_V
#undef PG8_WAIT_L
#undef PG8_BAR
#undef PG8_SCHED
}
}

#define LAS __attribute__((address_space(3)))
typedef unsigned short bf16_t;
typedef short bf16x8 __attribute__((ext_vector_type(8)));
typedef float f32x4 __attribute__((ext_vector_type(4)));
typedef float f32x16 __attribute__((ext_vector_type(16)));
typedef unsigned u32x4 __attribute__((ext_vector_type(4)));
typedef unsigned u32x2 __attribute__((ext_vector_type(2)));
using pg8::cvtpk; using pg8::pack8; using pg8::unpack8;
constexpr int NTHREADS = 512, NWAVES = 8;
constexpr int MH = 16384, DM = 1024, SEQ = 4096, NB_H = 4, NLAYER = 4, NP1 = 7168, NV2 = 2048, PLE = 256, NHEAD = 8;
constexpr size_t MiB = 1u << 20;
constexpr size_t LW_IN = 0, LW_A = (size_t)9216 * 1024, LW_B = LW_A + 1048576, LW_O = LW_B + 1048576, LW_G = LW_O + 1048576, LW_P = LW_G + 1048576, LW_TOTAL = LW_P + 262144;
constexpr size_t WS_W = 1 * MiB, WS_PROJ = 108 * MiB, WS_VT2 = 332 * MiB, WS_X0 = 396 * MiB, WS_X1 = 428 * MiB, WS_BRA = 460 * MiB, WS_BRB = 492 * MiB, WS_PB = 524 * MiB, WS_S0 = 532 * MiB, WS_S1 = 533 * MiB, WS_END = 534 * MiB;
static_assert(WS_W + LW_TOTAL * 2 * NLAYER <= WS_PROJ, "weights fit");
constexpr int TMP_LD = NP1 / 2;
constexpr int LDS_BYTES = 147456;
constexpr float EPS = 1e-6f;

struct Args {
    const float *x, *p, *norm_g, *w_in, *a_ln_g, *a_ln_b, *a_ws, *a_bs, *lam_q, *lam_k, *subln_g, *w_a_out, *w_b_out, *w_o, *ple_norm_g, *w_ple, *w_ple_gate, *final_g;
    float* out; unsigned char* ws;
};

__device__ __forceinline__ float wave_sum(float v) {
#pragma unroll
    for (int o = 1; o < 64; o <<= 1) v += __shfl_xor(v, o);
    return v;
}
#define LDS_WAIT() asm volatile("s_waitcnt lgkmcnt(0)" ::: "memory")

__device__ __forceinline__ void tr_item(const float* W, int K, int N, const float* scale, bf16_t* WT, int dst_row0, LAS float* scr, int k0, int n0, int lane) {
#pragma unroll 8
    for (int i = 0; i < 32; ++i) { const int kk = 2 * i + (lane >> 5); float v = W[(size_t)(k0 + kk) * N + n0 + (lane & 31)]; if (scale) v *= scale[k0 + kk]; scr[kk * 33 + (lane & 31)] = v; }
    LDS_WAIT(); asm volatile("" ::: "memory");
    const int c = lane & 7;
#pragma unroll
    for (int j = 0; j < 4; ++j) { const int n = (lane >> 3) + 8 * j; const LAS float* s = scr + (8 * c) * 33 + n;
        u32x4 o; o.x = cvtpk(s[0 * 33], s[1 * 33]); o.y = cvtpk(s[2 * 33], s[3 * 33]); o.z = cvtpk(s[4 * 33], s[5 * 33]); o.w = cvtpk(s[6 * 33], s[7 * 33]);
        *(u32x4*)(WT + (size_t)(dst_row0 + n) * K + k0 + 8 * c) = o; }
    LDS_WAIT(); asm volatile("" ::: "memory");
}
typedef const __attribute__((address_space(4))) Args* cargs_t;
__device__ __forceinline__ void weights_prologue(cargs_t ap, LAS unsigned char* lds, int gw, int ngw, int wave, int lane) {
    LAS float* scr = (LAS float*)(lds + wave * 16384);
    bf16_t* WT = (bf16_t*)(ap->ws + WS_W);
    constexpr int I_IN = 16 * 288, I_SQ = 16 * 32, I_P = 4 * 32, I_L = I_IN + 4 * I_SQ + I_P;
    for (int it = gw; it < I_L * NLAYER; it += ngw) {
        const int l = it / I_L; int r = it % I_L; bf16_t* wl = WT + (size_t)l * LW_TOTAL;
        if (r < I_IN) { const int kb = r / 288, nb = r % 288, n0 = nb * 32; const int osec = n0 >> 10;
            const int nsec = (int)((0x654832170ull >> (4 * osec)) & 0xFull);
            tr_item(ap->w_in + (size_t)l * 1024 * 9216, 1024, 9216, ap->norm_g + l * 1024, wl + LW_IN, nsec * 1024 + (n0 & 1023) - 0, scr, kb * 64, n0, lane);
            continue; }
        r -= I_IN;
        if (r < 4 * I_SQ) { const int which = r / I_SQ; const int rr = r % I_SQ; const int kb = rr / 32, nb = rr % 32;
            const float* src = which == 0 ? ap->w_a_out : which == 1 ? ap->w_b_out : which == 2 ? ap->w_o : ap->w_ple_gate;
            const size_t off = which == 0 ? LW_A : which == 1 ? LW_B : which == 2 ? LW_O : LW_G;
            tr_item(src + (size_t)l * 1048576, 1024, 1024, which == 3 ? ap->ple_norm_g + l * 1024 : nullptr, wl + off, nb * 32, scr, kb * 64, nb * 32, lane);
            continue; }
        r -= 4 * I_SQ;
        { const int kb = r / 32, nb = r % 32; tr_item(ap->w_ple + (size_t)l * 262144, 256, 1024, nullptr, wl + LW_P, nb * 32, scr, kb * 64, nb * 32, lane); }
    }
}

__device__ __forceinline__ void init_rows(const float* x, bf16_t* XB, float* S, int gw, int ngw, int lane) {
    asm volatile("" : "+v"(lane)); asm volatile("" : "+s"(gw));
    for (int m = gw; m < MH; m += ngw) {
        const f32x4* xr = (const f32x4*)(x + (size_t)m * DM) + lane; float s = 0.f; f32x4 v[4];
#pragma unroll
        for (int j = 0; j < 4; ++j) { v[j] = xr[64 * j]; s += (v[j][0] * v[j][0] + v[j][1] * v[j][1]) + (v[j][2] * v[j][2] + v[j][3] * v[j][3]); }
        s = wave_sum(s);
        u32x2* o = (u32x2*)(XB + (size_t)m * DM) + lane;
#pragma unroll
        for (int j = 0; j < 4; ++j) { u32x2 w; w.x = cvtpk(v[j][0], v[j][1]); w.y = cvtpk(v[j][2], v[j][3]); o[64 * j] = w; }
        if (lane < 16) S[(size_t)m * 16 + lane] = lane == 0 ? s : 0.f;
    }
}
__device__ __forceinline__ void final_rows(float* out, const float* g, int gw, int ngw, int lane) {
    asm volatile("" : "+v"(lane)); asm volatile("" : "+s"(gw));
    for (int m = gw; m < MH; m += ngw) {
        f32x4* xr = (f32x4*)(out + (size_t)m * DM) + lane; float s = 0.f; f32x4 v[4];
#pragma unroll
        for (int j = 0; j < 4; ++j) { v[j] = xr[64 * j]; s += (v[j][0] * v[j][0] + v[j][1] * v[j][1]) + (v[j][2] * v[j][2] + v[j][3] * v[j][3]); }
        const float rs = rsqrtf(wave_sum(s) * (1.0f / DM) + EPS);
#pragma unroll
        for (int j = 0; j < 4; ++j) { const f32x4 gg = ((const f32x4*)g)[64 * j + lane]; xr[64 * j] = v[j] * rs * gg; }
    }
}
__device__ __forceinline__ void convert_p(const float* p, bf16_t* PB, int gtid, int nthr) {
    asm volatile("" : "+v"(gtid));
    for (int i = gtid; i < MH * PLE / 8; i += nthr) { const f32x4 a = ((const f32x4*)p)[2 * i], b = ((const f32x4*)p)[2 * i + 1]; ((u32x4*)PB)[i] = pack8(a, b); }
}

__device__ __forceinline__ void gmlp_unit(LAS unsigned char* lds, const bf16_t* PROJ, const bf16_t* VT2, bf16_t* BRA, const float* lng, const float* lnb, const float* ws, const float* bs, int c, int gh) {
    int tid_ = threadIdx.x; asm volatile("" : "+v"(tid_)); const int tid = tid_, lane = tid & 63, l32 = lane & 31, hi = lane >> 5; const int w = __builtin_amdgcn_readfirstlane(tid >> 6);
    const int tok0 = c * 128;
    LAS float* red = (LAS float*)lds;
    LAS float* stat = (LAS float*)(lds + 32768);
    LAS unsigned char* T = lds + 34816;
    { const int sc = tid & 15, rg = tid >> 4; float s[8], q[8];
#pragma unroll
      for (int j = 0; j < 8; ++j) { s[j] = 0.f; q[j] = 0.f; }
      for (int i = 0; i < 32; ++i) { const u32x4 wv = *(const u32x4*)(VT2 + (size_t)(rg + 32 * i) * MH + tok0 + sc * 8); f32x4 a, b; unpack8(wv, a, b);
#pragma unroll
          for (int j = 0; j < 4; ++j) { s[j] += a[j]; q[j] += a[j] * a[j]; s[4 + j] += b[j]; q[4 + j] += b[j] * b[j]; } }
#pragma unroll
      for (int j = 0; j < 8; ++j) { red[rg * 256 + sc * 8 + j] = s[j]; red[rg * 256 + 128 + sc * 8 + j] = q[j]; } }
    __syncthreads();
    if (tid < 128) { float s = 0.f, q = 0.f;
        for (int i = 0; i < 32; ++i) { s += red[i * 256 + tid]; q += red[i * 256 + 128 + tid]; }
        const float mean = s * (1.0f / 1024.0f); const float var = q * (1.0f / 1024.0f) - mean * mean;
        stat[2 * tid] = mean; stat[2 * tid + 1] = rsqrtf(var + EPS); }
    __syncthreads();
    const int tb = w & 3, dh = w >> 2;
    for (int gi = 0; gi < 4; ++gi) { const int g = gh * 4 + gi;
#pragma unroll
        for (int i = 0; i < 4; ++i) { const int p = tid + 512 * i, d = p >> 4, sc = p & 15;
            const u32x4 wv = *(const u32x4*)(VT2 + (size_t)(g * 128 + d) * MH + tok0 + sc * 8); f32x4 a, b; unpack8(wv, a, b);
            const float gg = lng[g * 128 + d], bb = lnb[g * 128 + d];
#pragma unroll
            for (int j = 0; j < 4; ++j) { a[j] = (a[j] - stat[2 * (sc * 8 + j)]) * stat[2 * (sc * 8 + j) + 1] * gg + bb; b[j] = (b[j] - stat[2 * (sc * 8 + 4 + j)]) * stat[2 * (sc * 8 + 4 + j) + 1] * gg + bb; }
            *(LAS u32x4*)(T + d * 272 + sc * 16) = pack8(a, b); }
        __syncthreads();
        f32x16 acc0 = {}, acc1 = {};
        const float* wrow = ws + (size_t)g * 16384 + (size_t)(32 * tb + l32) * 128 + 8 * hi;
        const int trow = 32 * tb + l32;
        for (int ks = 0; ks < 2 * tb + 2; ++ks) {
            f32x4 wa = *(const f32x4*)(wrow + 16 * ks), wb = *(const f32x4*)(wrow + 16 * ks + 4); const int s0 = 16 * ks + 8 * hi;
#pragma unroll
            for (int j = 0; j < 4; ++j) { if (s0 + j > trow) wa[j] = 0.f; if (s0 + 4 + j > trow) wb[j] = 0.f; }
            const bf16x8 A = __builtin_bit_cast(bf16x8, pack8(wa, wb));
            const bf16x8 B0 = *(const LAS bf16x8*)(T + (64 * dh + l32) * 272 + (16 * ks + 8 * hi) * 2);
            const bf16x8 B1 = *(const LAS bf16x8*)(T + (64 * dh + 32 + l32) * 272 + (16 * ks + 8 * hi) * 2);
            acc0 = __builtin_amdgcn_mfma_f32_32x32x16_bf16(A, B0, acc0, 0, 0, 0);
            acc1 = __builtin_amdgcn_mfma_f32_32x32x16_bf16(A, B1, acc1, 0, 0, 0);
        }
#pragma unroll
        for (int r = 0; r < 16; ++r) { const int t = 32 * tb + (r & 3) + 8 * (r >> 2) + 4 * hi; const float bv = bs[g * 128 + t];
            const size_t tok = (size_t)(tok0 + t);
#pragma unroll
            for (int db = 0; db < 2; ++db) { const int col = g * 128 + 64 * dh + 32 * db + l32;
                const float uu = __uint_as_float((unsigned)PROJ[tok * NP1 + col] << 16), zz = __uint_as_float((unsigned)PROJ[tok * NP1 + 1024 + col] << 16);
                const float y = (db == 0 ? acc0[r] : acc1[r]) + bv;
                BRA[tok * DM + col] = (bf16_t)(cvtpk(uu * y * zz, 0.f) & 0xffffu); } }
        __syncthreads();
    }
}

constexpr int AT_KS = 17408, AT_VS = 18432, AT_VOFF = 2 * AT_KS;
__device__ __forceinline__ void attn_unit(LAS unsigned char* lds, const bf16_t* PROJ, const bf16_t* VT2, bf16_t* BRB, const float* subg, float lam, float lam_init, int b, int h, int qb) {
    int tid_ = threadIdx.x; asm volatile("" : "+v"(tid_)); const int tid = tid_, lane = tid & 63, l32 = lane & 31, hi = lane >> 5; const int w = __builtin_amdgcn_readfirstlane(tid >> 6); const int map = w >> 2, wq = w & 3;
    const int rowbase = b * SEQ, q0 = qb * 128, myq = q0 + wq * 32 + l32, NT = 2 * qb + 2;
    bf16x8 qf[4];
    { const bf16_t* qp = PROJ + (size_t)(rowbase + myq) * NP1 + 2048 + h * 128 + map * 64 + hi * 8;
#pragma unroll
      for (int ks = 0; ks < 4; ++ks) qf[ks] = *(const bf16x8*)(qp + ks * 16); }
    const bf16_t* ksrc[2]; const bf16_t* vsrc[2]; int kdst[2], vdst[2];
#pragma unroll
    for (int i = 0; i < 2; ++i) { const int p = tid + 512 * i;
        ksrc[i] = PROJ + (size_t)(rowbase + (p >> 4)) * NP1 + 3072 + h * 128 + (p & 15) * 8; kdst[i] = (p >> 4) * 272 + (p & 15) * 16;
        vsrc[i] = VT2 + (size_t)(1024 + h * 128 + (p >> 3)) * MH + rowbase + (p & 7) * 8; vdst[i] = AT_VOFF + (p >> 3) * 144 + (((p & 7) >> 1) * 16 + (p & 1) * 4) * 2; }
    u32x4 kr[2], vr[2];
#pragma unroll
    for (int i = 0; i < 2; ++i) { kr[i] = *(const u32x4*)(ksrc[i]); vr[i] = *(const u32x4*)(vsrc[i]); }
#pragma unroll
    for (int i = 0; i < 2; ++i) { *(LAS u32x4*)(lds + kdst[i]) = kr[i]; *(LAS u32x2*)(lds + vdst[i]) = (u32x2){vr[i].x, vr[i].y}; *(LAS u32x2*)(lds + vdst[i] + 16) = (u32x2){vr[i].z, vr[i].w}; }
    __syncthreads();
    f32x16 O[4]; O[0] = f32x16{}; O[1] = f32x16{}; O[2] = f32x16{}; O[3] = f32x16{};
    float m_run = -1e30f, l_run = 0.f;
    for (int t = 0; t < NT; ++t) {
        const int buf = t & 1, kv0 = 64 * t;
        if (t + 1 < NT) {
#pragma unroll
            for (int i = 0; i < 2; ++i) { kr[i] = *(const u32x4*)(ksrc[i] + (size_t)(kv0 + 64) * NP1); vr[i] = *(const u32x4*)(vsrc[i] + kv0 + 64); } }
        if (kv0 <= q0 + wq * 32 + 31) {
            LAS unsigned char* Kb = lds + buf * AT_KS + l32 * 272 + map * 128 + hi * 16;
            LAS unsigned char* Vb = lds + AT_VOFF + buf * AT_VS + l32 * 144 + hi * 16;
            f32x16 S0 = {}, S1 = {};
            { bf16x8 kf[8];
#pragma unroll
              for (int ks = 0; ks < 4; ++ks) { kf[2 * ks] = *(const LAS bf16x8*)(Kb + ks * 32); kf[2 * ks + 1] = *(const LAS bf16x8*)(Kb + 32 * 272 + ks * 32); }
              __builtin_amdgcn_sched_barrier(0);
#pragma unroll
              for (int ks = 0; ks < 4; ++ks) { S0 = __builtin_amdgcn_mfma_f32_32x32x16_bf16(kf[2 * ks], qf[ks], S0, 0, 0, 0); S1 = __builtin_amdgcn_mfma_f32_32x32x16_bf16(kf[2 * ks + 1], qf[ks], S1, 0, 0, 0); } }
            u32x4 va[8], vb[8];
#pragma unroll
            for (int j = 0; j < 2; ++j)
#pragma unroll
                for (int db = 0; db < 4; ++db) va[j * 4 + db] = *(const LAS u32x4*)(Vb + db * 32 * 144 + j * 32);
            __builtin_amdgcn_sched_barrier(0);
            if (t >= NT - 2) {
#pragma unroll
                for (int r = 0; r < 16; ++r) { const int kv = kv0 + (r & 3) + 8 * (r >> 2) + 4 * hi; if (kv > myq) S0[r] = -1e30f; if (kv + 32 > myq) S1[r] = -1e30f; } }
            float mx = __builtin_fmaxf(__builtin_fmaxf(S0[0], S1[0]), __builtin_fmaxf(S0[1], S1[1]));
#pragma unroll
            for (int r = 2; r < 16; r += 2) { mx = __builtin_fmaxf(__builtin_fmaxf(mx, S0[r]), S1[r]); mx = __builtin_fmaxf(__builtin_fmaxf(mx, S0[r + 1]), S1[r + 1]); }
            mx = fmaxf(mx, __shfl_xor(mx, 32));
            if (__any(mx > m_run)) { const float mnew = fmaxf(m_run, mx), alpha = __builtin_amdgcn_exp2f(m_run - mnew); m_run = mnew; l_run *= alpha;
#pragma unroll
                for (int db = 0; db < 4; ++db)
#pragma unroll
                    for (int r = 0; r < 16; ++r) O[db][r] *= alpha; }
            pg8::f32x2 ps2 = {0.f, 0.f};
#pragma unroll
            for (int r = 0; r < 16; r += 2) { S0[r] = __builtin_amdgcn_exp2f(S0[r] - m_run); S0[r + 1] = __builtin_amdgcn_exp2f(S0[r + 1] - m_run); S1[r] = __builtin_amdgcn_exp2f(S1[r] - m_run); S1[r + 1] = __builtin_amdgcn_exp2f(S1[r + 1] - m_run);
                ps2 += (pg8::f32x2){S0[r], S0[r + 1]}; ps2 += (pg8::f32x2){S1[r], S1[r + 1]}; }
            l_run += ps2.x + ps2.y;
            bf16x8 pf[4];
#pragma unroll
            for (int j = 0; j < 4; ++j) { u32x4 pw;
#pragma unroll
                for (int i = 0; i < 4; ++i) pw[i] = (j < 2) ? cvtpk(S0[8 * (j & 1) + 2 * i], S0[8 * (j & 1) + 2 * i + 1]) : cvtpk(S1[8 * (j & 1) + 2 * i], S1[8 * (j & 1) + 2 * i + 1]);
                pf[j] = __builtin_bit_cast(bf16x8, pw); }
#pragma unroll
            for (int j = 2; j < 4; ++j)
#pragma unroll
                for (int db = 0; db < 4; ++db) vb[(j - 2) * 4 + db] = *(const LAS u32x4*)(Vb + db * 32 * 144 + j * 32);
            __builtin_amdgcn_sched_barrier(0);
#pragma unroll
            for (int j = 0; j < 2; ++j)
#pragma unroll
                for (int db = 0; db < 4; ++db) O[db] = __builtin_amdgcn_mfma_f32_32x32x16_bf16(__builtin_bit_cast(bf16x8, va[j * 4 + db]), pf[j], O[db], 0, 0, 0);
#pragma unroll
            for (int j = 2; j < 4; ++j)
#pragma unroll
                for (int db = 0; db < 4; ++db) O[db] = __builtin_amdgcn_mfma_f32_32x32x16_bf16(__builtin_bit_cast(bf16x8, vb[(j - 2) * 4 + db]), pf[j], O[db], 0, 0, 0);
        }
        if (t + 1 < NT) {
#pragma unroll
            for (int i = 0; i < 2; ++i) { *(LAS u32x4*)(lds + (buf ^ 1) * AT_KS + kdst[i]) = kr[i]; *(LAS u32x2*)(lds + (buf ^ 1) * AT_VS + vdst[i]) = (u32x2){vr[i].x, vr[i].y}; *(LAS u32x2*)(lds + (buf ^ 1) * AT_VS + vdst[i] + 16) = (u32x2){vr[i].z, vr[i].w}; } }
        __syncthreads();
    }
    const float inv = 1.0f / (l_run + __shfl_xor(l_run, 32));
    LAS float* X = (LAS float*)lds + wq * 4096 + lane;
    if (map == 1) { const float sc = -lam * inv;
#pragma unroll
        for (int db = 0; db < 4; ++db)
#pragma unroll
            for (int r = 0; r < 16; ++r) X[(db * 16 + r) * 64] = O[db][r] * sc; }
    __syncthreads();
    if (map == 0) { float ss = 0.f;
#pragma unroll
        for (int db = 0; db < 4; ++db)
#pragma unroll
            for (int r = 0; r < 16; ++r) { const float o = O[db][r] * inv + X[(db * 16 + r) * 64]; O[db][r] = o; ss += o * o; }
        ss += __shfl_xor(ss, 32);
        const float rs = rsqrtf(ss * (1.0f / 128.0f) + EPS) * (1.0f - lam_init);
        const size_t row = (size_t)(rowbase + myq);
#pragma unroll
        for (int db = 0; db < 4; ++db)
#pragma unroll
            for (int rg = 0; rg < 4; ++rg) { const int d = 32 * db + 8 * rg + 4 * hi; const f32x4 gg = *(const f32x4*)(subg + d);
                const u32x2 zw = *(const u32x2*)(PROJ + row * NP1 + 4096 + h * 128 + d);
                const float z0 = __uint_as_float(zw.x << 16), z1 = __uint_as_float(zw.x & 0xffff0000u), z2 = __uint_as_float(zw.y << 16), z3 = __uint_as_float(zw.y & 0xffff0000u);
                u32x2 ow; ow.x = cvtpk(O[db][4 * rg] * rs * gg[0] * z0, O[db][4 * rg + 1] * rs * gg[1] * z1); ow.y = cvtpk(O[db][4 * rg + 2] * rs * gg[2] * z2, O[db][4 * rg + 3] * rs * gg[3] * z3);
                *(u32x2*)(BRB + row * DM + h * 128 + d) = ow; } }
    __syncthreads();
}

#define RLX_AGENT __ATOMIC_RELAXED, __HIP_MEMORY_SCOPE_AGENT
#define XB_TMO      128
#define XB_XCNT(j)  (256  + 64 * (j))
#define XB_XSUB(j)  (1280 + 64 * (j))
#define XB_XGEN(j)  (2304 + 64 * (j))
#define XB_TOP      3328
#define XB_TOPGEN   3392
#define XCD_BAR_WORDS 3456
#define XB_SPIN_CAP (1u << 18)

__device__ __forceinline__ unsigned xb_ld(unsigned* p)              { return __hip_atomic_load(p, __ATOMIC_RELAXED, __HIP_MEMORY_SCOPE_AGENT); }
__device__ __forceinline__ unsigned xb_add(unsigned* p, unsigned v) { return __hip_atomic_fetch_add(p, v, __ATOMIC_RELAXED, __HIP_MEMORY_SCOPE_AGENT); }
__device__ __forceinline__ unsigned xb_xcc_id() { return (unsigned)__builtin_amdgcn_s_getreg((3 << 11) | 20) & 0xFu; }
#define XB_SPIN(cond, bar) do { unsigned _sp = 0; while (cond) { __builtin_amdgcn_s_sleep(1); \
    if ((++_sp & 255u) == 0u) { if (xb_ld(&(bar)[XB_TMO])) break; if (_sp > XB_SPIN_CAP) { atomicAdd(&(bar)[XB_TMO], 1u); break; } } } } while (0)

struct XcdBarrier {
    unsigned* bar; unsigned x;
    volatile LAS unsigned* st;
};

__device__ __forceinline__ XcdBarrier xcd_barrier_post(unsigned* bar, volatile LAS unsigned* st) {
    XcdBarrier b; b.bar = bar; b.x = xb_xcc_id(); b.st = st;
    if (threadIdx.x == 0) (void)xb_add(&bar[XB_XCNT(b.x)], 1u);
    return b;
}
__device__ __forceinline__ void xcd_barrier_complete(unsigned* bar, unsigned x, unsigned& nloc, unsigned& nx) {
    const unsigned G = gridDim.x * gridDim.y * gridDim.z;
    unsigned sum, cnt, mine, sp = 0u;
    for (;;) {
        sum = 0u; cnt = 0u; mine = 0u;
#pragma unroll
        for (unsigned j = 0; j < 16; ++j) { const unsigned c = xb_ld(&bar[XB_XCNT(j)]); sum += c; cnt += (c > 0u) ? 1u : 0u; mine = (j == x) ? c : mine; }
        if (sum == G) break;
        __builtin_amdgcn_s_sleep(1);
        if ((++sp & 255u) == 0u) { if (xb_ld(&bar[XB_TMO])) break; if (sp > XB_SPIN_CAP) { atomicAdd(&bar[XB_TMO], 1u); break; } }
    }
    nloc = mine > 0u ? mine : 1u; nx = cnt > 0u ? cnt : 1u;
}

__device__ __forceinline__ void xcd_barrier(const XcdBarrier& b) {
    asm volatile("s_waitcnt vmcnt(0)" ::: "memory");
    __syncthreads();
    if (threadIdx.x == 0) {
        unsigned* bar = b.bar;
        __builtin_amdgcn_s_waitcnt(0);
        unsigned nloc = b.st[0], nx = b.st[1];
        if (nloc == 0u) { xcd_barrier_complete(bar, b.x, nloc, nx); b.st[0] = nloc; b.st[1] = nx; }
        const unsigned old = xb_add(&bar[XB_XSUB(b.x)], 1u);
        const unsigned gen = old / nloc;
        if (old + 1u == (gen + 1u) * nloc) {
            __builtin_amdgcn_fence(__ATOMIC_RELEASE, "agent");
            asm volatile("s_waitcnt vmcnt(0)" ::: "memory");
            const unsigned og = xb_add(&bar[XB_TOP], 1u);
            const unsigned tg = og / nx;
            if (og + 1u == (tg + 1u) * nx) xb_add(&bar[XB_TOPGEN], 1u);
            else XB_SPIN(xb_ld(&bar[XB_TOPGEN]) == tg, bar);
            __builtin_amdgcn_fence(__ATOMIC_ACQUIRE, "agent");
            xb_add(&bar[XB_XGEN(b.x)], 1u);
            asm volatile("s_waitcnt vmcnt(0)" ::: "memory");
        } else {
            XB_SPIN(xb_ld(&bar[XB_XGEN(b.x)]) == gen, bar);
            __builtin_amdgcn_fence(__ATOMIC_ACQUIRE, "agent");
            asm volatile("s_waitcnt vmcnt(0)" ::: "memory");
        }
    }
    __syncthreads();
}


__global__ void __launch_bounds__(NTHREADS, 2) mega_fwd(Args a_unused) {
    extern __shared__ __attribute__((aligned(16))) unsigned char lds_raw[];
    LAS unsigned char* lds = (LAS unsigned char*)lds_raw;
    cg::grid_group grid = cg::this_grid();
    const int tid = threadIdx.x, lane = tid & 63, wave = __builtin_amdgcn_readfirstlane(tid >> 6);
    const int G = gridDim.x, bx = blockIdx.x;
    const int vcu = (G % 8 == 0) ? (bx % 8) * (G / 8) + bx / 8 : bx;
    const int gw = vcu * NWAVES + wave, ngw = G * NWAVES;
#define ARGS() cargs_t ap = (cargs_t)__builtin_amdgcn_kernarg_segment_ptr(); asm volatile("" : "+s"(ap)); unsigned char* const ws = ap->ws
#define GSYNC() xcd_barrier(xbar)
#define WSP(T, off) ((T*)(ws + (off)))
#define XBP(ci) ((bf16_t*)(ws + ((ci) ? WS_X1 : WS_X0)))
#define SXP(ci) ((float*)(ws + ((ci) ? WS_S1 : WS_S0)))
#define TMPP ((float*)(ws + WS_PROJ + 4096))
    if (tid < 64) ((LAS unsigned*)(lds + 131072))[tid] = 0u;
    __syncthreads();
    grid.sync();
    XcdBarrier xbar;
    { ARGS(); xbar = xcd_barrier_post((unsigned*)ws, (volatile LAS unsigned*)(lds + 131072)); }
    { ARGS(); weights_prologue(ap, lds, gw, ngw, wave, lane); }

#define DUMP_BF16(buf_off, nelem) do { ARGS(); const bf16_t* B_ = WSP(bf16_t, buf_off); float* o_ = ap->out; \
    for (size_t i_ = (size_t)bx * NTHREADS + tid; i_ < (size_t)2 * MH * DM; i_ += (size_t)G * NTHREADS) o_[i_] = __uint_as_float((unsigned)B_[i_ % (size_t)(nelem)] << 16); } while (0)
    for (int hf = 0; hf < 2; ++hf) {
        { ARGS(); init_rows(ap->x + (size_t)hf * MH * DM, XBP(0), SXP(0), gw, ngw, lane); }
        GSYNC();
        int c = 0;
        for (int l = 0; l < NLAYER; ++l) {
            { ARGS(); convert_p(ap->p + ((size_t)l * 2 * MH + (size_t)hf * MH) * PLE, WSP(bf16_t, WS_PB), bx * NTHREADS + tid, G * NTHREADS); }
#if !defined(ONLY) || ONLY == 0
            { ARGS(); const bf16_t* wl = WSP(bf16_t, WS_W) + (size_t)l * LW_TOTAL;
              pg8::Gemm g{XBP(c), wl + LW_IN, MH, NP1, DM}; pg8::StaticOrder S; S.init(MH, NP1, G, bx);
              pg8::Epi E{0, WSP(bf16_t, WS_PROJ), NP1, nullptr, 0, nullptr, 0, nullptr, SXP(c), nullptr, nullptr, nullptr};
              pg8::gemm_phase<pg8::Epi, pg8::StaticOrder, true, true>(lds, g, S, E); }
#endif
#if !defined(ONLY) || ONLY == 1
            { ARGS(); const bf16_t* wl = WSP(bf16_t, WS_W) + (size_t)l * LW_TOTAL;
              pg8::Gemm g{wl + LW_IN + (size_t)NP1 * DM, XBP(c), NV2, MH, DM}; pg8::StaticOrder S; S.init(NV2, MH, G, bx);
              pg8::Epi E{1, WSP(bf16_t, WS_VT2), MH, nullptr, 0, nullptr, 0, nullptr, SXP(c), nullptr, nullptr, nullptr};
              pg8::gemm_phase<pg8::Epi, pg8::StaticOrder, true, true>(lds, g, S, E); }
#endif
            GSYNC();
#if defined(STOP_AFTER) && STOP_AFTER == 1
            DUMP_BF16(WS_PROJ, (size_t)MH * NP1); return;
#endif
#if defined(STOP_AFTER) && STOP_AFTER == 11
            DUMP_BF16(WS_VT2, (size_t)MH * NV2); return;
#endif
#ifndef NO_GMLP
            { ARGS();
              for (int u = vcu; u < 256; u += G)
                gmlp_unit(lds, WSP(bf16_t, WS_PROJ), WSP(bf16_t, WS_VT2), WSP(bf16_t, WS_BRA), ap->a_ln_g + l * 1024, ap->a_ln_b + l * 1024, ap->a_ws + (size_t)l * 131072, ap->a_bs + l * 1024, u >> 1, u & 1); }
#endif
#ifdef NO_ATTN
            { ARGS(); const bf16_t* PR = WSP(bf16_t, WS_PROJ); bf16_t* B = WSP(bf16_t, WS_BRB);
              for (int i = bx * NTHREADS + tid; i < MH * DM / 8; i += G * NTHREADS) { const int row = i >> 7, c8 = i & 127; *(u32x4*)(B + (size_t)row * DM + c8 * 8) = *(const u32x4*)(PR + (size_t)row * NP1 + 4096 + c8 * 8); } }
#endif
#ifdef NO_GMLP
            { ARGS(); const bf16_t* PR = WSP(bf16_t, WS_PROJ); bf16_t* B = WSP(bf16_t, WS_BRA);
              for (int i = bx * NTHREADS + tid; i < MH * DM / 8; i += G * NTHREADS) { const int row = i >> 7, c8 = i & 127; *(u32x4*)(B + (size_t)row * DM + c8 * 8) = *(const u32x4*)(PR + (size_t)row * NP1 + c8 * 8); } }
#endif
#ifndef NO_ATTN
            { ARGS();
              const float lam_init = 0.8f - 0.6f * expf(-0.3f * (float)l);
              const float d0 = wave_sum(ap->lam_q[l * 128 + lane] * ap->lam_k[l * 128 + lane]), d1 = wave_sum(ap->lam_q[l * 128 + 64 + lane] * ap->lam_k[l * 128 + 64 + lane]);
              const float lam = expf(d0) - expf(d1) + lam_init;
              for (int pu = vcu; pu < 512; pu += G) { const int bh = pu >> 4, s = pu & 15;
                  attn_unit(lds, WSP(bf16_t, WS_PROJ), WSP(bf16_t, WS_VT2), WSP(bf16_t, WS_BRB), ap->subln_g + l * 128, lam, lam_init, bh >> 3, bh & 7, 31 - s);
                  attn_unit(lds, WSP(bf16_t, WS_PROJ), WSP(bf16_t, WS_VT2), WSP(bf16_t, WS_BRB), ap->subln_g + l * 128, lam, lam_init, bh >> 3, bh & 7, s); } }
#endif
            GSYNC();
#if !defined(ONLY) || ONLY == 2
            { ARGS(); const bf16_t* wl = WSP(bf16_t, WS_W) + (size_t)l * LW_TOTAL;
              pg8::Gemm g{WSP(bf16_t, WS_BRA), wl + LW_A, MH, DM, DM}; pg8::StaticOrder S; S.init(MH, DM, G, bx);
              pg8::Epi E{2, WSP(bf16_t, WS_PROJ) + 2048, NP1, nullptr, 0, nullptr, 0, WSP(bf16_t, WS_PROJ) + 5120, nullptr, nullptr, nullptr, nullptr};
              pg8::gemm_phase<pg8::Epi, pg8::StaticOrder, true, true>(lds, g, S, E); }
#endif
#if !defined(ONLY) || ONLY == 3
            { ARGS(); const bf16_t* wl = WSP(bf16_t, WS_W) + (size_t)l * LW_TOTAL;
              pg8::Gemm g{WSP(bf16_t, WS_BRB), wl + LW_B, MH, DM, DM}; pg8::StaticOrder S; S.init(MH, DM, G, bx);
              pg8::Epi E{3, XBP(1 - c), DM, nullptr, 0, nullptr, 0, WSP(bf16_t, WS_PROJ) + 6144, nullptr, nullptr, WSP(bf16_t, WS_PROJ) + 2048, nullptr};
              pg8::gemm_phase<pg8::Epi, pg8::StaticOrder, true, true>(lds, g, S, E); }
#endif
            GSYNC();
#if defined(STOP_AFTER) && STOP_AFTER == 3
            if (c == 0) DUMP_BF16(WS_X1, (size_t)MH * DM); else DUMP_BF16(WS_X0, (size_t)MH * DM); return;
#endif
#if !defined(ONLY) || ONLY == 4
            { ARGS(); const bf16_t* wl = WSP(bf16_t, WS_W) + (size_t)l * LW_TOTAL; float* out = ap->out + (size_t)hf * MH * DM;
              pg8::Gemm g{XBP(1 - c), wl + LW_O, MH, DM, DM}; pg8::StaticOrder S; S.init(MH, DM, G, bx);
              pg8::Epi E{4, XBP(c), DM, nullptr, 0, l == 0 ? ap->x + (size_t)hf * MH * DM : (const float*)nullptr, DM, nullptr, nullptr, SXP(c), nullptr, XBP(c)};
              pg8::gemm_phase<pg8::Epi, pg8::StaticOrder, true, true>(lds, g, S, E); }
#endif
            GSYNC();
#if defined(STOP_AFTER) && STOP_AFTER == 4
            if (c == 0) DUMP_BF16(WS_X0, (size_t)MH * DM); else DUMP_BF16(WS_X1, (size_t)MH * DM); return;
#endif
#if !defined(ONLY) || ONLY == 5
            { ARGS(); const bf16_t* wl = WSP(bf16_t, WS_W) + (size_t)l * LW_TOTAL;
              pg8::Gemm g{XBP(c), wl + LW_G, MH, DM, DM}; pg8::StaticOrder S; S.init(MH, DM, G, bx);
              pg8::Epi E{5, WSP(bf16_t, WS_PROJ) + 2048, NP1, nullptr, 0, nullptr, 0, nullptr, SXP(c), nullptr, nullptr, nullptr};
              pg8::gemm_phase<pg8::Epi, pg8::StaticOrder, true, true>(lds, g, S, E); }
#endif
#if !defined(ONLY) || ONLY == 6
            { ARGS(); const bf16_t* wl = WSP(bf16_t, WS_W) + (size_t)l * LW_TOTAL; float* out = ap->out + (size_t)hf * MH * DM;
              pg8::Gemm g{WSP(bf16_t, WS_PB), wl + LW_P, MH, DM, PLE}; pg8::StaticOrder S; S.init(MH, DM, G, bx);
              pg8::Epi E{6, XBP(1 - c), DM, l == NLAYER - 1 ? out : (float*)nullptr, DM, nullptr, 0, nullptr, nullptr, SXP(1 - c), WSP(bf16_t, WS_PROJ) + 2048, XBP(c)};
              pg8::gemm_phase<pg8::Epi, pg8::StaticOrder, true, true>(lds, g, S, E); }
#endif
            GSYNC();
#if defined(STOP_AFTER) && STOP_AFTER == 5
            if (c == 0) DUMP_BF16(WS_X1, (size_t)MH * DM); else DUMP_BF16(WS_X0, (size_t)MH * DM); return;
#endif
            c ^= 1;
        }
        { ARGS(); final_rows(ap->out + (size_t)hf * MH * DM, ap->final_g, gw, ngw, lane); }
    }
}

extern "C" void kernel_launch(void* const* d_in, const int* in_sizes, int n_in, void* d_out, int out_size, void* d_ws, size_t ws_size, hipStream_t stream) {
    static int grid = 0;
    if (grid == 0) {
        if (n_in != 18 || ws_size < WS_END) { fprintf(stderr, "kernel_launch: unexpected n_in %d / ws_size %zu (need %zu)\n", n_in, ws_size, (size_t)WS_END); grid = -1; return; }
        int dev = 0, cus = 0, per_cu = 0;
        hipGetDevice(&dev); hipDeviceGetAttribute(&cus, hipDeviceAttributeMultiprocessorCount, dev);
        if (hipFuncSetAttribute((const void*)mega_fwd, hipFuncAttributeMaxDynamicSharedMemorySize, LDS_BYTES) != hipSuccess) { fprintf(stderr, "kernel_launch: hipFuncSetAttribute failed\n"); grid = -1; return; }
        if (hipOccupancyMaxActiveBlocksPerMultiprocessor(&per_cu, (const void*)mega_fwd, NTHREADS, LDS_BYTES) != hipSuccess || per_cu < 1) { fprintf(stderr, "kernel_launch: occupancy query gives %d\n", per_cu); per_cu = 1; }
        (void)hipGetLastError();
        grid = cus;
    }
    if (grid < 0) return;
    if (hipMemsetAsync(d_ws, 0, 16384, stream) != hipSuccess) { fprintf(stderr, "kernel_launch: memset failed\n"); return; }
    Args a{};
    const float** f = (const float**)&a;
    for (int i = 0; i < 18; ++i) f[i] = (const float*)d_in[i];
    a.out = (float*)d_out; a.ws = (unsigned char*)d_ws;
    void* args[] = {&a};
    hipError_t e = hipLaunchCooperativeKernel((const void*)mega_fwd, dim3(grid), dim3(NTHREADS), args, LDS_BYTES, stream);
    if (e != hipSuccess) fprintf(stderr, "cooperative launch failed: %s (grid %d)\n", hipGetErrorString(e), grid);
}
```

```cpp
#include <hip/hip_runtime.h>
#include <hip/hip_cooperative_groups.h>
#include <cstdio>
#include <cstdint>
namespace cg = cooperative_groups;
namespace pg8 {
#define PG8_LAS __attribute__((address_space(3)))
typedef unsigned short bf16_t;
typedef short bf16x8 __attribute__((ext_vector_type(8)));
typedef float f32x4 __attribute__((ext_vector_type(4)));
typedef unsigned u32x4 __attribute__((ext_vector_type(4)));
constexpr int BM = 256, BK = 64, HALF = 128, HTB = HALF * BK * 2  , STAGE_BYTES = 8 * HTB, NXCD = 8, WGM = 8;

__host__ __device__ __forceinline__ int lds_byte(int r, int c) { const int st = (r >> 4) * 2 + (c >> 5), rr = r & 15, cc = c & 31, ob = rr * 64 + cc * 2; return st * 1024 + (ob ^ (((ob >> 9) & 1) << 5)); }
__host__ __device__ __forceinline__ void stage_rc(int b, int& R, int& C) { const int st = b / 1024, sb = b % 1024, swz = sb ^ (((sb >> 9) & 1) << 5); R = (st >> 1) * 16 + swz / 64; C = (st & 1) * 32 + (swz % 64) / 2; }
__host__ __device__ __forceinline__ int perm32(int rho) { const int n = rho >> 4, i = rho & 15; return 8 * (i >> 2) + 4 * n + (i & 3); }

struct Unit { int pm, pn; };
struct Gemm { const bf16_t* A; const bf16_t* Bt; int M, N, K; };

struct StaticOrder {
    int nM, nN, nwg, G, c;
    __host__ __device__ void init(int M, int N, int G_, int c_) { nM = M / BM; nN = N / BM; nwg = nM * nN; G = G_; c = c_; }
    __host__ __device__ bool next(int i, Unit& u) const {
        const long L = (long)i * G + c; if (L >= nwg) return false;
        int wgid = (int)L; { const int q = nwg / NXCD, r = nwg % NXCD, xcd = wgid % NXCD, off = wgid / NXCD; wgid = (xcd < r ? xcd * (q + 1) : r * (q + 1) + (xcd - r) * q) + off; }
        const int nig = WGM * nN, gid = wgid / nig, fm = gid * WGM, gsz = (nM - fm) < WGM ? (nM - fm) : WGM;
        u.pm = fm + ((wgid % nig) % gsz); u.pn = (wgid % nig) / gsz; return true;
    }
    __device__ __forceinline__ void a_ready(const Unit&) const {}
    __device__ __forceinline__ void done(const Unit&) const {}
};

__device__ __forceinline__ unsigned cvt_pk_bf16(float lo, float hi) { unsigned r; asm volatile("v_cvt_pk_bf16_f32 %0, %1, %2" : "=v"(r) : "v"(lo), "v"(hi)); return r; }
typedef float f32x2 __attribute__((ext_vector_type(2)));
__device__ __forceinline__ f32x2 gelu_pk(f32x2 v) {
    const f32x2 av = __builtin_elementwise_abs(v), d = av * 0.2316418882f + 1.0f;
    f32x2 t; t.x = __builtin_amdgcn_rcpf(d.x); t.y = __builtin_amdgcn_rcpf(d.y);
    f32x2 q = t * 0.5307027145f + (-0.7265760135f); q = q * t + 0.7107068705f; q = q * t + (-0.142248368f); q = q * t + 0.127414796f; q = q * t;
    const f32x2 s = (v * v) * (-0.72134752044f);
    f32x2 e; e.x = __builtin_amdgcn_exp2f(s.x); e.y = __builtin_amdgcn_exp2f(s.y);
    const f32x2 m = v * (q * e), r = v - m;
    f32x2 o; o.x = v.x < 0.f ? m.x : r.x; o.y = v.y < 0.f ? m.y : r.y; return o;
}

typedef float f32x2_t __attribute__((ext_vector_type(2))); typedef __bf16 bf16x2_t __attribute__((ext_vector_type(2)));
__device__ __forceinline__ unsigned cvtpk(float lo, float hi) { f32x2_t v = {lo, hi}; bf16x2_t b = __builtin_convertvector(v, bf16x2_t); return __builtin_bit_cast(unsigned, b); }
__device__ __forceinline__ u32x4 pack8(f32x4 a, f32x4 b) { u32x4 w; w.x = cvtpk(a[0], a[1]); w.y = cvtpk(a[2], a[3]); w.z = cvtpk(b[0], b[1]); w.w = cvtpk(b[2], b[3]); return w; }
__device__ __forceinline__ void unpack8(u32x4 w, f32x4& a, f32x4& b) {
    a[0] = __uint_as_float(w.x << 16); a[1] = __uint_as_float(w.x & 0xffff0000u); a[2] = __uint_as_float(w.y << 16); a[3] = __uint_as_float(w.y & 0xffff0000u);
    b[0] = __uint_as_float(w.z << 16); b[1] = __uint_as_float(w.z & 0xffff0000u); b[2] = __uint_as_float(w.w << 16); b[3] = __uint_as_float(w.w & 0xffff0000u); }
__device__ __forceinline__ float sigm(float x) { return __builtin_amdgcn_rcpf(1.0f + __builtin_amdgcn_exp2f(-1.4426950408889634f * x)); }
__device__ __forceinline__ f32x4 sigm4(f32x4 v) { f32x4 o; o[0] = sigm(v[0]); o[1] = sigm(v[1]); o[2] = sigm(v[2]); o[3] = sigm(v[3]); return o; }
__device__ __forceinline__ f32x4 gelu4(f32x4 v) { f32x2 a = gelu_pk((f32x2){v[0], v[1]}), b = gelu_pk((f32x2){v[2], v[3]}); return (f32x4){a.x, a.y, b.x, b.y}; }
__device__ __forceinline__ float row_rstd(const float* S, int row) {
    const f32x4* p = (const f32x4*)(S + (size_t)row * 16); const f32x4 s = (p[0] + p[1]) + (p[2] + p[3]);
    return rsqrtf(((s[0] + s[1]) + (s[2] + s[3])) * (1.0f / 1024.0f) + 1e-6f); }
constexpr float QSCALE = 0.125f * 1.4426950408889634f;
struct Epi {
    static constexpr bool PERM = true, AFTER_DRAIN = false;
    int mode; bf16_t* Ob; int ldo; float* Of; int ldf; const float* Fin; int ldi; const bf16_t* G; const float* S; float* Sn; const bf16_t* T16; const bf16_t* Xin;
    __device__ __forceinline__ void operator()(const f32x4 (&acc)[2][2][4][2], const Unit& u, int wr, int wc, int fr, int fq) const {
        const int row0 = u.pm * BM + wr * 64 + fr, col0 = u.pn * BM + wc * 32 + 8 * fq;
        if (mode == 1) {
            const int sec = u.pm >> 2; f32x4 rc[2][2];
            { const int lane_ = fq * 16 + fr; const float mine = row_rstd(S, col0 + (fr >> 3) * HALF + (fr & 7));
#pragma unroll
              for (int bj = 0; bj < 2; ++bj)
#pragma unroll
                  for (int n = 0; n < 2; ++n)
#pragma unroll
                      for (int j = 0; j < 4; ++j) rc[bj][n][j] = __shfl(mine, (lane_ & 48) + bj * 8 + n * 4 + j); }
#pragma unroll
            for (int ai = 0; ai < 2; ++ai)
#pragma unroll
                for (int m = 0; m < 4; ++m) { const int row = row0 + ai * HALF + m * 16;
#pragma unroll
                    for (int bj = 0; bj < 2; ++bj) { f32x4 v0 = acc[ai][bj][m][0] * rc[bj][0], v1 = acc[ai][bj][m][1] * rc[bj][1];
                        if (sec == 0) { v0 = gelu4(v0); v1 = gelu4(v1); }
                        *(u32x4*)(Ob + (size_t)row * ldo + col0 + bj * HALF) = pack8(v0, v1); }
                    if (m & 1) asm volatile("" ::: "memory"); }
            return;
        }
        const int sec = u.pn >> 2;
        if (mode == 0 || mode == 5) {
#pragma unroll
            for (int ai = 0; ai < 2; ++ai) {
                float rsr[4];
#pragma unroll
                for (int m = 0; m < 4; ++m) { const f32x4 p = ((const f32x4*)(S + (size_t)(row0 + ai * HALF + m * 16) * 16))[fq]; float s_ = (p[0] + p[1]) + (p[2] + p[3]);
                    s_ += __shfl_xor(s_, 16); s_ += __shfl_xor(s_, 32); rsr[m] = rsqrtf(s_ * (1.0f / 1024.0f) + 1e-6f); }
#pragma unroll
                for (int m = 0; m < 4; ++m) { const int row = row0 + ai * HALF + m * 16; const float rs = rsr[m];
#pragma unroll
                    for (int bj = 0; bj < 2; ++bj) { const int col = col0 + bj * HALF; f32x4 v0 = acc[ai][bj][m][0] * rs, v1 = acc[ai][bj][m][1] * rs;
                        if (mode == 0) {
                            if (sec == 0) { v0 = gelu4(v0); v1 = gelu4(v1); }
                            else if (sec == 1 || sec == 4) { v0 = v0 * sigm4(v0); v1 = v1 * sigm4(v1); }
                            else if (sec == 2) { v0 = v0 * QSCALE; v1 = v1 * QSCALE; }
                            else if (sec >= 5) { v0 = sigm4(v0); v1 = sigm4(v1); }
                            *(u32x4*)(Ob + (size_t)row * ldo + col) = pack8(v0, v1);
                        } else { *(u32x4*)(Ob + (size_t)row * ldo + col) = pack8(sigm4(v0), sigm4(v1)); } }
                    asm volatile("" ::: "memory"); }
            }
            return;
        }
#pragma unroll
        for (int ai = 0; ai < 2; ++ai)
#pragma unroll
            for (int mh = 0; mh < 2; ++mh) {
                u32x4 gq[2][2], tq[2][2], xq[2][2]; f32x4 ta[2][2][2];
#pragma unroll
                for (int mm = 0; mm < 2; ++mm)
#pragma unroll
                    for (int bj = 0; bj < 2; ++bj) { const int row = row0 + ai * HALF + (2 * mh + mm) * 16, col = col0 + bj * HALF;
                        if (mode == 2 || mode == 3) gq[mm][bj] = *(const u32x4*)(G + (size_t)row * 7168 + col);
                        if (mode == 4 && Fin) { const float* t = Fin + (size_t)row * ldi + col; ta[mm][bj][0] = *(const f32x4*)t; ta[mm][bj][1] = *(const f32x4*)(t + 4); }
                        if ((mode == 4 && !Fin) || mode == 6) xq[mm][bj] = *(const u32x4*)(Xin + (size_t)row * 1024 + col);
                        if (mode == 3 || mode == 6) tq[mm][bj] = *(const u32x4*)(T16 + (size_t)row * 7168 + col);
                    }
#pragma unroll
                for (int mm = 0; mm < 2; ++mm) { const int m = 2 * mh + mm; const int row = row0 + ai * HALF + m * 16; float ss = 0.f;
#pragma unroll
                    for (int bj = 0; bj < 2; ++bj) { const int col = col0 + bj * HALF; f32x4 v0 = acc[ai][bj][m][0], v1 = acc[ai][bj][m][1];
                        if (mode == 2) { f32x4 g0, g1; unpack8(gq[mm][bj], g0, g1); *(u32x4*)(Ob + (size_t)row * ldo + col) = pack8(v0 * g0, v1 * g1); }
                        else if (mode == 3) { f32x4 g0, g1, t0, t1; unpack8(gq[mm][bj], g0, g1); unpack8(tq[mm][bj], t0, t1); v0 = t0 + v0 * g0; v1 = t1 + v1 * g1; *(u32x4*)(Ob + (size_t)row * ldo + col) = pack8(v0, v1); }
                        else { if (mode == 4) { if (Fin) { v0 = ta[mm][bj][0] + v0; v1 = ta[mm][bj][1] + v1; } else { f32x4 x0, x1; unpack8(xq[mm][bj], x0, x1); v0 = x0 + v0; v1 = x1 + v1; } }
                            else { f32x4 t0, t1, x0, x1; unpack8(tq[mm][bj], t0, t1); unpack8(xq[mm][bj], x0, x1); v0 = x0 + v0 * t0; v1 = x1 + v1 * t1; }
                            if (Of) { float* o = Of + (size_t)row * ldf + col; *(f32x4*)o = v0; *(f32x4*)(o + 4) = v1; }
                            *(u32x4*)(Ob + (size_t)row * ldo + col) = pack8(v0, v1);
                            ss += (v0[0] * v0[0] + v0[1] * v0[1]) + (v0[2] * v0[2] + v0[3] * v0[3]) + (v1[0] * v1[0] + v1[1] * v1[1]) + (v1[2] * v1[2] + v1[3] * v1[3]); } }
                    if (mode == 4 || mode == 6) { ss += __shfl_xor(ss, 16); ss += __shfl_xor(ss, 32); if (fq == 0) Sn[(size_t)row * 16 + u.pn * 4 + wc] = ss; } }
                asm volatile("" ::: "memory");
            }
    }
};
template <class Epi, class Sched, bool ALIGN_EPI = false, bool SP2 = false>
__device__ __forceinline__ void gemm_phase(PG8_LAS unsigned char* lds, const Gemm g, const Sched& S, const Epi& E) {
    int tid_ = threadIdx.x; asm volatile("" : "+v"(tid_)); const int tid = tid_, wid = __builtin_amdgcn_readfirstlane(tid >> 6), lane = tid & 63, wr = wid >> 2, wc = wid & 3, fr = lane & 15, fq = lane >> 4;
    int K_ = g.K; asm volatile("" : "+s"(K_)); const int K = K_, nt = K / BK;
    unsigned voffA[2], voffB[2];
#pragma unroll
    for (int i = 0; i < 2; ++i) { int R, C; stage_rc(tid * 16 + i * 8192, R, C); const int Rb = Epi::PERM ? ((R & ~31) + perm32(R & 31)) : R;
        voffA[i] = (unsigned)(R * K + C) * 2u; voffB[i] = (unsigned)(Rb * K + C) * 2u; }
    const size_t kstep = (size_t)(BK * 2);
    const size_t hstep = (size_t)HALF * K * 2;
    const size_t tstep = 2 * hstep;
    const unsigned ldsw = (unsigned)wid * 1024u;
    const int aoff = lds_byte(wr * 64 + fr, fq * 8), boff = lds_byte(wc * 32 + fr, fq * 8);
#define PG8_SA(b, h) (((b) * 2 + (h)) * HTB)
#define PG8_SB(b, h) ((4 + (b) * 2 + (h)) * HTB)
#define PG8_STAGE(bufoff, gbase, voff) do { _Pragma("unroll") for (int _i = 0; _i < 2; ++_i) \
        __builtin_amdgcn_global_load_lds((const unsigned*)((const char*)(gbase) + (voff)[_i]), (PG8_LAS unsigned*)(lds + (bufoff) + ldsw + _i * 8192), 16, 0, 0); } while (0)
#define PG8_LDA(dst, b, h) do { _Pragma("unroll") for (int m = 0; m < 4; ++m) _Pragma("unroll") for (int k = 0; k < 2; ++k) dst[m][k] = *(const PG8_LAS bf16x8*)(lds + PG8_SA(b, h) + aoff + m * 2048 + k * 1024); } while (0)
#define PG8_LDB(dst, b, h) do { _Pragma("unroll") for (int n = 0; n < 2; ++n) _Pragma("unroll") for (int k = 0; k < 2; ++k) dst[n][k] = *(const PG8_LAS bf16x8*)(lds + PG8_SB(b, h) + boff + n * 2048 + k * 1024); } while (0)
#define PG8_MMA(ai, bj, At, Bt) do { __builtin_amdgcn_s_setprio(1); _Pragma("unroll") for (int m = 0; m < 4; ++m) _Pragma("unroll") for (int n = 0; n < 2; ++n) _Pragma("unroll") for (int k = 0; k < 2; ++k) \
        acc[ai][bj][m][n] = __builtin_amdgcn_mfma_f32_16x16x32_bf16(Bt[n][k], At[m][k], acc[ai][bj][m][n], 0, 0, 0); __builtin_amdgcn_s_setprio(0); } while (0)
#define PG8_WAIT_V(n) asm volatile("s_waitcnt vmcnt(" #n ")" ::: "memory")
#define PG8_WAIT_L(n) asm volatile("s_waitcnt lgkmcnt(" #n ")" ::: "memory")
#define PG8_BAR __builtin_amdgcn_s_barrier()
#define PG8_SCHED __builtin_amdgcn_sched_barrier(0)
    Unit cur, nxt; int ui = 0;
    if (!S.next(0, cur)) return;
    f32x4 acc[2][2][4][2];
#pragma unroll
    for (int a = 0; a < 2; ++a)
#pragma unroll
        for (int b = 0; b < 2; ++b)
#pragma unroll
            for (int m = 0; m < 4; ++m)
#pragma unroll
                for (int n = 0; n < 2; ++n) acc[a][b][m][n] = (f32x4){0.f, 0.f, 0.f, 0.f};
    bf16x8 At[4][2], B0[2][2], B1[2][2];
    const char* cA = (const char*)g.A + (size_t)cur.pm * tstep; const char* cB = (const char*)g.Bt + (size_t)cur.pn * tstep;
    S.a_ready(cur);
    if constexpr (SP2) {
        PG8_STAGE(PG8_SB(0, 0), cB, voffB); PG8_STAGE(PG8_SB(0, 1), cB + hstep, voffB); PG8_STAGE(PG8_SA(0, 0), cA, voffA); PG8_STAGE(PG8_SA(0, 1), cA + hstep, voffA);
        if (wr == 1) PG8_BAR;
        PG8_WAIT_V(2); PG8_BAR;
        PG8_STAGE(PG8_SB(1, 0), cB + kstep, voffB); PG8_STAGE(PG8_SA(1, 0), cA + kstep, voffA); PG8_STAGE(PG8_SB(1, 1), cB + hstep + kstep, voffB);
        PG8_WAIT_V(6); PG8_BAR;
    } else {
        PG8_STAGE(PG8_SB(0, 0), cB, voffB); PG8_STAGE(PG8_SA(0, 0), cA, voffA); PG8_STAGE(PG8_SB(0, 1), cB + hstep, voffB); PG8_STAGE(PG8_SA(0, 1), cA + hstep, voffA);
        if (wr == 1) PG8_BAR;
        PG8_WAIT_V(4); PG8_BAR;
        PG8_STAGE(PG8_SB(1, 0), cB + kstep, voffB); PG8_STAGE(PG8_SA(1, 0), cA + kstep, voffA); PG8_STAGE(PG8_SB(1, 1), cB + hstep + kstep, voffB);
        PG8_WAIT_V(6); PG8_BAR;
    }
    for (;;) {
        const bool has_next = S.next(ui + 1, nxt);
        const char* nA = has_next ? (const char*)g.A + (size_t)nxt.pm * tstep : cA; const char* nB = has_next ? (const char*)g.Bt + (size_t)nxt.pn * tstep : cB;
        for (int t = 0; t < nt; t += 2) {
            const bool last = (t == nt - 2);
            const char* a1 = cA + (size_t)(t + 1) * kstep;
            const char* a2 = last ? nA : cA + (size_t)(t + 2) * kstep; const char* b2 = last ? nB : cB + (size_t)(t + 2) * kstep;
            const char* a3 = a2 + kstep; const char* b3 = b2 + kstep;
            if (last && has_next) S.a_ready(nxt);
            if constexpr (SP2) {
            PG8_LDB(B0, 0, 0); PG8_LDB(B1, 0, 1); PG8_SCHED; PG8_LDA(At, 0, 0); PG8_STAGE(PG8_SA(1, 1), a1 + hstep, voffA);
            PG8_WAIT_V(8); PG8_WAIT_L(0); PG8_BAR; PG8_MMA(0, 0, At, B0); PG8_MMA(0, 1, At, B1); PG8_BAR; PG8_SCHED;
            PG8_LDA(At, 0, 1); PG8_STAGE(PG8_SB(0, 0), b2, voffB); PG8_STAGE(PG8_SB(0, 1), b2 + hstep, voffB); PG8_STAGE(PG8_SA(0, 0), a2, voffA);
            PG8_WAIT_V(8); PG8_WAIT_L(0); PG8_BAR; PG8_MMA(1, 0, At, B0); PG8_MMA(1, 1, At, B1); PG8_BAR; PG8_SCHED;
            PG8_LDB(B0, 1, 0); PG8_LDB(B1, 1, 1); PG8_SCHED; PG8_LDA(At, 1, 0); PG8_STAGE(PG8_SA(0, 1), a2 + hstep, voffA);
            PG8_WAIT_V(8); PG8_WAIT_L(0); PG8_BAR; PG8_MMA(0, 0, At, B0); PG8_MMA(0, 1, At, B1); PG8_BAR; PG8_SCHED;
            PG8_LDA(At, 1, 1); PG8_STAGE(PG8_SB(1, 0), b3, voffB); PG8_STAGE(PG8_SB(1, 1), b3 + hstep, voffB); PG8_STAGE(PG8_SA(1, 0), a3, voffA);
            PG8_WAIT_V(8); PG8_WAIT_L(0); PG8_BAR; PG8_MMA(1, 0, At, B0); PG8_MMA(1, 1, At, B1); PG8_BAR; PG8_SCHED;
            } else {
            PG8_LDB(B0, 0, 0); PG8_SCHED; PG8_LDA(At, 0, 0); PG8_STAGE(PG8_SA(1, 1), a1 + hstep, voffA);
            PG8_WAIT_L(8); PG8_BAR; PG8_WAIT_L(0); PG8_MMA(0, 0, At, B0); PG8_BAR; PG8_SCHED;
            PG8_LDB(B1, 0, 1); PG8_STAGE(PG8_SB(0, 0), b2, voffB);
            PG8_BAR; PG8_WAIT_L(0); PG8_MMA(0, 1, At, B1); PG8_BAR;
            PG8_LDA(At, 0, 1); PG8_STAGE(PG8_SA(0, 0), a2, voffA);
            PG8_BAR; PG8_WAIT_L(0); PG8_MMA(1, 0, At, B0); PG8_BAR; PG8_SCHED;
            PG8_STAGE(PG8_SB(0, 1), b2 + hstep, voffB);
            PG8_WAIT_V(6); PG8_BAR; PG8_MMA(1, 1, At, B1); PG8_BAR;
            PG8_LDB(B0, 1, 0); PG8_SCHED; PG8_LDA(At, 1, 0); PG8_STAGE(PG8_SA(0, 1), a2 + hstep, voffA);
            PG8_WAIT_L(8); PG8_BAR; PG8_WAIT_L(0); PG8_MMA(0, 0, At, B0); PG8_BAR; PG8_SCHED;
            PG8_LDB(B1, 1, 1); PG8_STAGE(PG8_SB(1, 0), b3, voffB);
            PG8_BAR; PG8_WAIT_L(0); PG8_MMA(0, 1, At, B1); PG8_BAR;
            PG8_LDA(At, 1, 1); PG8_STAGE(PG8_SA(1, 0), a3, voffA);
            PG8_BAR; PG8_WAIT_L(0); PG8_MMA(1, 0, At, B0); PG8_BAR; PG8_SCHED;
            PG8_STAGE(PG8_SB(1, 1), b3 + hstep, voffB);
            PG8_WAIT_V(6); PG8_BAR; PG8_MMA(1, 1, At, B1); PG8_BAR;
            }
        }
        if constexpr (ALIGN_EPI) { if (wr == 0) PG8_BAR; }
        if constexpr (!Epi::AFTER_DRAIN) { E(acc, cur, wr, wc, fr, fq); S.done(cur); }
        if (!has_next) break;
#pragma unroll
        for (int a = 0; a < 2; ++a)
#pragma unroll
            for (int b = 0; b < 2; ++b)
#pragma unroll
                for (int m = 0; m < 4; ++m)
#pragma unroll
                    for (int n = 0; n < 2; ++n) acc[a][b][m][n] = (f32x4){0.f, 0.f, 0.f, 0.f};
        cur = nxt; cA = nA; cB = nB; ++ui;
        if constexpr (ALIGN_EPI) { if (wr == 1) PG8_BAR; }
    }
    PG8_WAIT_V(0);
    if constexpr (!ALIGN_EPI) { if (wr == 0) PG8_BAR; }
    PG8_BAR;
    if constexpr (Epi::AFTER_DRAIN) { E.fused(acc, cur, wr, wc, fr, fq, lds, wid, lane); S.done(cur); }
#undef PG8_SA
#undef PG8_SB
#undef PG8_STAGE
#undef PG8_LDA
#undef PG8_LDB
#undef PG8_MMA
#undef PG8_WAIT_V
#undef PG8_WAIT_L
#undef PG8_BAR
#undef PG8_SCHED
}
}

#define LAS __attribute__((address_space(3)))
typedef unsigned short bf16_t;
typedef short bf16x8 __attribute__((ext_vector_type(8)));
typedef float f32x4 __attribute__((ext_vector_type(4)));
typedef float f32x16 __attribute__((ext_vector_type(16)));
typedef unsigned u32x4 __attribute__((ext_vector_type(4)));
typedef unsigned u32x2 __attribute__((ext_vector_type(2)));
using pg8::cvtpk; using pg8::pack8; using pg8::unpack8;
constexpr int NTHREADS = 512, NWAVES = 8;
constexpr int MH = 16384, DM = 1024, SEQ = 4096, NB_H = 4, NLAYER = 4, NP1 = 7168, NV2 = 2048, PLE = 256, NHEAD = 8;
constexpr size_t MiB = 1u << 20;
constexpr size_t LW_IN = 0, LW_A = (size_t)9216 * 1024, LW_B = LW_A + 1048576, LW_O = LW_B + 1048576, LW_G = LW_O + 1048576, LW_P = LW_G + 1048576, LW_TOTAL = LW_P + 262144;
constexpr size_t WS_W = 1 * MiB, WS_PROJ = 108 * MiB, WS_VT2 = 332 * MiB, WS_X0 = 396 * MiB, WS_X1 = 428 * MiB, WS_BRA = 460 * MiB, WS_BRB = 492 * MiB, WS_PB = 524 * MiB, WS_S0 = 532 * MiB, WS_S1 = 533 * MiB, WS_END = 534 * MiB;
static_assert(WS_W + LW_TOTAL * 2 * NLAYER <= WS_PROJ, "weights fit");
constexpr int TMP_LD = NP1 / 2;
constexpr int LDS_BYTES = 147456;
constexpr float EPS = 1e-6f;

struct Args {
    const float *x, *p, *norm_g, *w_in, *a_ln_g, *a_ln_b, *a_ws, *a_bs, *lam_q, *lam_k, *subln_g, *w_a_out, *w_b_out, *w_o, *ple_norm_g, *w_ple, *w_ple_gate, *final_g;
    float* out; unsigned char* ws;
};

__device__ __forceinline__ float wave_sum(float v) {
#pragma unroll
    for (int o = 1; o < 64; o <<= 1) v += __shfl_xor(v, o);
    return v;
}
#define LDS_WAIT() asm volatile("s_waitcnt lgkmcnt(0)" ::: "memory")

__device__ __forceinline__ void tr_item(const float* W, int K, int N, const float* scale, bf16_t* WT, int dst_row0, LAS float* scr, int k0, int n0, int lane) {
#pragma unroll 8
    for (int i = 0; i < 32; ++i) { const int kk = 2 * i + (lane >> 5); float v = W[(size_t)(k0 + kk) * N + n0 + (lane & 31)]; if (scale) v *= scale[k0 + kk]; scr[kk * 33 + (lane & 31)] = v; }
    LDS_WAIT(); asm volatile("" ::: "memory");
    const int c = lane & 7;
#pragma unroll
    for (int j = 0; j < 4; ++j) { const int n = (lane >> 3) + 8 * j; const LAS float* s = scr + (8 * c) * 33 + n;
        u32x4 o; o.x = cvtpk(s[0 * 33], s[1 * 33]); o.y = cvtpk(s[2 * 33], s[3 * 33]); o.z = cvtpk(s[4 * 33], s[5 * 33]); o.w = cvtpk(s[6 * 33], s[7 * 33]);
        *(u32x4*)(WT + (size_t)(dst_row0 + n) * K + k0 + 8 * c) = o; }
    LDS_WAIT(); asm volatile("" ::: "memory");
}
typedef const __attribute__((address_space(4))) Args* cargs_t;
__device__ __forceinline__ void weights_prologue(cargs_t ap, LAS unsigned char* lds, int gw, int ngw, int wave, int lane) {
    LAS float* scr = (LAS float*)(lds + wave * 16384);
    bf16_t* WT = (bf16_t*)(ap->ws + WS_W);
    constexpr int I_IN = 16 * 288, I_SQ = 16 * 32, I_P = 4 * 32, I_L = I_IN + 4 * I_SQ + I_P;
    for (int it = gw; it < I_L * NLAYER; it += ngw) {
        const int l = it / I_L; int r = it % I_L; bf16_t* wl = WT + (size_t)l * LW_TOTAL;
        if (r < I_IN) { const int kb = r / 288, nb = r % 288, n0 = nb * 32; const int osec = n0 >> 10;
            const int nsec = (int)((0x654832170ull >> (4 * osec)) & 0xFull);
            tr_item(ap->w_in + (size_t)l * 1024 * 9216, 1024, 9216, ap->norm_g + l * 1024, wl + LW_IN, nsec * 1024 + (n0 & 1023) - 0, scr, kb * 64, n0, lane);
            continue; }
        r -= I_IN;
        if (r < 4 * I_SQ) { const int which = r / I_SQ; const int rr = r % I_SQ; const int kb = rr / 32, nb = rr % 32;
            const float* src = which == 0 ? ap->w_a_out : which == 1 ? ap->w_b_out : which == 2 ? ap->w_o : ap->w_ple_gate;
            const size_t off = which == 0 ? LW_A : which == 1 ? LW_B : which == 2 ? LW_O : LW_G;
            tr_item(src + (size_t)l * 1048576, 1024, 1024, which == 3 ? ap->ple_norm_g + l * 1024 : nullptr, wl + off, nb * 32, scr, kb * 64, nb * 32, lane);
            continue; }
        r -= 4 * I_SQ;
        { const int kb = r / 32, nb = r % 32; tr_item(ap->w_ple + (size_t)l * 262144, 256, 1024, nullptr, wl + LW_P, nb * 32, scr, kb * 64, nb * 32, lane); }
    }
}

__device__ __forceinline__ void init_rows(const float* x, bf16_t* XB, float* S, int gw, int ngw, int lane) {
    asm volatile("" : "+v"(lane)); asm volatile("" : "+s"(gw));
    for (int m = gw; m < MH; m += ngw) {
        const f32x4* xr = (const f32x4*)(x + (size_t)m * DM) + lane; float s = 0.f; f32x4 v[4];
#pragma unroll
        for (int j = 0; j < 4; ++j) { v[j] = xr[64 * j]; s += (v[j][0] * v[j][0] + v[j][1] * v[j][1]) + (v[j][2] * v[j][2] + v[j][3] * v[j][3]); }
        s = wave_sum(s);
        u32x2* o = (u32x2*)(XB + (size_t)m * DM) + lane;
#pragma unroll
        for (int j = 0; j < 4; ++j) { u32x2 w; w.x = cvtpk(v[j][0], v[j][1]); w.y = cvtpk(v[j][2], v[j][3]); o[64 * j] = w; }
        if (lane < 16) S[(size_t)m * 16 + lane] = lane == 0 ? s : 0.f;
    }
}
__device__ __forceinline__ void final_rows(float* out, const float* g, int gw, int ngw, int lane) {
    asm volatile("" : "+v"(lane)); asm volatile("" : "+s"(gw));
    for (int m = gw; m < MH; m += ngw) {
        f32x4* xr = (f32x4*)(out + (size_t)m * DM) + lane; float s = 0.f; f32x4 v[4];
#pragma unroll
        for (int j = 0; j < 4; ++j) { v[j] = xr[64 * j]; s += (v[j][0] * v[j][0] + v[j][1] * v[j][1]) + (v[j][2] * v[j][2] + v[j][3] * v[j][3]); }
        const float rs = rsqrtf(wave_sum(s) * (1.0f / DM) + EPS);
#pragma unroll
        for (int j = 0; j < 4; ++j) { const f32x4 gg = ((const f32x4*)g)[64 * j + lane]; xr[64 * j] = v[j] * rs * gg; }
    }
}
__device__ __forceinline__ void convert_p(const float* p, bf16_t* PB, int gtid, int nthr) {
    asm volatile("" : "+v"(gtid));
    for (int i = gtid; i < MH * PLE / 8; i += nthr) { const f32x4 a = ((const f32x4*)p)[2 * i], b = ((const f32x4*)p)[2 * i + 1]; ((u32x4*)PB)[i] = pack8(a, b); }
}

__device__ __forceinline__ void gmlp_unit(LAS unsigned char* lds, const bf16_t* PROJ, const bf16_t* VT2, bf16_t* BRA, const float* lng, const float* lnb, const float* ws, const float* bs, int c, int gh) {
    int tid_ = threadIdx.x; asm volatile("" : "+v"(tid_)); const int tid = tid_, lane = tid & 63, l32 = lane & 31, hi = lane >> 5; const int w = __builtin_amdgcn_readfirstlane(tid >> 6);
    const int tok0 = c * 128;
    LAS float* red = (LAS float*)lds;
    LAS float* stat = (LAS float*)(lds + 32768);
    LAS unsigned char* T = lds + 34816;
    { const int sc = tid & 15, rg = tid >> 4; float s[8], q[8];
#pragma unroll
      for (int j = 0; j < 8; ++j) { s[j] = 0.f; q[j] = 0.f; }
      for (int i = 0; i < 32; ++i) { const u32x4 wv = *(const u32x4*)(VT2 + (size_t)(rg + 32 * i) * MH + tok0 + sc * 8); f32x4 a, b; unpack8(wv, a, b);
#pragma unroll
          for (int j = 0; j < 4; ++j) { s[j] += a[j]; q[j] += a[j] * a[j]; s[4 + j] += b[j]; q[4 + j] += b[j] * b[j]; } }
#pragma unroll
      for (int j = 0; j < 8; ++j) { red[rg * 256 + sc * 8 + j] = s[j]; red[rg * 256 + 128 + sc * 8 + j] = q[j]; } }
    __syncthreads();
    if (tid < 128) { float s = 0.f, q = 0.f;
        for (int i = 0; i < 32; ++i) { s += red[i * 256 + tid]; q += red[i * 256 + 128 + tid]; }
        const float mean = s * (1.0f / 1024.0f); const float var = q * (1.0f / 1024.0f) - mean * mean;
        stat[2 * tid] = mean; stat[2 * tid + 1] = rsqrtf(var + EPS); }
    __syncthreads();
    const int tb = w & 3, dh = w >> 2;
    for (int gi = 0; gi < 4; ++gi) { const int g = gh * 4 + gi;
#pragma unroll
        for (int i = 0; i < 4; ++i) { const int p = tid + 512 * i, d = p >> 4, sc = p & 15;
            const u32x4 wv = *(const u32x4*)(VT2 + (size_t)(g * 128 + d) * MH + tok0 + sc * 8); f32x4 a, b; unpack8(wv, a, b);
            const float gg = lng[g * 128 + d], bb = lnb[g * 128 + d];
#pragma unroll
            for (int j = 0; j < 4; ++j) { a[j] = (a[j] - stat[2 * (sc * 8 + j)]) * stat[2 * (sc * 8 + j) + 1] * gg + bb; b[j] = (b[j] - stat[2 * (sc * 8 + 4 + j)]) * stat[2 * (sc * 8 + 4 + j) + 1] * gg + bb; }
            *(LAS u32x4*)(T + d * 272 + sc * 16) = pack8(a, b); }
        __syncthreads();
        f32x16 acc0 = {}, acc1 = {};
        const float* wrow = ws + (size_t)g * 16384 + (size_t)(32 * tb + l32) * 128 + 8 * hi;
        const int trow = 32 * tb + l32;
        for (int ks = 0; ks < 2 * tb + 2; ++ks) {
            f32x4 wa = *(const f32x4*)(wrow + 16 * ks), wb = *(const f32x4*)(wrow + 16 * ks + 4); const int s0 = 16 * ks + 8 * hi;
#pragma unroll
            for (int j = 0; j < 4; ++j) { if (s0 + j > trow) wa[j] = 0.f; if (s0 + 4 + j > trow) wb[j] = 0.f; }
            const bf16x8 A = __builtin_bit_cast(bf16x8, pack8(wa, wb));
            const bf16x8 B0 = *(const LAS bf16x8*)(T + (64 * dh + l32) * 272 + (16 * ks + 8 * hi) * 2);
            const bf16x8 B1 = *(const LAS bf16x8*)(T + (64 * dh + 32 + l32) * 272 + (16 * ks + 8 * hi) * 2);
            acc0 = __builtin_amdgcn_mfma_f32_32x32x16_bf16(A, B0, acc0, 0, 0, 0);
            acc1 = __builtin_amdgcn_mfma_f32_32x32x16_bf16(A, B1, acc1, 0, 0, 0);
        }
        LAS float* Yb = (LAS float*)(lds + 71680);
#pragma unroll
        for (int r = 0; r < 16; ++r) { const int t = 32 * tb + (r & 3) + 8 * (r >> 2) + 4 * hi; const float bv = bs[g * 128 + t];
            Yb[t * 132 + 64 * dh + l32] = acc0[r] + bv; Yb[t * 132 + 64 * dh + 32 + l32] = acc1[r] + bv; }
        __syncthreads();
#pragma unroll
        for (int i = 0; i < 4; ++i) { const int p = tid + 512 * i, t = p >> 4, c8 = p & 15; const size_t tok = (size_t)(tok0 + t); const int col = g * 128 + c8 * 8;
            f32x4 u0, u1, z0, z1; unpack8(*(const u32x4*)(PROJ + tok * NP1 + col), u0, u1); unpack8(*(const u32x4*)(PROJ + tok * NP1 + 1024 + col), z0, z1);
            const f32x4 y0 = *(const LAS f32x4*)(Yb + t * 132 + c8 * 8), y1 = *(const LAS f32x4*)(Yb + t * 132 + c8 * 8 + 4);
            *(u32x4*)(BRA + tok * DM + col) = pack8(u0 * y0 * z0, u1 * y1 * z1); }
        __syncthreads();
    }
}

constexpr int AT_KS = 17408, AT_VS = 18432, AT_VOFF = 2 * AT_KS;
__device__ __forceinline__ void attn_unit(LAS unsigned char* lds, const bf16_t* PROJ, const bf16_t* VT2, bf16_t* BRB, const float* subg, float lam, float lam_init, int b, int h, int qb) {
    int tid_ = threadIdx.x; asm volatile("" : "+v"(tid_)); const int tid = tid_, lane = tid & 63, l32 = lane & 31, hi = lane >> 5; const int w = __builtin_amdgcn_readfirstlane(tid >> 6); const int map = w >> 2, wq = w & 3;
    const int rowbase = b * SEQ, q0 = qb * 128, myq = q0 + wq * 32 + l32, NT = 2 * qb + 2;
    bf16x8 qf[4];
    { const bf16_t* qp = PROJ + (size_t)(rowbase + myq) * NP1 + 2048 + h * 128 + map * 64 + hi * 8;
#pragma unroll
      for (int ks = 0; ks < 4; ++ks) qf[ks] = *(const bf16x8*)(qp + ks * 16); }
    const bf16_t* ksrc[2]; const bf16_t* vsrc[2]; int kdst[2], vdst[2];
#pragma unroll
    for (int i = 0; i < 2; ++i) { const int p = tid + 512 * i;
        ksrc[i] = PROJ + (size_t)(rowbase + (p >> 4)) * NP1 + 3072 + h * 128 + (p & 15) * 8; kdst[i] = (p >> 4) * 272 + (p & 15) * 16;
        vsrc[i] = VT2 + (size_t)(1024 + h * 128 + (p >> 3)) * MH + rowbase + (p & 7) * 8; vdst[i] = AT_VOFF + (p >> 3) * 144 + (((p & 7) >> 1) * 16 + (p & 1) * 4) * 2; }
    u32x4 kr[2], vr[2];
#pragma unroll
    for (int i = 0; i < 2; ++i) { kr[i] = *(const u32x4*)(ksrc[i]); vr[i] = *(const u32x4*)(vsrc[i]); }
#pragma unroll
    for (int i = 0; i < 2; ++i) { *(LAS u32x4*)(lds + kdst[i]) = kr[i]; *(LAS u32x2*)(lds + vdst[i]) = (u32x2){vr[i].x, vr[i].y}; *(LAS u32x2*)(lds + vdst[i] + 16) = (u32x2){vr[i].z, vr[i].w}; }
    __syncthreads();
    f32x16 O[4]; O[0] = f32x16{}; O[1] = f32x16{}; O[2] = f32x16{}; O[3] = f32x16{};
    float m_run = -1e30f, l_run = 0.f;
    for (int t = 0; t < NT; ++t) {
        const int buf = t & 1, kv0 = 64 * t;
        if (t + 1 < NT) {
#pragma unroll
            for (int i = 0; i < 2; ++i) { kr[i] = *(const u32x4*)(ksrc[i] + (size_t)(kv0 + 64) * NP1); vr[i] = *(const u32x4*)(vsrc[i] + kv0 + 64); } }
        if (kv0 <= q0 + wq * 32 + 31) {
            LAS unsigned char* Kb = lds + buf * AT_KS + l32 * 272 + map * 128 + hi * 16;
            LAS unsigned char* Vb = lds + AT_VOFF + buf * AT_VS + l32 * 144 + hi * 16;
            f32x16 S0 = {}, S1 = {};
            { bf16x8 kf[8];
#pragma unroll
              for (int ks = 0; ks < 4; ++ks) { kf[2 * ks] = *(const LAS bf16x8*)(Kb + ks * 32); kf[2 * ks + 1] = *(const LAS bf16x8*)(Kb + 32 * 272 + ks * 32); }
              __builtin_amdgcn_sched_barrier(0);
#pragma unroll
              for (int ks = 0; ks < 4; ++ks) { S0 = __builtin_amdgcn_mfma_f32_32x32x16_bf16(kf[2 * ks], qf[ks], S0, 0, 0, 0); S1 = __builtin_amdgcn_mfma_f32_32x32x16_bf16(kf[2 * ks + 1], qf[ks], S1, 0, 0, 0); } }
            u32x4 va[8], vb[8];
#pragma unroll
            for (int j = 0; j < 2; ++j)
#pragma unroll
                for (int db = 0; db < 4; ++db) va[j * 4 + db] = *(const LAS u32x4*)(Vb + db * 32 * 144 + j * 32);
            __builtin_amdgcn_sched_barrier(0);
            if (t >= NT - 2) {
#pragma unroll
                for (int r = 0; r < 16; ++r) { const int kv = kv0 + (r & 3) + 8 * (r >> 2) + 4 * hi; if (kv > myq) S0[r] = -1e30f; if (kv + 32 > myq) S1[r] = -1e30f; } }
            float mx = __builtin_fmaxf(__builtin_fmaxf(S0[0], S1[0]), __builtin_fmaxf(S0[1], S1[1]));
#pragma unroll
            for (int r = 2; r < 16; r += 2) { mx = __builtin_fmaxf(__builtin_fmaxf(mx, S0[r]), S1[r]); mx = __builtin_fmaxf(__builtin_fmaxf(mx, S0[r + 1]), S1[r + 1]); }
            mx = fmaxf(mx, __shfl_xor(mx, 32));
            if (__any(mx > m_run)) { const float mnew = fmaxf(m_run, mx), alpha = __builtin_amdgcn_exp2f(m_run - mnew); m_run = mnew; l_run *= alpha;
#pragma unroll
                for (int db = 0; db < 4; ++db)
#pragma unroll
                    for (int r = 0; r < 16; ++r) O[db][r] *= alpha; }
            pg8::f32x2 ps2 = {0.f, 0.f};
#pragma unroll
            for (int r = 0; r < 16; r += 2) { S0[r] = __builtin_amdgcn_exp2f(S0[r] - m_run); S0[r + 1] = __builtin_amdgcn_exp2f(S0[r + 1] - m_run); S1[r] = __builtin_amdgcn_exp2f(S1[r] - m_run); S1[r + 1] = __builtin_amdgcn_exp2f(S1[r + 1] - m_run);
                ps2 += (pg8::f32x2){S0[r], S0[r + 1]}; ps2 += (pg8::f32x2){S1[r], S1[r + 1]}; }
            l_run += ps2.x + ps2.y;
            bf16x8 pf[4];
#pragma unroll
            for (int j = 0; j < 4; ++j) { u32x4 pw;
#pragma unroll
                for (int i = 0; i < 4; ++i) pw[i] = (j < 2) ? cvtpk(S0[8 * (j & 1) + 2 * i], S0[8 * (j & 1) + 2 * i + 1]) : cvtpk(S1[8 * (j & 1) + 2 * i], S1[8 * (j & 1) + 2 * i + 1]);
                pf[j] = __builtin_bit_cast(bf16x8, pw); }
#pragma unroll
            for (int j = 2; j < 4; ++j)
#pragma unroll
                for (int db = 0; db < 4; ++db) vb[(j - 2) * 4 + db] = *(const LAS u32x4*)(Vb + db * 32 * 144 + j * 32);
            __builtin_amdgcn_sched_barrier(0);
#pragma unroll
            for (int j = 0; j < 2; ++j)
#pragma unroll
                for (int db = 0; db < 4; ++db) O[db] = __builtin_amdgcn_mfma_f32_32x32x16_bf16(__builtin_bit_cast(bf16x8, va[j * 4 + db]), pf[j], O[db], 0, 0, 0);
#pragma unroll
            for (int j = 2; j < 4; ++j)
#pragma unroll
                for (int db = 0; db < 4; ++db) O[db] = __builtin_amdgcn_mfma_f32_32x32x16_bf16(__builtin_bit_cast(bf16x8, vb[(j - 2) * 4 + db]), pf[j], O[db], 0, 0, 0);
        }
        if (t + 1 < NT) {
#pragma unroll
            for (int i = 0; i < 2; ++i) { *(LAS u32x4*)(lds + (buf ^ 1) * AT_KS + kdst[i]) = kr[i]; *(LAS u32x2*)(lds + (buf ^ 1) * AT_VS + vdst[i]) = (u32x2){vr[i].x, vr[i].y}; *(LAS u32x2*)(lds + (buf ^ 1) * AT_VS + vdst[i] + 16) = (u32x2){vr[i].z, vr[i].w}; } }
        __syncthreads();
    }
    const float inv = 1.0f / (l_run + __shfl_xor(l_run, 32));
    LAS float* X = (LAS float*)lds + wq * 4096 + lane;
    if (map == 1) { const float sc = -lam * inv;
#pragma unroll
        for (int db = 0; db < 4; ++db)
#pragma unroll
            for (int r = 0; r < 16; ++r) X[(db * 16 + r) * 64] = O[db][r] * sc; }
    __syncthreads();
    if (map == 0) { float ss = 0.f;
#pragma unroll
        for (int db = 0; db < 4; ++db)
#pragma unroll
            for (int r = 0; r < 16; ++r) { const float o = O[db][r] * inv + X[(db * 16 + r) * 64]; O[db][r] = o; ss += o * o; }
        ss += __shfl_xor(ss, 32);
        const float rs = rsqrtf(ss * (1.0f / 128.0f) + EPS) * (1.0f - lam_init);
        const size_t row = (size_t)(rowbase + myq);
#pragma unroll
        for (int db = 0; db < 4; ++db)
#pragma unroll
            for (int rg = 0; rg < 4; ++rg) { const int d = 32 * db + 8 * rg + 4 * hi; const f32x4 gg = *(const f32x4*)(subg + d);
                const u32x2 zw = *(const u32x2*)(PROJ + row * NP1 + 4096 + h * 128 + d);
                const float z0 = __uint_as_float(zw.x << 16), z1 = __uint_as_float(zw.x & 0xffff0000u), z2 = __uint_as_float(zw.y << 16), z3 = __uint_as_float(zw.y & 0xffff0000u);
                u32x2 ow; ow.x = cvtpk(O[db][4 * rg] * rs * gg[0] * z0, O[db][4 * rg + 1] * rs * gg[1] * z1); ow.y = cvtpk(O[db][4 * rg + 2] * rs * gg[2] * z2, O[db][4 * rg + 3] * rs * gg[3] * z3);
                *(u32x2*)(BRB + row * DM + h * 128 + d) = ow; } }
    __syncthreads();
}

#define RLX_AGENT __ATOMIC_RELAXED, __HIP_MEMORY_SCOPE_AGENT
#define XB_TMO      128
#define XB_XCNT(j)  (256  + 64 * (j))
#define XB_XSUB(j)  (1280 + 64 * (j))
#define XB_XGEN(j)  (2304 + 64 * (j))
#define XB_TOP      3328
#define XB_TOPGEN   3392
#define XCD_BAR_WORDS 3456
#define XB_SPIN_CAP (1u << 18)

__device__ __forceinline__ unsigned xb_ld(unsigned* p)              { return __hip_atomic_load(p, __ATOMIC_RELAXED, __HIP_MEMORY_SCOPE_AGENT); }
__device__ __forceinline__ unsigned xb_add(unsigned* p, unsigned v) { return __hip_atomic_fetch_add(p, v, __ATOMIC_RELAXED, __HIP_MEMORY_SCOPE_AGENT); }
__device__ __forceinline__ unsigned xb_xcc_id() { return (unsigned)__builtin_amdgcn_s_getreg((3 << 11) | 20) & 0xFu; }
#define XB_SPIN(cond, bar) do { unsigned _sp = 0; while (cond) { __builtin_amdgcn_s_sleep(1); \
    if ((++_sp & 255u) == 0u) { if (xb_ld(&(bar)[XB_TMO])) break; if (_sp > XB_SPIN_CAP) { atomicAdd(&(bar)[XB_TMO], 1u); break; } } } } while (0)

struct XcdBarrier {
    unsigned* bar; unsigned x;
    volatile LAS unsigned* st;
};

__device__ __forceinline__ XcdBarrier xcd_barrier_post(unsigned* bar, volatile LAS unsigned* st) {
    XcdBarrier b; b.bar = bar; b.x = xb_xcc_id(); b.st = st;
    if (threadIdx.x == 0) (void)xb_add(&bar[XB_XCNT(b.x)], 1u);
    return b;
}
__device__ __forceinline__ void xcd_barrier_complete(unsigned* bar, unsigned x, unsigned& nloc, unsigned& nx) {
    const unsigned G = gridDim.x * gridDim.y * gridDim.z;
    unsigned sum, cnt, mine, sp = 0u;
    for (;;) {
        sum = 0u; cnt = 0u; mine = 0u;
#pragma unroll
        for (unsigned j = 0; j < 16; ++j) { const unsigned c = xb_ld(&bar[XB_XCNT(j)]); sum += c; cnt += (c > 0u) ? 1u : 0u; mine = (j == x) ? c : mine; }
        if (sum == G) break;
        __builtin_amdgcn_s_sleep(1);
        if ((++sp & 255u) == 0u) { if (xb_ld(&bar[XB_TMO])) break; if (sp > XB_SPIN_CAP) { atomicAdd(&bar[XB_TMO], 1u); break; } }
    }
    nloc = mine > 0u ? mine : 1u; nx = cnt > 0u ? cnt : 1u;
}

__device__ __forceinline__ void xcd_barrier(const XcdBarrier& b) {
    asm volatile("s_waitcnt vmcnt(0)" ::: "memory");
    __syncthreads();
    if (threadIdx.x == 0) {
        unsigned* bar = b.bar;
        __builtin_amdgcn_s_waitcnt(0);
        unsigned nloc = b.st[0], nx = b.st[1];
        if (nloc == 0u) { xcd_barrier_complete(bar, b.x, nloc, nx); b.st[0] = nloc; b.st[1] = nx; }
        const unsigned old = xb_add(&bar[XB_XSUB(b.x)], 1u);
        const unsigned gen = old / nloc;
        if (old + 1u == (gen + 1u) * nloc) {
            __builtin_amdgcn_fence(__ATOMIC_RELEASE, "agent");
            asm volatile("s_waitcnt vmcnt(0)" ::: "memory");
            const unsigned og = xb_add(&bar[XB_TOP], 1u);
            const unsigned tg = og / nx;
            if (og + 1u == (tg + 1u) * nx) xb_add(&bar[XB_TOPGEN], 1u);
            else XB_SPIN(xb_ld(&bar[XB_TOPGEN]) == tg, bar);
            __builtin_amdgcn_fence(__ATOMIC_ACQUIRE, "agent");
            xb_add(&bar[XB_XGEN(b.x)], 1u);
            asm volatile("s_waitcnt vmcnt(0)" ::: "memory");
        } else {
            XB_SPIN(xb_ld(&bar[XB_XGEN(b.x)]) == gen, bar);
            __builtin_amdgcn_fence(__ATOMIC_ACQUIRE, "agent");
            asm volatile("s_waitcnt vmcnt(0)" ::: "memory");
        }
    }
    __syncthreads();
}


__global__ void __launch_bounds__(NTHREADS, 2) mega_fwd(Args a_unused) {
    extern __shared__ __attribute__((aligned(16))) unsigned char lds_raw[];
    LAS unsigned char* lds = (LAS unsigned char*)lds_raw;
    cg::grid_group grid = cg::this_grid();
    const int tid = threadIdx.x, lane = tid & 63, wave = __builtin_amdgcn_readfirstlane(tid >> 6);
    const int G = gridDim.x, bx = blockIdx.x;
    const int vcu = (G % 8 == 0) ? (bx % 8) * (G / 8) + bx / 8 : bx;
    const int gw = vcu * NWAVES + wave, ngw = G * NWAVES;
#define ARGS() cargs_t ap = (cargs_t)__builtin_amdgcn_kernarg_segment_ptr(); asm volatile("" : "+s"(ap)); unsigned char* const ws = ap->ws
#define GSYNC() xcd_barrier(xbar)
#define WSP(T, off) ((T*)(ws + (off)))
#define XBP(ci) ((bf16_t*)(ws + ((ci) ? WS_X1 : WS_X0)))
#define SXP(ci) ((float*)(ws + ((ci) ? WS_S1 : WS_S0)))
#define TMPP ((float*)(ws + WS_PROJ + 4096))
    if (tid < 64) ((LAS unsigned*)(lds + 147200))[tid] = 0u;
    __syncthreads();
    grid.sync();
    XcdBarrier xbar;
    { ARGS(); xbar = xcd_barrier_post((unsigned*)ws, (volatile LAS unsigned*)(lds + 147200)); }
    { ARGS(); weights_prologue(ap, lds, gw, ngw, wave, lane); }

#define DUMP_BF16(buf_off, nelem) do { ARGS(); const bf16_t* B_ = WSP(bf16_t, buf_off); float* o_ = ap->out; \
    for (size_t i_ = (size_t)bx * NTHREADS + tid; i_ < (size_t)2 * MH * DM; i_ += (size_t)G * NTHREADS) o_[i_] = __uint_as_float((unsigned)B_[i_ % (size_t)(nelem)] << 16); } while (0)
    for (int hf = 0; hf < 2; ++hf) {
        { ARGS(); init_rows(ap->x + (size_t)hf * MH * DM, XBP(0), SXP(0), gw, ngw, lane); }
        GSYNC();
        int c = 0;
        for (int l = 0; l < NLAYER; ++l) {
            { ARGS(); convert_p(ap->p + ((size_t)l * 2 * MH + (size_t)hf * MH) * PLE, WSP(bf16_t, WS_PB), bx * NTHREADS + tid, G * NTHREADS); }
#if !defined(ONLY) || ONLY == 0
            { ARGS(); const bf16_t* wl = WSP(bf16_t, WS_W) + (size_t)l * LW_TOTAL;
              pg8::Gemm g{XBP(c), wl + LW_IN, MH, NP1, DM}; pg8::StaticOrder S; S.init(MH, NP1, G, bx);
              pg8::Epi E{0, WSP(bf16_t, WS_PROJ), NP1, nullptr, 0, nullptr, 0, nullptr, SXP(c), nullptr, nullptr, nullptr};
              pg8::gemm_phase<pg8::Epi, pg8::StaticOrder, true, true>(lds, g, S, E); }
#endif
#if !defined(ONLY) || ONLY == 1
            { ARGS(); const bf16_t* wl = WSP(bf16_t, WS_W) + (size_t)l * LW_TOTAL;
              pg8::Gemm g{wl + LW_IN + (size_t)NP1 * DM, XBP(c), NV2, MH, DM}; pg8::StaticOrder S; S.init(NV2, MH, G, bx);
              pg8::Epi E{1, WSP(bf16_t, WS_VT2), MH, nullptr, 0, nullptr, 0, nullptr, SXP(c), nullptr, nullptr, nullptr};
              pg8::gemm_phase<pg8::Epi, pg8::StaticOrder, true, true>(lds, g, S, E); }
#endif
            GSYNC();
#if defined(STOP_AFTER) && STOP_AFTER == 1
            DUMP_BF16(WS_PROJ, (size_t)MH * NP1); return;
#endif
#if defined(STOP_AFTER) && STOP_AFTER == 11
            DUMP_BF16(WS_VT2, (size_t)MH * NV2); return;
#endif
#ifndef NO_GMLP
            { ARGS();
              for (int u = vcu; u < 256; u += G)
                gmlp_unit(lds, WSP(bf16_t, WS_PROJ), WSP(bf16_t, WS_VT2), WSP(bf16_t, WS_BRA), ap->a_ln_g + l * 1024, ap->a_ln_b + l * 1024, ap->a_ws + (size_t)l * 131072, ap->a_bs + l * 1024, u >> 1, u & 1); }
#endif
#ifdef NO_ATTN
            { ARGS(); const bf16_t* PR = WSP(bf16_t, WS_PROJ); bf16_t* B = WSP(bf16_t, WS_BRB);
              for (int i = bx * NTHREADS + tid; i < MH * DM / 8; i += G * NTHREADS) { const int row = i >> 7, c8 = i & 127; *(u32x4*)(B + (size_t)row * DM + c8 * 8) = *(const u32x4*)(PR + (size_t)row * NP1 + 4096 + c8 * 8); } }
#endif
#ifdef NO_GMLP
            { ARGS(); const bf16_t* PR = WSP(bf16_t, WS_PROJ); bf16_t* B = WSP(bf16_t, WS_BRA);
              for (int i = bx * NTHREADS + tid; i < MH * DM / 8; i += G * NTHREADS) { const int row = i >> 7, c8 = i & 127; *(u32x4*)(B + (size_t)row * DM + c8 * 8) = *(const u32x4*)(PR + (size_t)row * NP1 + c8 * 8); } }
#endif
#ifndef NO_ATTN
            { ARGS();
              const float lam_init = 0.8f - 0.6f * expf(-0.3f * (float)l);
              const float d0 = wave_sum(ap->lam_q[l * 128 + lane] * ap->lam_k[l * 128 + lane]), d1 = wave_sum(ap->lam_q[l * 128 + 64 + lane] * ap->lam_k[l * 128 + 64 + lane]);
              const float lam = expf(d0) - expf(d1) + lam_init;
              for (int pu = vcu; pu < 512; pu += G) { const int bh = pu >> 4, s = pu & 15;
                  attn_unit(lds, WSP(bf16_t, WS_PROJ), WSP(bf16_t, WS_VT2), WSP(bf16_t, WS_BRB), ap->subln_g + l * 128, lam, lam_init, bh >> 3, bh & 7, 31 - s);
                  attn_unit(lds, WSP(bf16_t, WS_PROJ), WSP(bf16_t, WS_VT2), WSP(bf16_t, WS_BRB), ap->subln_g + l * 128, lam, lam_init, bh >> 3, bh & 7, s); } }
#endif
            GSYNC();
#if !defined(ONLY) || ONLY == 2
            { ARGS(); const bf16_t* wl = WSP(bf16_t, WS_W) + (size_t)l * LW_TOTAL;
              pg8::Gemm g{WSP(bf16_t, WS_BRA), wl + LW_A, MH, DM, DM}; pg8::StaticOrder S; S.init(MH, DM, G, bx);
              pg8::Epi E{2, WSP(bf16_t, WS_PROJ) + 2048, NP1, nullptr, 0, nullptr, 0, WSP(bf16_t, WS_PROJ) + 5120, nullptr, nullptr, nullptr, nullptr};
              pg8::gemm_phase<pg8::Epi, pg8::StaticOrder, true, true>(lds, g, S, E); }
#endif
#if !defined(ONLY) || ONLY == 3
            { ARGS(); const bf16_t* wl = WSP(bf16_t, WS_W) + (size_t)l * LW_TOTAL;
              pg8::Gemm g{WSP(bf16_t, WS_BRB), wl + LW_B, MH, DM, DM}; pg8::StaticOrder S; S.init(MH, DM, G, bx);
              pg8::Epi E{3, XBP(1 - c), DM, nullptr, 0, nullptr, 0, WSP(bf16_t, WS_PROJ) + 6144, nullptr, nullptr, WSP(bf16_t, WS_PROJ) + 2048, nullptr};
              pg8::gemm_phase<pg8::Epi, pg8::StaticOrder, true, true>(lds, g, S, E); }
#endif
            GSYNC();
#if defined(STOP_AFTER) && STOP_AFTER == 3
            if (c == 0) DUMP_BF16(WS_X1, (size_t)MH * DM); else DUMP_BF16(WS_X0, (size_t)MH * DM); return;
#endif
#if !defined(ONLY) || ONLY == 4
            { ARGS(); const bf16_t* wl = WSP(bf16_t, WS_W) + (size_t)l * LW_TOTAL; float* out = ap->out + (size_t)hf * MH * DM;
              pg8::Gemm g{XBP(1 - c), wl + LW_O, MH, DM, DM}; pg8::StaticOrder S; S.init(MH, DM, G, bx);
              pg8::Epi E{4, XBP(c), DM, nullptr, 0, l == 0 ? ap->x + (size_t)hf * MH * DM : (const float*)nullptr, DM, nullptr, nullptr, SXP(c), nullptr, XBP(c)};
              pg8::gemm_phase<pg8::Epi, pg8::StaticOrder, true, true>(lds, g, S, E); }
#endif
            GSYNC();
#if defined(STOP_AFTER) && STOP_AFTER == 4
            if (c == 0) DUMP_BF16(WS_X0, (size_t)MH * DM); else DUMP_BF16(WS_X1, (size_t)MH * DM); return;
#endif
#if !defined(ONLY) || ONLY == 5
            { ARGS(); const bf16_t* wl = WSP(bf16_t, WS_W) + (size_t)l * LW_TOTAL;
              pg8::Gemm g{XBP(c), wl + LW_G, MH, DM, DM}; pg8::StaticOrder S; S.init(MH, DM, G, bx);
              pg8::Epi E{5, WSP(bf16_t, WS_PROJ) + 2048, NP1, nullptr, 0, nullptr, 0, nullptr, SXP(c), nullptr, nullptr, nullptr};
              pg8::gemm_phase<pg8::Epi, pg8::StaticOrder, true, true>(lds, g, S, E); }
#endif
#if !defined(ONLY) || ONLY == 6
            { ARGS(); const bf16_t* wl = WSP(bf16_t, WS_W) + (size_t)l * LW_TOTAL; float* out = ap->out + (size_t)hf * MH * DM;
              pg8::Gemm g{WSP(bf16_t, WS_PB), wl + LW_P, MH, DM, PLE}; pg8::StaticOrder S; S.init(MH, DM, G, bx);
              pg8::Epi E{6, XBP(1 - c), DM, l == NLAYER - 1 ? out : (float*)nullptr, DM, nullptr, 0, nullptr, nullptr, SXP(1 - c), WSP(bf16_t, WS_PROJ) + 2048, XBP(c)};
              pg8::gemm_phase<pg8::Epi, pg8::StaticOrder, true, true>(lds, g, S, E); }
#endif
            GSYNC();
#if defined(STOP_AFTER) && STOP_AFTER == 5
            if (c == 0) DUMP_BF16(WS_X1, (size_t)MH * DM); else DUMP_BF16(WS_X0, (size_t)MH * DM); return;
#endif
            c ^= 1;
        }
        { ARGS(); final_rows(ap->out + (size_t)hf * MH * DM, ap->final_g, gw, ngw, lane); }
    }
}

extern "C" void kernel_launch(void* const* d_in, const int* in_sizes, int n_in, void* d_out, int out_size, void* d_ws, size_t ws_size, hipStream_t stream) {
    static int grid = 0;
    if (grid == 0) {
        if (n_in != 18 || ws_size < WS_END) { fprintf(stderr, "kernel_launch: unexpected n_in %d / ws_size %zu (need %zu)\n", n_in, ws_size, (size_t)WS_END); grid = -1; return; }
        int dev = 0, cus = 0, per_cu = 0;
        hipGetDevice(&dev); hipDeviceGetAttribute(&cus, hipDeviceAttributeMultiprocessorCount, dev);
        if (hipFuncSetAttribute((const void*)mega_fwd, hipFuncAttributeMaxDynamicSharedMemorySize, LDS_BYTES) != hipSuccess) { fprintf(stderr, "kernel_launch: hipFuncSetAttribute failed\n"); grid = -1; return; }
        if (hipOccupancyMaxActiveBlocksPerMultiprocessor(&per_cu, (const void*)mega_fwd, NTHREADS, LDS_BYTES) != hipSuccess || per_cu < 1) { fprintf(stderr, "kernel_launch: occupancy query gives %d\n", per_cu); per_cu = 1; }
        (void)hipGetLastError();
        grid = cus;
    }
    if (grid < 0) return;
    if (hipMemsetAsync(d_ws, 0, 16384, stream) != hipSuccess) { fprintf(stderr, "kernel_launch: memset failed\n"); return; }
    Args a{};
    const float** f = (const float**)&a;
    for (int i = 0; i < 18; ++i) f[i] = (const float*)d_in[i];
    a.out = (float*)d_out; a.ws = (unsigned char*)d_ws;
    void* args[] = {&a};
    hipError_t e = hipLaunchCooperativeKernel((const void*)mega_fwd, dim3(grid), dim3(NTHREADS), args, LDS_BYTES, stream);
    if (e != hipSuccess) fprintf(stderr, "cooperative launch failed: %s (grid %d)\n", hipGetErrorString(e), grid);
}
```

```cpp
#include <hip/hip_runtime.h>
#include <hip/hip_cooperative_groups.h>
#include <cstdio>
#include <cstdint>
namespace cg = cooperative_groups;
namespace pg8 {
#define PG8_LAS __attribute__((address_space(3)))
typedef unsigned short bf16_t;
typedef short bf16x8 __attribute__((ext_vector_type(8)));
typedef float f32x4 __attribute__((ext_vector_type(4)));
typedef unsigned u32x4 __attribute__((ext_vector_type(4)));
constexpr int BM = 256, BK = 64, HALF = 128, HTB = HALF * BK * 2  , STAGE_BYTES = 8 * HTB, NXCD = 8, WGM = 8;

__host__ __device__ __forceinline__ int lds_byte(int r, int c) { const int st = (r >> 4) * 2 + (c >> 5), rr = r & 15, cc = c & 31, ob = rr * 64 + cc * 2; return st * 1024 + (ob ^ (((ob >> 9) & 1) << 5)); }
__host__ __device__ __forceinline__ void stage_rc(int b, int& R, int& C) { const int st = b / 1024, sb = b % 1024, swz = sb ^ (((sb >> 9) & 1) << 5); R = (st >> 1) * 16 + swz / 64; C = (st & 1) * 32 + (swz % 64) / 2; }
__host__ __device__ __forceinline__ int perm32(int rho) { const int n = rho >> 4, i = rho & 15; return 8 * (i >> 2) + 4 * n + (i & 3); }

struct Unit { int pm, pn; };
struct Gemm { const bf16_t* A; const bf16_t* Bt; int M, N, K; };

struct StaticOrder {
    int nM, nN, nwg, G, c;
    __host__ __device__ void init(int M, int N, int G_, int c_) { nM = M / BM; nN = N / BM; nwg = nM * nN; G = G_; c = c_; }
    __host__ __device__ bool next(int i, Unit& u) const {
        const long L = (long)i * G + c; if (L >= nwg) return false;
        int wgid = (int)L; { const int q = nwg / NXCD, r = nwg % NXCD, xcd = wgid % NXCD, off = wgid / NXCD; wgid = (xcd < r ? xcd * (q + 1) : r * (q + 1) + (xcd - r) * q) + off; }
        const int nig = WGM * nN, gid = wgid / nig, fm = gid * WGM, gsz = (nM - fm) < WGM ? (nM - fm) : WGM;
        u.pm = fm + ((wgid % nig) % gsz); u.pn = (wgid % nig) / gsz; return true;
    }
    __device__ __forceinline__ void a_ready(const Unit&) const {}
    __device__ __forceinline__ void done(const Unit&) const {}
};

__device__ __forceinline__ unsigned cvt_pk_bf16(float lo, float hi) { unsigned r; asm volatile("v_cvt_pk_bf16_f32 %0, %1, %2" : "=v"(r) : "v"(lo), "v"(hi)); return r; }
typedef float f32x2 __attribute__((ext_vector_type(2)));
__device__ __forceinline__ f32x2 gelu_pk(f32x2 v) {
    const f32x2 av = __builtin_elementwise_abs(v), d = av * 0.2316418882f + 1.0f;
    f32x2 t; t.x = __builtin_amdgcn_rcpf(d.x); t.y = __builtin_amdgcn_rcpf(d.y);
    f32x2 q = t * 0.5307027145f + (-0.7265760135f); q = q * t + 0.7107068705f; q = q * t + (-0.142248368f); q = q * t + 0.127414796f; q = q * t;
    const f32x2 s = (v * v) * (-0.72134752044f);
    f32x2 e; e.x = __builtin_amdgcn_exp2f(s.x); e.y = __builtin_amdgcn_exp2f(s.y);
    const f32x2 m = v * (q * e), r = v - m;
    f32x2 o; o.x = v.x < 0.f ? m.x : r.x; o.y = v.y < 0.f ? m.y : r.y; return o;
}

typedef float f32x2_t __attribute__((ext_vector_type(2))); typedef __bf16 bf16x2_t __attribute__((ext_vector_type(2)));
__device__ __forceinline__ unsigned cvtpk(float lo, float hi) { f32x2_t v = {lo, hi}; bf16x2_t b = __builtin_convertvector(v, bf16x2_t); return __builtin_bit_cast(unsigned, b); }
__device__ __forceinline__ u32x4 pack8(f32x4 a, f32x4 b) { u32x4 w; w.x = cvtpk(a[0], a[1]); w.y = cvtpk(a[2], a[3]); w.z = cvtpk(b[0], b[1]); w.w = cvtpk(b[2], b[3]); return w; }
__device__ __forceinline__ void unpack8(u32x4 w, f32x4& a, f32x4& b) {
    a[0] = __uint_as_float(w.x << 16); a[1] = __uint_as_float(w.x & 0xffff0000u); a[2] = __uint_as_float(w.y << 16); a[3] = __uint_as_float(w.y & 0xffff0000u);
    b[0] = __uint_as_float(w.z << 16); b[1] = __uint_as_float(w.z & 0xffff0000u); b[2] = __uint_as_float(w.w << 16); b[3] = __uint_as_float(w.w & 0xffff0000u); }
__device__ __forceinline__ float sigm(float x) { return __builtin_amdgcn_rcpf(1.0f + __builtin_amdgcn_exp2f(-1.4426950408889634f * x)); }
__device__ __forceinline__ f32x4 sigm4(f32x4 v) { f32x4 o; o[0] = sigm(v[0]); o[1] = sigm(v[1]); o[2] = sigm(v[2]); o[3] = sigm(v[3]); return o; }
__device__ __forceinline__ f32x4 gelu4(f32x4 v) { f32x2 a = gelu_pk((f32x2){v[0], v[1]}), b = gelu_pk((f32x2){v[2], v[3]}); return (f32x4){a.x, a.y, b.x, b.y}; }
__device__ __forceinline__ float row_rstd(const float* S, int row) {
    const f32x4* p = (const f32x4*)(S + (size_t)row * 16); const f32x4 s = (p[0] + p[1]) + (p[2] + p[3]);
    return rsqrtf(((s[0] + s[1]) + (s[2] + s[3])) * (1.0f / 1024.0f) + 1e-6f); }
constexpr float QSCALE = 0.125f * 1.4426950408889634f;
struct Epi {
    static constexpr bool PERM = true, AFTER_DRAIN = false;
    int mode; bf16_t* Ob; int ldo; float* Of; int ldf; const float* Fin; int ldi; const bf16_t* G; const float* S; float* Sn; const bf16_t* T16; const bf16_t* Xin;
    __device__ __forceinline__ void operator()(const f32x4 (&acc)[2][2][4][2], const Unit& u, int wr, int wc, int fr, int fq) const {
        const int row0 = u.pm * BM + wr * 64 + fr, col0 = u.pn * BM + wc * 32 + 8 * fq;
        if (mode == 1) {
            const int sec = u.pm >> 2; f32x4 rc[2][2];
            { const int lane_ = fq * 16 + fr; const float mine = row_rstd(S, col0 + (fr >> 3) * HALF + (fr & 7));
#pragma unroll
              for (int bj = 0; bj < 2; ++bj)
#pragma unroll
                  for (int n = 0; n < 2; ++n)
#pragma unroll
                      for (int j = 0; j < 4; ++j) rc[bj][n][j] = __shfl(mine, (lane_ & 48) + bj * 8 + n * 4 + j); }
#pragma unroll
            for (int ai = 0; ai < 2; ++ai)
#pragma unroll
                for (int m = 0; m < 4; ++m) { const int row = row0 + ai * HALF + m * 16;
#pragma unroll
                    for (int bj = 0; bj < 2; ++bj) { f32x4 v0 = acc[ai][bj][m][0] * rc[bj][0], v1 = acc[ai][bj][m][1] * rc[bj][1];
                        if (sec == 0) { v0 = gelu4(v0); v1 = gelu4(v1); }
                        *(u32x4*)(Ob + (size_t)row * ldo + col0 + bj * HALF) = pack8(v0, v1); }
                    if (m & 1) asm volatile("" ::: "memory"); }
            return;
        }
        const int sec = u.pn >> 2;
        if (mode == 0 || mode == 5) {
#pragma unroll
            for (int ai = 0; ai < 2; ++ai) {
                float rsr[4];
#pragma unroll
                for (int m = 0; m < 4; ++m) { const f32x4 p = ((const f32x4*)(S + (size_t)(row0 + ai * HALF + m * 16) * 16))[fq]; float s_ = (p[0] + p[1]) + (p[2] + p[3]);
                    s_ += __shfl_xor(s_, 16); s_ += __shfl_xor(s_, 32); rsr[m] = rsqrtf(s_ * (1.0f / 1024.0f) + 1e-6f); }
#pragma unroll
                for (int m = 0; m < 4; ++m) { const int row = row0 + ai * HALF + m * 16; const float rs = rsr[m];
#pragma unroll
                    for (int bj = 0; bj < 2; ++bj) { const int col = col0 + bj * HALF; f32x4 v0 = acc[ai][bj][m][0] * rs, v1 = acc[ai][bj][m][1] * rs;
                        if (mode == 0) {
                            if (sec == 0) { v0 = gelu4(v0); v1 = gelu4(v1); }
                            else if (sec == 1 || sec == 4) { v0 = v0 * sigm4(v0); v1 = v1 * sigm4(v1); }
                            else if (sec == 2) { v0 = v0 * QSCALE; v1 = v1 * QSCALE; }
                            else if (sec >= 5) { v0 = sigm4(v0); v1 = sigm4(v1); }
                            *(u32x4*)(Ob + (size_t)row * ldo + col) = pack8(v0, v1);
                        } else { *(u32x4*)(Ob + (size_t)row * ldo + col) = pack8(sigm4(v0), sigm4(v1)); } }
                    asm volatile("" ::: "memory"); }
            }
            return;
        }
#pragma unroll
        for (int ai = 0; ai < 2; ++ai)
#pragma unroll
            for (int mh = 0; mh < 2; ++mh) {
                u32x4 gq[2][2], tq[2][2], xq[2][2]; f32x4 ta[2][2][2];
#pragma unroll
                for (int mm = 0; mm < 2; ++mm)
#pragma unroll
                    for (int bj = 0; bj < 2; ++bj) { const int row = row0 + ai * HALF + (2 * mh + mm) * 16, col = col0 + bj * HALF;
                        if (mode == 2 || mode == 3) gq[mm][bj] = *(const u32x4*)(G + (size_t)row * 7168 + col);
                        if (mode == 4 && Fin) { const float* t = Fin + (size_t)row * ldi + col; ta[mm][bj][0] = *(const f32x4*)t; ta[mm][bj][1] = *(const f32x4*)(t + 4); }
                        if ((mode == 4 && !Fin) || mode == 6) xq[mm][bj] = *(const u32x4*)(Xin + (size_t)row * 1024 + col);
                        if (mode == 3 || mode == 6) tq[mm][bj] = *(const u32x4*)(T16 + (size_t)row * 7168 + col);
                    }
#pragma unroll
                for (int mm = 0; mm < 2; ++mm) { const int m = 2 * mh + mm; const int row = row0 + ai * HALF + m * 16; float ss = 0.f;
#pragma unroll
                    for (int bj = 0; bj < 2; ++bj) { const int col = col0 + bj * HALF; f32x4 v0 = acc[ai][bj][m][0], v1 = acc[ai][bj][m][1];
                        if (mode == 2) { f32x4 g0, g1; unpack8(gq[mm][bj], g0, g1); *(u32x4*)(Ob + (size_t)row * ldo + col) = pack8(v0 * g0, v1 * g1); }
                        else if (mode == 3) { f32x4 g0, g1, t0, t1; unpack8(gq[mm][bj], g0, g1); unpack8(tq[mm][bj], t0, t1); v0 = t0 + v0 * g0; v1 = t1 + v1 * g1; *(u32x4*)(Ob + (size_t)row * ldo + col) = pack8(v0, v1); }
                        else { if (mode == 4) { if (Fin) { v0 = ta[mm][bj][0] + v0; v1 = ta[mm][bj][1] + v1; } else { f32x4 x0, x1; unpack8(xq[mm][bj], x0, x1); v0 = x0 + v0; v1 = x1 + v1; } }
                            else { f32x4 t0, t1, x0, x1; unpack8(tq[mm][bj], t0, t1); unpack8(xq[mm][bj], x0, x1); v0 = x0 + v0 * t0; v1 = x1 + v1 * t1; }
                            if (Of) { float* o = Of + (size_t)row * ldf + col; *(f32x4*)o = v0; *(f32x4*)(o + 4) = v1; }
                            *(u32x4*)(Ob + (size_t)row * ldo + col) = pack8(v0, v1);
                            ss += (v0[0] * v0[0] + v0[1] * v0[1]) + (v0[2] * v0[2] + v0[3] * v0[3]) + (v1[0] * v1[0] + v1[1] * v1[1]) + (v1[2] * v1[2] + v1[3] * v1[3]); } }
                    if (mode == 4 || mode == 6) { ss += __shfl_xor(ss, 16); ss += __shfl_xor(ss, 32); if (fq == 0) Sn[(size_t)row * 16 + u.pn * 4 + wc] = ss; } }
                asm volatile("" ::: "memory");
            }
    }
};
template <class Epi, class Sched, bool ALIGN_EPI = false, bool SP2 = false>
__device__ __forceinline__ void gemm_phase(PG8_LAS unsigned char* lds, const Gemm g, const Sched& S, const Epi& E) {
    int tid_ = threadIdx.x; asm volatile("" : "+v"(tid_)); const int tid = tid_, wid = __builtin_amdgcn_readfirstlane(tid >> 6), lane = tid & 63, wr = wid >> 2, wc = wid & 3, fr = lane & 15, fq = lane >> 4;
    int K_ = g.K; asm volatile("" : "+s"(K_)); const int K = K_, nt = K / BK;
    unsigned voffA[2], voffB[2];
#pragma unroll
    for (int i = 0; i < 2; ++i) { int R, C; stage_rc(tid * 16 + i * 8192, R, C); const int Rb = Epi::PERM ? ((R & ~31) + perm32(R & 31)) : R;
        voffA[i] = (unsigned)(R * K + C) * 2u; voffB[i] = (unsigned)(Rb * K + C) * 2u; }
    const size_t kstep = (size_t)(BK * 2);
    const size_t hstep = (size_t)HALF * K * 2;
    const size_t tstep = 2 * hstep;
    const unsigned ldsw = (unsigned)wid * 1024u;
    const int aoff = lds_byte(wr * 64 + fr, fq * 8), boff = lds_byte(wc * 32 + fr, fq * 8);
#define PG8_SA(b, h) (((b) * 2 + (h)) * HTB)
#define PG8_SB(b, h) ((4 + (b) * 2 + (h)) * HTB)
#define PG8_STAGE(bufoff, gbase, voff) do { _Pragma("unroll") for (int _i = 0; _i < 2; ++_i) \
        __builtin_amdgcn_global_load_lds((const unsigned*)((const char*)(gbase) + (voff)[_i]), (PG8_LAS unsigned*)(lds + (bufoff) + ldsw + _i * 8192), 16, 0, 0); } while (0)
#define PG8_LDA(dst, b, h) do { _Pragma("unroll") for (int m = 0; m < 4; ++m) _Pragma("unroll") for (int k = 0; k < 2; ++k) dst[m][k] = *(const PG8_LAS bf16x8*)(lds + PG8_SA(b, h) + aoff + m * 2048 + k * 1024); } while (0)
#define PG8_LDB(dst, b, h) do { _Pragma("unroll") for (int n = 0; n < 2; ++n) _Pragma("unroll") for (int k = 0; k < 2; ++k) dst[n][k] = *(const PG8_LAS bf16x8*)(lds + PG8_SB(b, h) + boff + n * 2048 + k * 1024); } while (0)
#define PG8_MMA(ai, bj, At, Bt) do { __builtin_amdgcn_s_setprio(1); _Pragma("unroll") for (int m = 0; m < 4; ++m) _Pragma("unroll") for (int n = 0; n < 2; ++n) _Pragma("unroll") for (int k = 0; k < 2; ++k) \
        acc[ai][bj][m][n] = __builtin_amdgcn_mfma_f32_16x16x32_bf16(Bt[n][k], At[m][k], acc[ai][bj][m][n], 0, 0, 0); __builtin_amdgcn_s_setprio(0); } while (0)
#define PG8_WAIT_V(n) asm volatile("s_waitcnt vmcnt(" #n ")" ::: "memory")
#define PG8_WAIT_L(n) asm volatile("s_waitcnt lgkmcnt(" #n ")" ::: "memory")
#define PG8_BAR __builtin_amdgcn_s_barrier()
#define PG8_SCHED __builtin_amdgcn_sched_barrier(0)
    Unit cur, nxt; int ui = 0;
    if (!S.next(0, cur)) return;
    f32x4 acc[2][2][4][2];
#pragma unroll
    for (int a = 0; a < 2; ++a)
#pragma unroll
        for (int b = 0; b < 2; ++b)
#pragma unroll
            for (int m = 0; m < 4; ++m)
#pragma unroll
                for (int n = 0; n < 2; ++n) acc[a][b][m][n] = (f32x4){0.f, 0.f, 0.f, 0.f};
    bf16x8 At[4][2], B0[2][2], B1[2][2];
    const char* cA = (const char*)g.A + (size_t)cur.pm * tstep; const char* cB = (const char*)g.Bt + (size_t)cur.pn * tstep;
    S.a_ready(cur);
    if constexpr (SP2) {
        PG8_STAGE(PG8_SB(0, 0), cB, voffB); PG8_STAGE(PG8_SB(0, 1), cB + hstep, voffB); PG8_STAGE(PG8_SA(0, 0), cA, voffA); PG8_STAGE(PG8_SA(0, 1), cA + hstep, voffA);
        if (wr == 1) PG8_BAR;
        PG8_WAIT_V(2); PG8_BAR;
        PG8_STAGE(PG8_SB(1, 0), cB + kstep, voffB); PG8_STAGE(PG8_SA(1, 0), cA + kstep, voffA); PG8_STAGE(PG8_SB(1, 1), cB + hstep + kstep, voffB);
        PG8_WAIT_V(6); PG8_BAR;
    } else {
        PG8_STAGE(PG8_SB(0, 0), cB, voffB); PG8_STAGE(PG8_SA(0, 0), cA, voffA); PG8_STAGE(PG8_SB(0, 1), cB + hstep, voffB); PG8_STAGE(PG8_SA(0, 1), cA + hstep, voffA);
        if (wr == 1) PG8_BAR;
        PG8_WAIT_V(4); PG8_BAR;
        PG8_STAGE(PG8_SB(1, 0), cB + kstep, voffB); PG8_STAGE(PG8_SA(1, 0), cA + kstep, voffA); PG8_STAGE(PG8_SB(1, 1), cB + hstep + kstep, voffB);
        PG8_WAIT_V(6); PG8_BAR;
    }
    for (;;) {
        const bool has_next = S.next(ui + 1, nxt);
        const char* nA = has_next ? (const char*)g.A + (size_t)nxt.pm * tstep : cA; const char* nB = has_next ? (const char*)g.Bt + (size_t)nxt.pn * tstep : cB;
        for (int t = 0; t < nt; t += 2) {
            const bool last = (t == nt - 2);
            const char* a1 = cA + (size_t)(t + 1) * kstep;
            const char* a2 = last ? nA : cA + (size_t)(t + 2) * kstep; const char* b2 = last ? nB : cB + (size_t)(t + 2) * kstep;
            const char* a3 = a2 + kstep; const char* b3 = b2 + kstep;
            if (last && has_next) S.a_ready(nxt);
            if constexpr (SP2) {
            PG8_LDB(B0, 0, 0); PG8_LDB(B1, 0, 1); PG8_SCHED; PG8_LDA(At, 0, 0); PG8_STAGE(PG8_SA(1, 1), a1 + hstep, voffA);
            PG8_WAIT_V(8); PG8_WAIT_L(0); PG8_BAR; PG8_MMA(0, 0, At, B0); PG8_MMA(0, 1, At, B1); PG8_BAR; PG8_SCHED;
            PG8_LDA(At, 0, 1); PG8_STAGE(PG8_SB(0, 0), b2, voffB); PG8_STAGE(PG8_SB(0, 1), b2 + hstep, voffB); PG8_STAGE(PG8_SA(0, 0), a2, voffA);
            PG8_WAIT_V(8); PG8_WAIT_L(0); PG8_BAR; PG8_MMA(1, 0, At, B0); PG8_MMA(1, 1, At, B1); PG8_BAR; PG8_SCHED;
            PG8_LDB(B0, 1, 0); PG8_LDB(B1, 1, 1); PG8_SCHED; PG8_LDA(At, 1, 0); PG8_STAGE(PG8_SA(0, 1), a2 + hstep, voffA);
            PG8_WAIT_V(8); PG8_WAIT_L(0); PG8_BAR; PG8_MMA(0, 0, At, B0); PG8_MMA(0, 1, At, B1); PG8_BAR; PG8_SCHED;
            PG8_LDA(At, 1, 1); PG8_STAGE(PG8_SB(1, 0), b3, voffB); PG8_STAGE(PG8_SB(1, 1), b3 + hstep, voffB); PG8_STAGE(PG8_SA(1, 0), a3, voffA);
            PG8_WAIT_V(8); PG8_WAIT_L(0); PG8_BAR; PG8_MMA(1, 0, At, B0); PG8_MMA(1, 1, At, B1); PG8_BAR; PG8_SCHED;
            } else {
            PG8_LDB(B0, 0, 0); PG8_SCHED; PG8_LDA(At, 0, 0); PG8_STAGE(PG8_SA(1, 1), a1 + hstep, voffA);
            PG8_WAIT_L(8); PG8_BAR; PG8_WAIT_L(0); PG8_MMA(0, 0, At, B0); PG8_BAR; PG8_SCHED;
            PG8_LDB(B1, 0, 1); PG8_STAGE(PG8_SB(0, 0), b2, voffB);
            PG8_BAR; PG8_WAIT_L(0); PG8_MMA(0, 1, At, B1); PG8_BAR;
            PG8_LDA(At, 0, 1); PG8_STAGE(PG8_SA(0, 0), a2, voffA);
            PG8_BAR; PG8_WAIT_L(0); PG8_MMA(1, 0, At, B0); PG8_BAR; PG8_SCHED;
            PG8_STAGE(PG8_SB(0, 1), b2 + hstep, voffB);
            PG8_WAIT_V(6); PG8_BAR; PG8_MMA(1, 1, At, B1); PG8_BAR;
            PG8_LDB(B0, 1, 0); PG8_SCHED; PG8_LDA(At, 1, 0); PG8_STAGE(PG8_SA(0, 1), a2 + hstep, voffA);
            PG8_WAIT_L(8); PG8_BAR; PG8_WAIT_L(0); PG8_MMA(0, 0, At, B0); PG8_BAR; PG8_SCHED;
            PG8_LDB(B1, 1, 1); PG8_STAGE(PG8_SB(1, 0), b3, voffB);
            PG8_BAR; PG8_WAIT_L(0); PG8_MMA(0, 1, At, B1); PG8_BAR;
            PG8_LDA(At, 1, 1); PG8_STAGE(PG8_SA(1, 0), a3, voffA);
            PG8_BAR; PG8_WAIT_L(0); PG8_MMA(1, 0, At, B0); PG8_BAR; PG8_SCHED;
            PG8_STAGE(PG8_SB(1, 1), b3 + hstep, voffB);
            PG8_WAIT_V(6); PG8_BAR; PG8_MMA(1, 1, At, B1); PG8_BAR;
            }
        }
        if constexpr (ALIGN_EPI) { if (wr == 0) PG8_BAR; }
        if constexpr (!Epi::AFTER_DRAIN) { E(acc, cur, wr, wc, fr, fq); S.done(cur); }
        if (!has_next) break;
#pragma unroll
        for (int a = 0; a < 2; ++a)
#pragma unroll
            for (int b = 0; b < 2; ++b)
#pragma unroll
                for (int m = 0; m < 4; ++m)
#pragma unroll
                    for (int n = 0; n < 2; ++n) acc[a][b][m][n] = (f32x4){0.f, 0.f, 0.f, 0.f};
        cur = nxt; cA = nA; cB = nB; ++ui;
        if constexpr (ALIGN_EPI) { if (wr == 1) PG8_BAR; }
    }
    PG8_WAIT_V(0);
    if constexpr (!ALIGN_EPI) { if (wr == 0) PG8_BAR; }
    PG8_BAR;
    if constexpr (Epi::AFTER_DRAIN) { E.fused(acc, cur, wr, wc, fr, fq, lds, wid, lane); S.done(cur); }
#undef PG8_SA
#undef PG8_SB
#undef PG8_STAGE
#undef PG8_LDA
#undef PG8_LDB
#undef PG8_MMA
#undef PG8_WAIT_V
#undef PG8_WAIT_L
#undef PG8_BAR
#undef PG8_SCHED
}
}

#define LAS __attribute__((address_space(3)))
typedef unsigned short bf16_t;
typedef short bf16x8 __attribute__((ext_vector_type(8)));
typedef float f32x4 __attribute__((ext_vector_type(4)));
typedef float f32x16 __attribute__((ext_vector_type(16)));
typedef unsigned u32x4 __attribute__((ext_vector_type(4)));
typedef unsigned u32x2 __attribute__((ext_vector_type(2)));
using pg8::cvtpk; using pg8::pack8; using pg8::unpack8;
constexpr int NTHREADS = 512, NWAVES = 8;
constexpr int MH = 16384, DM = 1024, SEQ = 4096, NB_H = 4, NLAYER = 4, NP1 = 7168, NV2 = 2048, PLE = 256, NHEAD = 8;
constexpr size_t MiB = 1u << 20;
constexpr size_t LW_IN = 0, LW_A = (size_t)9216 * 1024, LW_B = LW_A + 1048576, LW_O = LW_B + 1048576, LW_G = LW_O + 1048576, LW_P = LW_G + 1048576, LW_TOTAL = LW_P + 262144;
constexpr size_t WS_W = 1 * MiB, WS_PROJ = 108 * MiB, WS_VT2 = 332 * MiB, WS_X0 = 396 * MiB, WS_X1 = 428 * MiB, WS_BRA = 460 * MiB, WS_BRB = 492 * MiB, WS_PB = 524 * MiB, WS_S0 = 532 * MiB, WS_S1 = 533 * MiB, WS_END = 534 * MiB;
static_assert(WS_W + LW_TOTAL * 2 * NLAYER <= WS_PROJ, "weights fit");
constexpr int TMP_LD = NP1 / 2;
constexpr int LDS_BYTES = 147456;
constexpr float EPS = 1e-6f;

struct Args {
    const float *x, *p, *norm_g, *w_in, *a_ln_g, *a_ln_b, *a_ws, *a_bs, *lam_q, *lam_k, *subln_g, *w_a_out, *w_b_out, *w_o, *ple_norm_g, *w_ple, *w_ple_gate, *final_g;
    float* out; unsigned char* ws;
};

__device__ __forceinline__ float wave_sum(float v) {
#pragma unroll
    for (int o = 1; o < 64; o <<= 1) v += __shfl_xor(v, o);
    return v;
}
#define LDS_WAIT() asm volatile("s_waitcnt lgkmcnt(0)" ::: "memory")

__device__ __forceinline__ void tr_item(const float* W, int K, int N, const float* scale, bf16_t* WT, int dst_row0, LAS float* scr, int k0, int n0, int lane) {
    f32x4 v[8];
#pragma unroll
    for (int i = 0; i < 8; ++i) v[i] = *(const f32x4*)(W + (size_t)(k0 + 4 * i + (lane >> 4)) * N + n0 + (lane & 15) * 4);
#pragma unroll
    for (int i = 0; i < 8; ++i) { const int kk = 4 * i + (lane >> 4); f32x4 x = v[i]; if (scale) x = x * scale[k0 + kk]; *(LAS f32x4*)(scr + kk * 68 + (lane & 15) * 4) = x; }
    LDS_WAIT(); asm volatile("" ::: "memory");
    bf16_t* o = WT + (size_t)(dst_row0 + lane) * K + k0;
#pragma unroll
    for (int j = 0; j < 4; ++j) { const LAS float* s = scr + (8 * j) * 68 + lane;
        u32x4 w; w.x = cvtpk(s[0 * 68], s[1 * 68]); w.y = cvtpk(s[2 * 68], s[3 * 68]); w.z = cvtpk(s[4 * 68], s[5 * 68]); w.w = cvtpk(s[6 * 68], s[7 * 68]);
        *(u32x4*)(o + 8 * j) = w; }
    LDS_WAIT(); asm volatile("" ::: "memory");
}
typedef const __attribute__((address_space(4))) Args* cargs_t;
__device__ __forceinline__ void weights_prologue(cargs_t ap, LAS unsigned char* lds, int gw, int ngw, int wave, int lane) {
    LAS float* scr = (LAS float*)(lds + wave * 16384);
    bf16_t* WT = (bf16_t*)(ap->ws + WS_W);
    constexpr int I_IN = 32 * 144, I_SQ = 32 * 16, I_P = 8 * 16, I_L = I_IN + 4 * I_SQ + I_P;
    for (int it = gw; it < I_L * NLAYER; it += ngw) {
        const int l = it / I_L; int r = it % I_L; bf16_t* wl = WT + (size_t)l * LW_TOTAL;
        if (r < I_IN) { const int kb = r / 144, nb = r % 144, n0 = nb * 64; const int osec = n0 >> 10;
            const int nsec = (int)((0x654832170ull >> (4 * osec)) & 0xFull);
            tr_item(ap->w_in + (size_t)l * 1024 * 9216, 1024, 9216, ap->norm_g + l * 1024, wl + LW_IN, nsec * 1024 + (n0 & 1023), scr, kb * 32, n0, lane);
            continue; }
        r -= I_IN;
        if (r < 4 * I_SQ) { const int which = r / I_SQ; const int rr = r % I_SQ; const int kb = rr / 16, nb = rr % 16;
            const float* src = which == 0 ? ap->w_a_out : which == 1 ? ap->w_b_out : which == 2 ? ap->w_o : ap->w_ple_gate;
            const size_t off = which == 0 ? LW_A : which == 1 ? LW_B : which == 2 ? LW_O : LW_G;
            tr_item(src + (size_t)l * 1048576, 1024, 1024, which == 3 ? ap->ple_norm_g + l * 1024 : nullptr, wl + off, nb * 64, scr, kb * 32, nb * 64, lane);
            continue; }
        r -= 4 * I_SQ;
        { const int kb = r / 16, nb = r % 16; tr_item(ap->w_ple + (size_t)l * 262144, 256, 1024, nullptr, wl + LW_P, nb * 64, scr, kb * 32, nb * 64, lane); }
    }
}

__device__ __forceinline__ void init_rows(const float* x, bf16_t* XB, float* S, int gw, int ngw, int lane) {
    asm volatile("" : "+v"(lane)); asm volatile("" : "+s"(gw));
    for (int m = gw; m < MH; m += ngw) {
        const f32x4* xr = (const f32x4*)(x + (size_t)m * DM) + lane; float s = 0.f; f32x4 v[4];
#pragma unroll
        for (int j = 0; j < 4; ++j) { v[j] = xr[64 * j]; s += (v[j][0] * v[j][0] + v[j][1] * v[j][1]) + (v[j][2] * v[j][2] + v[j][3] * v[j][3]); }
        s = wave_sum(s);
        u32x2* o = (u32x2*)(XB + (size_t)m * DM) + lane;
#pragma unroll
        for (int j = 0; j < 4; ++j) { u32x2 w; w.x = cvtpk(v[j][0], v[j][1]); w.y = cvtpk(v[j][2], v[j][3]); o[64 * j] = w; }
        if (lane < 16) S[(size_t)m * 16 + lane] = lane == 0 ? s : 0.f;
    }
}
__device__ __forceinline__ void final_rows(float* out, const float* g, int gw, int ngw, int lane) {
    asm volatile("" : "+v"(lane)); asm volatile("" : "+s"(gw));
    for (int m = gw; m < MH; m += ngw) {
        f32x4* xr = (f32x4*)(out + (size_t)m * DM) + lane; float s = 0.f; f32x4 v[4];
#pragma unroll
        for (int j = 0; j < 4; ++j) { v[j] = xr[64 * j]; s += (v[j][0] * v[j][0] + v[j][1] * v[j][1]) + (v[j][2] * v[j][2] + v[j][3] * v[j][3]); }
        const float rs = rsqrtf(wave_sum(s) * (1.0f / DM) + EPS);
#pragma unroll
        for (int j = 0; j < 4; ++j) { const f32x4 gg = ((const f32x4*)g)[64 * j + lane]; xr[64 * j] = v[j] * rs * gg; }
    }
}
__device__ __forceinline__ void convert_p(const float* p, bf16_t* PB, int gtid, int nthr) {
    asm volatile("" : "+v"(gtid));
    for (int i = gtid; i < MH * PLE / 8; i += nthr) { const f32x4 a = ((const f32x4*)p)[2 * i], b = ((const f32x4*)p)[2 * i + 1]; ((u32x4*)PB)[i] = pack8(a, b); }
}

__device__ __forceinline__ void gmlp_unit(LAS unsigned char* lds, const bf16_t* PROJ, const bf16_t* VT2, bf16_t* BRA, const float* lng, const float* lnb, const float* ws, const float* bs, int c, int gh) {
    int tid_ = threadIdx.x; asm volatile("" : "+v"(tid_)); const int tid = tid_, lane = tid & 63, l32 = lane & 31, hi = lane >> 5; const int w = __builtin_amdgcn_readfirstlane(tid >> 6);
    const int tok0 = c * 128;
    LAS float* red = (LAS float*)lds;
    LAS float* stat = (LAS float*)(lds + 32768);
    LAS unsigned char* T = lds + 34816;
    { const int sc = tid & 15, rg = tid >> 4; float s[8], q[8];
#pragma unroll
      for (int j = 0; j < 8; ++j) { s[j] = 0.f; q[j] = 0.f; }
      for (int i = 0; i < 32; ++i) { const u32x4 wv = *(const u32x4*)(VT2 + (size_t)(rg + 32 * i) * MH + tok0 + sc * 8); f32x4 a, b; unpack8(wv, a, b);
#pragma unroll
          for (int j = 0; j < 4; ++j) { s[j] += a[j]; q[j] += a[j] * a[j]; s[4 + j] += b[j]; q[4 + j] += b[j] * b[j]; } }
#pragma unroll
      for (int j = 0; j < 8; ++j) { red[rg * 256 + sc * 8 + j] = s[j]; red[rg * 256 + 128 + sc * 8 + j] = q[j]; } }
    __syncthreads();
    if (tid < 128) { float s = 0.f, q = 0.f;
        for (int i = 0; i < 32; ++i) { s += red[i * 256 + tid]; q += red[i * 256 + 128 + tid]; }
        const float mean = s * (1.0f / 1024.0f); const float var = q * (1.0f / 1024.0f) - mean * mean;
        stat[2 * tid] = mean; stat[2 * tid + 1] = rsqrtf(var + EPS); }
    __syncthreads();
    const int tb = w & 3, dh = w >> 2;
    for (int gi = 0; gi < 4; ++gi) { const int g = gh * 4 + gi;
#pragma unroll
        for (int i = 0; i < 4; ++i) { const int p = tid + 512 * i, d = p >> 4, sc = p & 15;
            const u32x4 wv = *(const u32x4*)(VT2 + (size_t)(g * 128 + d) * MH + tok0 + sc * 8); f32x4 a, b; unpack8(wv, a, b);
            const float gg = lng[g * 128 + d], bb = lnb[g * 128 + d];
#pragma unroll
            for (int j = 0; j < 4; ++j) { a[j] = (a[j] - stat[2 * (sc * 8 + j)]) * stat[2 * (sc * 8 + j) + 1] * gg + bb; b[j] = (b[j] - stat[2 * (sc * 8 + 4 + j)]) * stat[2 * (sc * 8 + 4 + j) + 1] * gg + bb; }
            *(LAS u32x4*)(T + d * 272 + sc * 16) = pack8(a, b); }
        __syncthreads();
        f32x16 acc0 = {}, acc1 = {};
        const float* wrow = ws + (size_t)g * 16384 + (size_t)(32 * tb + l32) * 128 + 8 * hi;
        const int trow = 32 * tb + l32;
        for (int ks = 0; ks < 2 * tb + 2; ++ks) {
            f32x4 wa = *(const f32x4*)(wrow + 16 * ks), wb = *(const f32x4*)(wrow + 16 * ks + 4); const int s0 = 16 * ks + 8 * hi;
#pragma unroll
            for (int j = 0; j < 4; ++j) { if (s0 + j > trow) wa[j] = 0.f; if (s0 + 4 + j > trow) wb[j] = 0.f; }
            const bf16x8 A = __builtin_bit_cast(bf16x8, pack8(wa, wb));
            const bf16x8 B0 = *(const LAS bf16x8*)(T + (64 * dh + l32) * 272 + (16 * ks + 8 * hi) * 2);
            const bf16x8 B1 = *(const LAS bf16x8*)(T + (64 * dh + 32 + l32) * 272 + (16 * ks + 8 * hi) * 2);
            acc0 = __builtin_amdgcn_mfma_f32_32x32x16_bf16(A, B0, acc0, 0, 0, 0);
            acc1 = __builtin_amdgcn_mfma_f32_32x32x16_bf16(A, B1, acc1, 0, 0, 0);
        }
        LAS float* Yb = (LAS float*)(lds + 71680);
#pragma unroll
        for (int r = 0; r < 16; ++r) { const int t = 32 * tb + (r & 3) + 8 * (r >> 2) + 4 * hi; const float bv = bs[g * 128 + t];
            Yb[t * 132 + 64 * dh + l32] = acc0[r] + bv; Yb[t * 132 + 64 * dh + 32 + l32] = acc1[r] + bv; }
        __syncthreads();
#pragma unroll
        for (int i = 0; i < 4; ++i) { const int p = tid + 512 * i, t = p >> 4, c8 = p & 15; const size_t tok = (size_t)(tok0 + t); const int col = g * 128 + c8 * 8;
            f32x4 u0, u1, z0, z1; unpack8(*(const u32x4*)(PROJ + tok * NP1 + col), u0, u1); unpack8(*(const u32x4*)(PROJ + tok * NP1 + 1024 + col), z0, z1);
            const f32x4 y0 = *(const LAS f32x4*)(Yb + t * 132 + c8 * 8), y1 = *(const LAS f32x4*)(Yb + t * 132 + c8 * 8 + 4);
            *(u32x4*)(BRA + tok * DM + col) = pack8(u0 * y0 * z0, u1 * y1 * z1); }
        __syncthreads();
    }
}

constexpr int AT_KS = 17408, AT_VS = 18432, AT_VOFF = 2 * AT_KS;
__device__ __forceinline__ void attn_unit(LAS unsigned char* lds, const bf16_t* PROJ, const bf16_t* VT2, bf16_t* BRB, const float* subg, float lam, float lam_init, int b, int h, int qb) {
    int tid_ = threadIdx.x; asm volatile("" : "+v"(tid_)); const int tid = tid_, lane = tid & 63, l32 = lane & 31, hi = lane >> 5; const int w = __builtin_amdgcn_readfirstlane(tid >> 6); const int map = w >> 2, wq = w & 3;
    const int rowbase = b * SEQ, q0 = qb * 128, myq = q0 + wq * 32 + l32, NT = 2 * qb + 2;
    bf16x8 qf[4];
    { const bf16_t* qp = PROJ + (size_t)(rowbase + myq) * NP1 + 2048 + h * 128 + map * 64 + hi * 8;
#pragma unroll
      for (int ks = 0; ks < 4; ++ks) qf[ks] = *(const bf16x8*)(qp + ks * 16); }
    const bf16_t* ksrc[2]; const bf16_t* vsrc[2]; int kdst[2], vdst[2];
#pragma unroll
    for (int i = 0; i < 2; ++i) { const int p = tid + 512 * i;
        ksrc[i] = PROJ + (size_t)(rowbase + (p >> 4)) * NP1 + 3072 + h * 128 + (p & 15) * 8; kdst[i] = (p >> 4) * 272 + (p & 15) * 16;
        vsrc[i] = VT2 + (size_t)(1024 + h * 128 + (p >> 3)) * MH + rowbase + (p & 7) * 8; vdst[i] = AT_VOFF + (p >> 3) * 144 + (((p & 7) >> 1) * 16 + (p & 1) * 4) * 2; }
    u32x4 kr[2], vr[2];
#pragma unroll
    for (int i = 0; i < 2; ++i) { kr[i] = *(const u32x4*)(ksrc[i]); vr[i] = *(const u32x4*)(vsrc[i]); }
#pragma unroll
    for (int i = 0; i < 2; ++i) { *(LAS u32x4*)(lds + kdst[i]) = kr[i]; *(LAS u32x2*)(lds + vdst[i]) = (u32x2){vr[i].x, vr[i].y}; *(LAS u32x2*)(lds + vdst[i] + 16) = (u32x2){vr[i].z, vr[i].w}; }
    __syncthreads();
    f32x16 O[4]; O[0] = f32x16{}; O[1] = f32x16{}; O[2] = f32x16{}; O[3] = f32x16{};
    float m_run = -1e30f, l_run = 0.f;
    for (int t = 0; t < NT; ++t) {
        const int buf = t & 1, kv0 = 64 * t;
        if (t + 1 < NT) {
#pragma unroll
            for (int i = 0; i < 2; ++i) { kr[i] = *(const u32x4*)(ksrc[i] + (size_t)(kv0 + 64) * NP1); vr[i] = *(const u32x4*)(vsrc[i] + kv0 + 64); } }
        if (kv0 <= q0 + wq * 32 + 31) {
            LAS unsigned char* Kb = lds + buf * AT_KS + l32 * 272 + map * 128 + hi * 16;
            LAS unsigned char* Vb = lds + AT_VOFF + buf * AT_VS + l32 * 144 + hi * 16;
            f32x16 S0 = {}, S1 = {};
            { bf16x8 kf[8];
#pragma unroll
              for (int ks = 0; ks < 4; ++ks) { kf[2 * ks] = *(const LAS bf16x8*)(Kb + ks * 32); kf[2 * ks + 1] = *(const LAS bf16x8*)(Kb + 32 * 272 + ks * 32); }
              __builtin_amdgcn_sched_barrier(0);
#pragma unroll
              for (int ks = 0; ks < 4; ++ks) { S0 = __builtin_amdgcn_mfma_f32_32x32x16_bf16(kf[2 * ks], qf[ks], S0, 0, 0, 0); S1 = __builtin_amdgcn_mfma_f32_32x32x16_bf16(kf[2 * ks + 1], qf[ks], S1, 0, 0, 0); } }
            u32x4 va[8], vb[8];
#pragma unroll
            for (int j = 0; j < 2; ++j)
#pragma unroll
                for (int db = 0; db < 4; ++db) va[j * 4 + db] = *(const LAS u32x4*)(Vb + db * 32 * 144 + j * 32);
            __builtin_amdgcn_sched_barrier(0);
            if (t >= NT - 2) {
#pragma unroll
                for (int r = 0; r < 16; ++r) { const int kv = kv0 + (r & 3) + 8 * (r >> 2) + 4 * hi; if (kv > myq) S0[r] = -1e30f; if (kv + 32 > myq) S1[r] = -1e30f; } }
            float mx = __builtin_fmaxf(__builtin_fmaxf(S0[0], S1[0]), __builtin_fmaxf(S0[1], S1[1]));
#pragma unroll
            for (int r = 2; r < 16; r += 2) { mx = __builtin_fmaxf(__builtin_fmaxf(mx, S0[r]), S1[r]); mx = __builtin_fmaxf(__builtin_fmaxf(mx, S0[r + 1]), S1[r + 1]); }
            mx = fmaxf(mx, __shfl_xor(mx, 32));
            if (__any(mx > m_run)) { const float mnew = fmaxf(m_run, mx), alpha = __builtin_amdgcn_exp2f(m_run - mnew); m_run = mnew; l_run *= alpha;
#pragma unroll
                for (int db = 0; db < 4; ++db)
#pragma unroll
                    for (int r = 0; r < 16; ++r) O[db][r] *= alpha; }
            pg8::f32x2 ps2 = {0.f, 0.f};
#pragma unroll
            for (int r = 0; r < 16; r += 2) { S0[r] = __builtin_amdgcn_exp2f(S0[r] - m_run); S0[r + 1] = __builtin_amdgcn_exp2f(S0[r + 1] - m_run); ps2 += (pg8::f32x2){S0[r], S0[r + 1]}; }
            bf16x8 pf[4];
#pragma unroll
            for (int j = 0; j < 2; ++j) { u32x4 pw;
#pragma unroll
                for (int i = 0; i < 4; ++i) pw[i] = cvtpk(S0[8 * j + 2 * i], S0[8 * j + 2 * i + 1]);
                pf[j] = __builtin_bit_cast(bf16x8, pw); }
#pragma unroll
            for (int j = 2; j < 4; ++j)
#pragma unroll
                for (int db = 0; db < 4; ++db) vb[(j - 2) * 4 + db] = *(const LAS u32x4*)(Vb + db * 32 * 144 + j * 32);
            __builtin_amdgcn_sched_barrier(0);
#pragma unroll
            for (int j = 0; j < 2; ++j)
#pragma unroll
                for (int db = 0; db < 4; ++db) O[db] = __builtin_amdgcn_mfma_f32_32x32x16_bf16(__builtin_bit_cast(bf16x8, va[j * 4 + db]), pf[j], O[db], 0, 0, 0);
#pragma unroll
            for (int r = 0; r < 16; r += 2) { S1[r] = __builtin_amdgcn_exp2f(S1[r] - m_run); S1[r + 1] = __builtin_amdgcn_exp2f(S1[r + 1] - m_run); ps2 += (pg8::f32x2){S1[r], S1[r + 1]}; }
#pragma unroll
            for (int j = 2; j < 4; ++j) { u32x4 pw;
#pragma unroll
                for (int i = 0; i < 4; ++i) pw[i] = cvtpk(S1[8 * (j & 1) + 2 * i], S1[8 * (j & 1) + 2 * i + 1]);
                pf[j] = __builtin_bit_cast(bf16x8, pw); }
#pragma unroll
            for (int k = 0; k < 8; ++k) { __builtin_amdgcn_sched_group_barrier(0x008, 1, 0); __builtin_amdgcn_sched_group_barrier(0x002, 6, 0); }
            __builtin_amdgcn_sched_barrier(0);
            l_run += ps2.x + ps2.y;
#pragma unroll
            for (int j = 2; j < 4; ++j)
#pragma unroll
                for (int db = 0; db < 4; ++db) O[db] = __builtin_amdgcn_mfma_f32_32x32x16_bf16(__builtin_bit_cast(bf16x8, vb[(j - 2) * 4 + db]), pf[j], O[db], 0, 0, 0);
        }
        if (t + 1 < NT) {
#pragma unroll
            for (int i = 0; i < 2; ++i) { *(LAS u32x4*)(lds + (buf ^ 1) * AT_KS + kdst[i]) = kr[i]; *(LAS u32x2*)(lds + (buf ^ 1) * AT_VS + vdst[i]) = (u32x2){vr[i].x, vr[i].y}; *(LAS u32x2*)(lds + (buf ^ 1) * AT_VS + vdst[i] + 16) = (u32x2){vr[i].z, vr[i].w}; } }
        __syncthreads();
    }
    const float inv = 1.0f / (l_run + __shfl_xor(l_run, 32));
    LAS float* X = (LAS float*)lds + wq * 4096 + lane;
    if (map == 1) { const float sc = -lam * inv;
#pragma unroll
        for (int db = 0; db < 4; ++db)
#pragma unroll
            for (int r = 0; r < 16; ++r) X[(db * 16 + r) * 64] = O[db][r] * sc; }
    __syncthreads();
    if (map == 0) { float ss = 0.f;
#pragma unroll
        for (int db = 0; db < 4; ++db)
#pragma unroll
            for (int r = 0; r < 16; ++r) { const float o = O[db][r] * inv + X[(db * 16 + r) * 64]; O[db][r] = o; ss += o * o; }
        ss += __shfl_xor(ss, 32);
        const float rs = rsqrtf(ss * (1.0f / 128.0f) + EPS) * (1.0f - lam_init);
        LAS float* Zr = (LAS float*)(lds + 65536) + (wq * 32 + l32) * 132;
#pragma unroll
        for (int db = 0; db < 4; ++db)
#pragma unroll
            for (int rg = 0; rg < 4; ++rg) { const int d = 32 * db + 8 * rg + 4 * hi; const f32x4 gg = *(const f32x4*)(subg + d);
                *(LAS f32x4*)(Zr + d) = (f32x4){O[db][4 * rg] * rs * gg[0], O[db][4 * rg + 1] * rs * gg[1], O[db][4 * rg + 2] * rs * gg[2], O[db][4 * rg + 3] * rs * gg[3]}; } }
    __syncthreads();
#pragma unroll
    for (int i = 0; i < 4; ++i) { const int p = tid + 512 * i, q = p >> 4, c8 = p & 15; const size_t row = (size_t)(rowbase + q0 + q);
        f32x4 z0, z1; unpack8(*(const u32x4*)(PROJ + row * NP1 + 4096 + h * 128 + c8 * 8), z0, z1);
        const LAS float* zp = (const LAS float*)(lds + 65536) + q * 132 + c8 * 8;
        const f32x4 v0 = *(const LAS f32x4*)zp, v1 = *(const LAS f32x4*)(zp + 4);
        *(u32x4*)(BRB + row * DM + h * 128 + c8 * 8) = pack8(v0 * z0, v1 * z1); }
    __syncthreads();
}

#define RLX_AGENT __ATOMIC_RELAXED, __HIP_MEMORY_SCOPE_AGENT
#define XB_TMO      128
#define XB_XCNT(j)  (256  + 64 * (j))
#define XB_XSUB(j)  (1280 + 64 * (j))
#define XB_XGEN(j)  (2304 + 64 * (j))
#define XB_TOP      3328
#define XB_TOPGEN   3392
#define XCD_BAR_WORDS 3456
#define XB_SPIN_CAP (1u << 18)

__device__ __forceinline__ unsigned xb_ld(unsigned* p)              { return __hip_atomic_load(p, __ATOMIC_RELAXED, __HIP_MEMORY_SCOPE_AGENT); }
__device__ __forceinline__ unsigned xb_add(unsigned* p, unsigned v) { return __hip_atomic_fetch_add(p, v, __ATOMIC_RELAXED, __HIP_MEMORY_SCOPE_AGENT); }
__device__ __forceinline__ unsigned xb_xcc_id() { return (unsigned)__builtin_amdgcn_s_getreg((3 << 11) | 20) & 0xFu; }
#define XB_SPIN(cond, bar) do { unsigned _sp = 0; while (cond) { __builtin_amdgcn_s_sleep(1); \
    if ((++_sp & 255u) == 0u) { if (xb_ld(&(bar)[XB_TMO])) break; if (_sp > XB_SPIN_CAP) { atomicAdd(&(bar)[XB_TMO], 1u); break; } } } } while (0)

struct XcdBarrier {
    unsigned* bar; unsigned x;
    volatile LAS unsigned* st;
};

__device__ __forceinline__ XcdBarrier xcd_barrier_post(unsigned* bar, volatile LAS unsigned* st) {
    XcdBarrier b; b.bar = bar; b.x = xb_xcc_id(); b.st = st;
    if (threadIdx.x == 0) (void)xb_add(&bar[XB_XCNT(b.x)], 1u);
    return b;
}
__device__ __forceinline__ void xcd_barrier_complete(unsigned* bar, unsigned x, unsigned& nloc, unsigned& nx) {
    const unsigned G = gridDim.x * gridDim.y * gridDim.z;
    unsigned sum, cnt, mine, sp = 0u;
    for (;;) {
        sum = 0u; cnt = 0u; mine = 0u;
#pragma unroll
        for (unsigned j = 0; j < 16; ++j) { const unsigned c = xb_ld(&bar[XB_XCNT(j)]); sum += c; cnt += (c > 0u) ? 1u : 0u; mine = (j == x) ? c : mine; }
        if (sum == G) break;
        __builtin_amdgcn_s_sleep(1);
        if ((++sp & 255u) == 0u) { if (xb_ld(&bar[XB_TMO])) break; if (sp > XB_SPIN_CAP) { atomicAdd(&bar[XB_TMO], 1u); break; } }
    }
    nloc = mine > 0u ? mine : 1u; nx = cnt > 0u ? cnt : 1u;
}

__device__ __forceinline__ void xcd_barrier(const XcdBarrier& b) {
    asm volatile("s_waitcnt vmcnt(0)" ::: "memory");
    __syncthreads();
    if (threadIdx.x == 0) {
        unsigned* bar = b.bar;
        __builtin_amdgcn_s_waitcnt(0);
        unsigned nloc = b.st[0], nx = b.st[1];
        if (nloc == 0u) { xcd_barrier_complete(bar, b.x, nloc, nx); b.st[0] = nloc; b.st[1] = nx; }
        const unsigned old = xb_add(&bar[XB_XSUB(b.x)], 1u);
        const unsigned gen = old / nloc;
        if (old + 1u == (gen + 1u) * nloc) {
            __builtin_amdgcn_fence(__ATOMIC_RELEASE, "agent");
            asm volatile("s_waitcnt vmcnt(0)" ::: "memory");
            const unsigned og = xb_add(&bar[XB_TOP], 1u);
            const unsigned tg = og / nx;
            if (og + 1u == (tg + 1u) * nx) xb_add(&bar[XB_TOPGEN], 1u);
            else XB_SPIN(xb_ld(&bar[XB_TOPGEN]) == tg, bar);
            __builtin_amdgcn_fence(__ATOMIC_ACQUIRE, "agent");
            xb_add(&bar[XB_XGEN(b.x)], 1u);
            asm volatile("s_waitcnt vmcnt(0)" ::: "memory");
        } else {
            XB_SPIN(xb_ld(&bar[XB_XGEN(b.x)]) == gen, bar);
            __builtin_amdgcn_fence(__ATOMIC_ACQUIRE, "agent");
            asm volatile("s_waitcnt vmcnt(0)" ::: "memory");
        }
    }
    __syncthreads();
}


__global__ void __launch_bounds__(NTHREADS, 2) mega_fwd(Args a_unused) {
    extern __shared__ __attribute__((aligned(16))) unsigned char lds_raw[];
    LAS unsigned char* lds = (LAS unsigned char*)lds_raw;
    cg::grid_group grid = cg::this_grid();
    const int tid = threadIdx.x, lane = tid & 63, wave = __builtin_amdgcn_readfirstlane(tid >> 6);
    const int G = gridDim.x, bx = blockIdx.x;
    const int vcu = (G % 8 == 0) ? (bx % 8) * (G / 8) + bx / 8 : bx;
    const int gw = vcu * NWAVES + wave, ngw = G * NWAVES;
#define ARGS() cargs_t ap = (cargs_t)__builtin_amdgcn_kernarg_segment_ptr(); asm volatile("" : "+s"(ap)); unsigned char* const ws = ap->ws
#define GSYNC() xcd_barrier(xbar)
#define WSP(T, off) ((T*)(ws + (off)))
#define XBP(ci) ((bf16_t*)(ws + ((ci) ? WS_X1 : WS_X0)))
#define SXP(ci) ((float*)(ws + ((ci) ? WS_S1 : WS_S0)))
#define TMPP ((float*)(ws + WS_PROJ + 4096))
    if (tid < 64) ((LAS unsigned*)(lds + 147200))[tid] = 0u;
    __syncthreads();
    grid.sync();
    XcdBarrier xbar;
    { ARGS(); xbar = xcd_barrier_post((unsigned*)ws, (volatile LAS unsigned*)(lds + 147200)); }
    { ARGS(); weights_prologue(ap, lds, gw, ngw, wave, lane); }

#define DUMP_BF16(buf_off, nelem) do { ARGS(); const bf16_t* B_ = WSP(bf16_t, buf_off); float* o_ = ap->out; \
    for (size_t i_ = (size_t)bx * NTHREADS + tid; i_ < (size_t)2 * MH * DM; i_ += (size_t)G * NTHREADS) o_[i_] = __uint_as_float((unsigned)B_[i_ % (size_t)(nelem)] << 16); } while (0)
    for (int hf = 0; hf < 2; ++hf) {
        { ARGS(); init_rows(ap->x + (size_t)hf * MH * DM, XBP(0), SXP(0), gw, ngw, lane); }
        GSYNC();
        int c = 0;
        for (int l = 0; l < NLAYER; ++l) {
            { ARGS(); convert_p(ap->p + ((size_t)l * 2 * MH + (size_t)hf * MH) * PLE, WSP(bf16_t, WS_PB), bx * NTHREADS + tid, G * NTHREADS); }
#if !defined(ONLY) || ONLY == 0
            { ARGS(); const bf16_t* wl = WSP(bf16_t, WS_W) + (size_t)l * LW_TOTAL;
              pg8::Gemm g{XBP(c), wl + LW_IN, MH, NP1, DM}; pg8::StaticOrder S; S.init(MH, NP1, G, bx);
              pg8::Epi E{0, WSP(bf16_t, WS_PROJ), NP1, nullptr, 0, nullptr, 0, nullptr, SXP(c), nullptr, nullptr, nullptr};
              pg8::gemm_phase<pg8::Epi, pg8::StaticOrder, true, true>(lds, g, S, E); }
#endif
#if !defined(ONLY) || ONLY == 1
            { ARGS(); const bf16_t* wl = WSP(bf16_t, WS_W) + (size_t)l * LW_TOTAL;
              pg8::Gemm g{wl + LW_IN + (size_t)NP1 * DM, XBP(c), NV2, MH, DM}; pg8::StaticOrder S; S.init(NV2, MH, G, bx);
              pg8::Epi E{1, WSP(bf16_t, WS_VT2), MH, nullptr, 0, nullptr, 0, nullptr, SXP(c), nullptr, nullptr, nullptr};
              pg8::gemm_phase<pg8::Epi, pg8::StaticOrder, true, true>(lds, g, S, E); }
#endif
            GSYNC();
#if defined(STOP_AFTER) && STOP_AFTER == 1
            DUMP_BF16(WS_PROJ, (size_t)MH * NP1); return;
#endif
#if defined(STOP_AFTER) && STOP_AFTER == 11
            DUMP_BF16(WS_VT2, (size_t)MH * NV2); return;
#endif
#ifndef NO_GMLP
            { ARGS();
              for (int u = vcu; u < 256; u += G)
                gmlp_unit(lds, WSP(bf16_t, WS_PROJ), WSP(bf16_t, WS_VT2), WSP(bf16_t, WS_BRA), ap->a_ln_g + l * 1024, ap->a_ln_b + l * 1024, ap->a_ws + (size_t)l * 131072, ap->a_bs + l * 1024, u >> 1, u & 1); }
#endif
#ifdef NO_ATTN
            { ARGS(); const bf16_t* PR = WSP(bf16_t, WS_PROJ); bf16_t* B = WSP(bf16_t, WS_BRB);
              for (int i = bx * NTHREADS + tid; i < MH * DM / 8; i += G * NTHREADS) { const int row = i >> 7, c8 = i & 127; *(u32x4*)(B + (size_t)row * DM + c8 * 8) = *(const u32x4*)(PR + (size_t)row * NP1 + 4096 + c8 * 8); } }
#endif
#ifdef NO_GMLP
            { ARGS(); const bf16_t* PR = WSP(bf16_t, WS_PROJ); bf16_t* B = WSP(bf16_t, WS_BRA);
              for (int i = bx * NTHREADS + tid; i < MH * DM / 8; i += G * NTHREADS) { const int row = i >> 7, c8 = i & 127; *(u32x4*)(B + (size_t)row * DM + c8 * 8) = *(const u32x4*)(PR + (size_t)row * NP1 + c8 * 8); } }
#endif
#ifndef NO_ATTN
            { ARGS();
              const float lam_init = 0.8f - 0.6f * expf(-0.3f * (float)l);
              const float d0 = wave_sum(ap->lam_q[l * 128 + lane] * ap->lam_k[l * 128 + lane]), d1 = wave_sum(ap->lam_q[l * 128 + 64 + lane] * ap->lam_k[l * 128 + 64 + lane]);
              const float lam = expf(d0) - expf(d1) + lam_init;
              for (int pu = vcu; pu < 512; pu += G) { const int bh = pu >> 4, s = pu & 15;
                  attn_unit(lds, WSP(bf16_t, WS_PROJ), WSP(bf16_t, WS_VT2), WSP(bf16_t, WS_BRB), ap->subln_g + l * 128, lam, lam_init, bh >> 3, bh & 7, 31 - s);
                  attn_unit(lds, WSP(bf16_t, WS_PROJ), WSP(bf16_t, WS_VT2), WSP(bf16_t, WS_BRB), ap->subln_g + l * 128, lam, lam_init, bh >> 3, bh & 7, s); } }
#endif
            GSYNC();
#if !defined(ONLY) || ONLY == 2
            { ARGS(); const bf16_t* wl = WSP(bf16_t, WS_W) + (size_t)l * LW_TOTAL;
              pg8::Gemm g{WSP(bf16_t, WS_BRA), wl + LW_A, MH, DM, DM}; pg8::StaticOrder S; S.init(MH, DM, G, bx);
              pg8::Epi E{2, WSP(bf16_t, WS_PROJ) + 2048, NP1, nullptr, 0, nullptr, 0, WSP(bf16_t, WS_PROJ) + 5120, nullptr, nullptr, nullptr, nullptr};
              pg8::gemm_phase<pg8::Epi, pg8::StaticOrder, true, true>(lds, g, S, E); }
#endif
#if !defined(ONLY) || ONLY == 3
            { ARGS(); const bf16_t* wl = WSP(bf16_t, WS_W) + (size_t)l * LW_TOTAL;
              pg8::Gemm g{WSP(bf16_t, WS_BRB), wl + LW_B, MH, DM, DM}; pg8::StaticOrder S; S.init(MH, DM, G, bx);
              pg8::Epi E{3, XBP(1 - c), DM, nullptr, 0, nullptr, 0, WSP(bf16_t, WS_PROJ) + 6144, nullptr, nullptr, WSP(bf16_t, WS_PROJ) + 2048, nullptr};
              pg8::gemm_phase<pg8::Epi, pg8::StaticOrder, true, true>(lds, g, S, E); }
#endif
            GSYNC();
#if defined(STOP_AFTER) && STOP_AFTER == 3
            if (c == 0) DUMP_BF16(WS_X1, (size_t)MH * DM); else DUMP_BF16(WS_X0, (size_t)MH * DM); return;
#endif
#if !defined(ONLY) || ONLY == 4
            { ARGS(); const bf16_t* wl = WSP(bf16_t, WS_W) + (size_t)l * LW_TOTAL; float* out = ap->out + (size_t)hf * MH * DM;
              pg8::Gemm g{XBP(1 - c), wl + LW_O, MH, DM, DM}; pg8::StaticOrder S; S.init(MH, DM, G, bx);
              pg8::Epi E{4, XBP(c), DM, nullptr, 0, l == 0 ? ap->x + (size_t)hf * MH * DM : (const float*)nullptr, DM, nullptr, nullptr, SXP(c), nullptr, XBP(c)};
              pg8::gemm_phase<pg8::Epi, pg8::StaticOrder, true, true>(lds, g, S, E); }
#endif
            GSYNC();
#if defined(STOP_AFTER) && STOP_AFTER == 4
            if (c == 0) DUMP_BF16(WS_X0, (size_t)MH * DM); else DUMP_BF16(WS_X1, (size_t)MH * DM); return;
#endif
#if !defined(ONLY) || ONLY == 5
            { ARGS(); const bf16_t* wl = WSP(bf16_t, WS_W) + (size_t)l * LW_TOTAL;
              pg8::Gemm g{XBP(c), wl + LW_G, MH, DM, DM}; pg8::StaticOrder S; S.init(MH, DM, G, bx);
              pg8::Epi E{5, WSP(bf16_t, WS_PROJ) + 2048, NP1, nullptr, 0, nullptr, 0, nullptr, SXP(c), nullptr, nullptr, nullptr};
              pg8::gemm_phase<pg8::Epi, pg8::StaticOrder, true, true>(lds, g, S, E); }
#endif
#if !defined(ONLY) || ONLY == 6
            { ARGS(); const bf16_t* wl = WSP(bf16_t, WS_W) + (size_t)l * LW_TOTAL; float* out = ap->out + (size_t)hf * MH * DM;
              pg8::Gemm g{WSP(bf16_t, WS_PB), wl + LW_P, MH, DM, PLE}; pg8::StaticOrder S; S.init(MH, DM, G, bx);
              pg8::Epi E{6, XBP(1 - c), DM, l == NLAYER - 1 ? out : (float*)nullptr, DM, nullptr, 0, nullptr, nullptr, SXP(1 - c), WSP(bf16_t, WS_PROJ) + 2048, XBP(c)};
              pg8::gemm_phase<pg8::Epi, pg8::StaticOrder, true, true>(lds, g, S, E); }
#endif
            GSYNC();
#if defined(STOP_AFTER) && STOP_AFTER == 5
            if (c == 0) DUMP_BF16(WS_X1, (size_t)MH * DM); else DUMP_BF16(WS_X0, (size_t)MH * DM); return;
#endif
            c ^= 1;
        }
        { ARGS(); final_rows(ap->out + (size_t)hf * MH * DM, ap->final_g, gw, ngw, lane); }
    }
}

extern "C" void kernel_launch(void* const* d_in, const int* in_sizes, int n_in, void* d_out, int out_size, void* d_ws, size_t ws_size, hipStream_t stream) {
    static int grid = 0;
    if (grid == 0) {
        if (n_in != 18 || ws_size < WS_END) { fprintf(stderr, "kernel_launch: unexpected n_in %d / ws_size %zu (need %zu)\n", n_in, ws_size, (size_t)WS_END); grid = -1; return; }
        int dev = 0, cus = 0, per_cu = 0;
        hipGetDevice(&dev); hipDeviceGetAttribute(&cus, hipDeviceAttributeMultiprocessorCount, dev);
        if (hipFuncSetAttribute((const void*)mega_fwd, hipFuncAttributeMaxDynamicSharedMemorySize, LDS_BYTES) != hipSuccess) { fprintf(stderr, "kernel_launch: hipFuncSetAttribute failed\n"); grid = -1; return; }
        if (hipOccupancyMaxActiveBlocksPerMultiprocessor(&per_cu, (const void*)mega_fwd, NTHREADS, LDS_BYTES) != hipSuccess || per_cu < 1) { fprintf(stderr, "kernel_launch: occupancy query gives %d\n", per_cu); per_cu = 1; }
        (void)hipGetLastError();
        grid = cus;
    }
    if (grid < 0) return;
    if (hipMemsetAsync(d_ws, 0, 16384, stream) != hipSuccess) { fprintf(stderr, "kernel_launch: memset failed\n"); return; }
    Args a{};
    const float** f = (const float**)&a;
    for (int i = 0; i < 18; ++i) f[i] = (const float*)d_in[i];
    a.out = (float*)d_out; a.ws = (unsigned char*)d_ws;
    void* args[] = {&a};
    hipError_t e = hipLaunchCooperativeKernel((const void*)mega_fwd, dim3(grid), dim3(NTHREADS), args, LDS_BYTES, stream);
    if (e != hipSuccess) fprintf(stderr, "cooperative launch failed: %s (grid %d)\n", hipGetErrorString(e), grid);
}
```

```cpp
#include <hip/hip_runtime.h>
#include <hip/hip_cooperative_groups.h>
#include <cstdio>
#include <cstdint>
namespace cg = cooperative_groups;
namespace pg8 {
#define PG8_LAS __attribute__((address_space(3)))
typedef unsigned short bf16_t;
typedef short bf16x8 __attribute__((ext_vector_type(8)));
typedef float f32x4 __attribute__((ext_vector_type(4)));
typedef unsigned u32x4 __attribute__((ext_vector_type(4)));
constexpr int BM = 256, BK = 64, HALF = 128, HTB = HALF * BK * 2  , STAGE_BYTES = 8 * HTB, NXCD = 8, WGM = 8;

__host__ __device__ __forceinline__ int lds_byte(int r, int c) { const int st = (r >> 4) * 2 + (c >> 5), rr = r & 15, cc = c & 31, ob = rr * 64 + cc * 2; return st * 1024 + (ob ^ (((ob >> 9) & 1) << 5)); }
__host__ __device__ __forceinline__ void stage_rc(int b, int& R, int& C) { const int st = b / 1024, sb = b % 1024, swz = sb ^ (((sb >> 9) & 1) << 5); R = (st >> 1) * 16 + swz / 64; C = (st & 1) * 32 + (swz % 64) / 2; }
__host__ __device__ __forceinline__ int perm32(int rho) { const int n = rho >> 4, i = rho & 15; return 8 * (i >> 2) + 4 * n + (i & 3); }

struct Unit { int pm, pn; };
struct Gemm { const bf16_t* A; const bf16_t* Bt; int M, N, K; };

struct StaticOrder {
    int nM, nN, nwg, G, c;
    __host__ __device__ void init(int M, int N, int G_, int c_) { nM = M / BM; nN = N / BM; nwg = nM * nN; G = G_; c = c_; }
    __host__ __device__ bool next(int i, Unit& u) const {
        const long L = (long)i * G + c; if (L >= nwg) return false;
        int wgid = (int)L; { const int q = nwg / NXCD, r = nwg % NXCD, xcd = wgid % NXCD, off = wgid / NXCD; wgid = (xcd < r ? xcd * (q + 1) : r * (q + 1) + (xcd - r) * q) + off; }
        const int nig = WGM * nN, gid = wgid / nig, fm = gid * WGM, gsz = (nM - fm) < WGM ? (nM - fm) : WGM;
        u.pm = fm + ((wgid % nig) % gsz); u.pn = (wgid % nig) / gsz; return true;
    }
    __device__ __forceinline__ void a_ready(const Unit&) const {}
    __device__ __forceinline__ void done(const Unit&) const {}
};

__device__ __forceinline__ unsigned cvt_pk_bf16(float lo, float hi) { unsigned r; asm volatile("v_cvt_pk_bf16_f32 %0, %1, %2" : "=v"(r) : "v"(lo), "v"(hi)); return r; }
typedef float f32x2 __attribute__((ext_vector_type(2)));
__device__ __forceinline__ f32x2 gelu_pk(f32x2 v) {
    const f32x2 av = __builtin_elementwise_abs(v), d = av * 0.2316418882f + 1.0f;
    f32x2 t; t.x = __builtin_amdgcn_rcpf(d.x); t.y = __builtin_amdgcn_rcpf(d.y);
    f32x2 q = t * 0.5307027145f + (-0.7265760135f); q = q * t + 0.7107068705f; q = q * t + (-0.142248368f); q = q * t + 0.127414796f; q = q * t;
    const f32x2 s = (v * v) * (-0.72134752044f);
    f32x2 e; e.x = __builtin_amdgcn_exp2f(s.x); e.y = __builtin_amdgcn_exp2f(s.y);
    const f32x2 m = v * (q * e), r = v - m;
    f32x2 o; o.x = v.x < 0.f ? m.x : r.x; o.y = v.y < 0.f ? m.y : r.y; return o;
}

typedef float f32x2_t __attribute__((ext_vector_type(2))); typedef __bf16 bf16x2_t __attribute__((ext_vector_type(2)));
__device__ __forceinline__ unsigned cvtpk(float lo, float hi) { f32x2_t v = {lo, hi}; bf16x2_t b = __builtin_convertvector(v, bf16x2_t); return __builtin_bit_cast(unsigned, b); }
__device__ __forceinline__ u32x4 pack8(f32x4 a, f32x4 b) { u32x4 w; w.x = cvtpk(a[0], a[1]); w.y = cvtpk(a[2], a[3]); w.z = cvtpk(b[0], b[1]); w.w = cvtpk(b[2], b[3]); return w; }
__device__ __forceinline__ void unpack8(u32x4 w, f32x4& a, f32x4& b) {
    a[0] = __uint_as_float(w.x << 16); a[1] = __uint_as_float(w.x & 0xffff0000u); a[2] = __uint_as_float(w.y << 16); a[3] = __uint_as_float(w.y & 0xffff0000u);
    b[0] = __uint_as_float(w.z << 16); b[1] = __uint_as_float(w.z & 0xffff0000u); b[2] = __uint_as_float(w.w << 16); b[3] = __uint_as_float(w.w & 0xffff0000u); }
__device__ __forceinline__ float sigm(float x) { return __builtin_amdgcn_rcpf(1.0f + __builtin_amdgcn_exp2f(-1.4426950408889634f * x)); }
__device__ __forceinline__ f32x4 sigm4(f32x4 v) { f32x4 o; o[0] = sigm(v[0]); o[1] = sigm(v[1]); o[2] = sigm(v[2]); o[3] = sigm(v[3]); return o; }
__device__ __forceinline__ f32x4 gelu4(f32x4 v) { f32x2 a = gelu_pk((f32x2){v[0], v[1]}), b = gelu_pk((f32x2){v[2], v[3]}); return (f32x4){a.x, a.y, b.x, b.y}; }
__device__ __forceinline__ float row_rstd(const float* S, int row) {
    const f32x4* p = (const f32x4*)(S + (size_t)row * 16); const f32x4 s = (p[0] + p[1]) + (p[2] + p[3]);
    return rsqrtf(((s[0] + s[1]) + (s[2] + s[3])) * (1.0f / 1024.0f) + 1e-6f); }
constexpr float QSCALE = 0.125f * 1.4426950408889634f;
struct Epi {
    static constexpr bool PERM = true, AFTER_DRAIN = false;
    int mode; bf16_t* Ob; int ldo; float* Of; int ldf; const float* Fin; int ldi; const bf16_t* G; const float* S; float* Sn; const bf16_t* T16; const bf16_t* Xin;
    __device__ __forceinline__ void operator()(const f32x4 (&acc)[2][2][4][2], const Unit& u, int wr, int wc, int fr, int fq) const {
        const int row0 = u.pm * BM + wr * 64 + fr, col0 = u.pn * BM + wc * 32 + 8 * fq;
        if (mode == 1) {
            const int sec = u.pm >> 2; f32x4 rc[2][2];
            { const int lane_ = fq * 16 + fr; const float mine = row_rstd(S, col0 + (fr >> 3) * HALF + (fr & 7));
#pragma unroll
              for (int bj = 0; bj < 2; ++bj)
#pragma unroll
                  for (int n = 0; n < 2; ++n)
#pragma unroll
                      for (int j = 0; j < 4; ++j) rc[bj][n][j] = __shfl(mine, (lane_ & 48) + bj * 8 + n * 4 + j); }
#pragma unroll
            for (int ai = 0; ai < 2; ++ai)
#pragma unroll
                for (int m = 0; m < 4; ++m) { const int row = row0 + ai * HALF + m * 16;
#pragma unroll
                    for (int bj = 0; bj < 2; ++bj) { f32x4 v0 = acc[ai][bj][m][0] * rc[bj][0], v1 = acc[ai][bj][m][1] * rc[bj][1];
                        if (sec == 0) { v0 = gelu4(v0); v1 = gelu4(v1); }
                        *(u32x4*)(Ob + (size_t)row * ldo + col0 + bj * HALF) = pack8(v0, v1); }
                    if (m & 1) asm volatile("" ::: "memory"); }
            return;
        }
        const int sec = u.pn >> 2;
        if (mode == 0 || mode == 5) {
#pragma unroll
            for (int ai = 0; ai < 2; ++ai) {
                float rsr[4];
#pragma unroll
                for (int m = 0; m < 4; ++m) { const f32x4 p = ((const f32x4*)(S + (size_t)(row0 + ai * HALF + m * 16) * 16))[fq]; float s_ = (p[0] + p[1]) + (p[2] + p[3]);
                    s_ += __shfl_xor(s_, 16); s_ += __shfl_xor(s_, 32); rsr[m] = rsqrtf(s_ * (1.0f / 1024.0f) + 1e-6f); }
#pragma unroll
                for (int m = 0; m < 4; ++m) { const int row = row0 + ai * HALF + m * 16; const float rs = rsr[m];
#pragma unroll
                    for (int bj = 0; bj < 2; ++bj) { const int col = col0 + bj * HALF; f32x4 v0 = acc[ai][bj][m][0] * rs, v1 = acc[ai][bj][m][1] * rs;
                        if (mode == 0) {
                            if (sec == 0) { v0 = gelu4(v0); v1 = gelu4(v1); }
                            else if (sec == 1 || sec == 4) { v0 = v0 * sigm4(v0); v1 = v1 * sigm4(v1); }
                            else if (sec == 2) { v0 = v0 * QSCALE; v1 = v1 * QSCALE; }
                            else if (sec >= 5) { v0 = sigm4(v0); v1 = sigm4(v1); }
                            *(u32x4*)(Ob + (size_t)row * ldo + col) = pack8(v0, v1);
                        } else { *(u32x4*)(Ob + (size_t)row * ldo + col) = pack8(sigm4(v0), sigm4(v1)); } }
                    asm volatile("" ::: "memory"); }
            }
            return;
        }
#pragma unroll
        for (int ai = 0; ai < 2; ++ai)
#pragma unroll
            for (int mh = 0; mh < 2; ++mh) {
                u32x4 gq[2][2], tq[2][2], xq[2][2]; f32x4 ta[2][2][2];
#pragma unroll
                for (int mm = 0; mm < 2; ++mm)
#pragma unroll
                    for (int bj = 0; bj < 2; ++bj) { const int row = row0 + ai * HALF + (2 * mh + mm) * 16, col = col0 + bj * HALF;
                        if (mode == 2 || mode == 3) gq[mm][bj] = *(const u32x4*)(G + (size_t)row * 7168 + col);
                        if (mode == 4 && Fin) { const float* t = Fin + (size_t)row * ldi + col; ta[mm][bj][0] = *(const f32x4*)t; ta[mm][bj][1] = *(const f32x4*)(t + 4); }
                        if ((mode == 4 && !Fin) || mode == 6) xq[mm][bj] = *(const u32x4*)(Xin + (size_t)row * 1024 + col);
                        if (mode == 3 || mode == 6) tq[mm][bj] = *(const u32x4*)(T16 + (size_t)row * 7168 + col);
                    }
#pragma unroll
                for (int mm = 0; mm < 2; ++mm) { const int m = 2 * mh + mm; const int row = row0 + ai * HALF + m * 16; float ss = 0.f;
#pragma unroll
                    for (int bj = 0; bj < 2; ++bj) { const int col = col0 + bj * HALF; f32x4 v0 = acc[ai][bj][m][0], v1 = acc[ai][bj][m][1];
                        if (mode == 2) { f32x4 g0, g1; unpack8(gq[mm][bj], g0, g1); *(u32x4*)(Ob + (size_t)row * ldo + col) = pack8(v0 * g0, v1 * g1); }
                        else if (mode == 3) { f32x4 g0, g1, t0, t1; unpack8(gq[mm][bj], g0, g1); unpack8(tq[mm][bj], t0, t1); v0 = t0 + v0 * g0; v1 = t1 + v1 * g1; *(u32x4*)(Ob + (size_t)row * ldo + col) = pack8(v0, v1); }
                        else { if (mode == 4) { if (Fin) { v0 = ta[mm][bj][0] + v0; v1 = ta[mm][bj][1] + v1; } else { f32x4 x0, x1; unpack8(xq[mm][bj], x0, x1); v0 = x0 + v0; v1 = x1 + v1; } }
                            else { f32x4 t0, t1, x0, x1; unpack8(tq[mm][bj], t0, t1); unpack8(xq[mm][bj], x0, x1); v0 = x0 + v0 * t0; v1 = x1 + v1 * t1; }
                            if (Of) { float* o = Of + (size_t)row * ldf + col; *(f32x4*)o = v0; *(f32x4*)(o + 4) = v1; }
                            *(u32x4*)(Ob + (size_t)row * ldo + col) = pack8(v0, v1);
                            ss += (v0[0] * v0[0] + v0[1] * v0[1]) + (v0[2] * v0[2] + v0[3] * v0[3]) + (v1[0] * v1[0] + v1[1] * v1[1]) + (v1[2] * v1[2] + v1[3] * v1[3]); } }
                    if (mode == 4 || mode == 6) { ss += __shfl_xor(ss, 16); ss += __shfl_xor(ss, 32); if (fq == 0) Sn[(size_t)row * 16 + u.pn * 4 + wc] = ss; } }
                asm volatile("" ::: "memory");
            }
    }
};
template <class Epi, class Sched, bool ALIGN_EPI = false, bool SP2 = false>
__device__ __forceinline__ void gemm_phase(PG8_LAS unsigned char* lds, const Gemm g, const Sched& S, const Epi& E) {
    int tid_ = threadIdx.x; asm volatile("" : "+v"(tid_)); const int tid = tid_, wid = __builtin_amdgcn_readfirstlane(tid >> 6), lane = tid & 63, wr = wid >> 2, wc = wid & 3, fr = lane & 15, fq = lane >> 4;
    int K_ = g.K; asm volatile("" : "+s"(K_)); const int K = K_, nt = K / BK;
    unsigned voffA[2], voffB[2];
#pragma unroll
    for (int i = 0; i < 2; ++i) { int R, C; stage_rc(tid * 16 + i * 8192, R, C); const int Rb = Epi::PERM ? ((R & ~31) + perm32(R & 31)) : R;
        voffA[i] = (unsigned)(R * K + C) * 2u; voffB[i] = (unsigned)(Rb * K + C) * 2u; }
    const size_t kstep = (size_t)(BK * 2);
    const size_t hstep = (size_t)HALF * K * 2;
    const size_t tstep = 2 * hstep;
    const unsigned ldsw = (unsigned)wid * 1024u;
    const int aoff = lds_byte(wr * 64 + fr, fq * 8), boff = lds_byte(wc * 32 + fr, fq * 8);
#define PG8_SA(b, h) (((b) * 2 + (h)) * HTB)
#define PG8_SB(b, h) ((4 + (b) * 2 + (h)) * HTB)
#define PG8_STAGE(bufoff, gbase, voff) do { _Pragma("unroll") for (int _i = 0; _i < 2; ++_i) \
        __builtin_amdgcn_global_load_lds((const unsigned*)((const char*)(gbase) + (voff)[_i]), (PG8_LAS unsigned*)(lds + (bufoff) + ldsw + _i * 8192), 16, 0, 0); } while (0)
#define PG8_LDA(dst, b, h) do { _Pragma("unroll") for (int m = 0; m < 4; ++m) _Pragma("unroll") for (int k = 0; k < 2; ++k) dst[m][k] = *(const PG8_LAS bf16x8*)(lds + PG8_SA(b, h) + aoff + m * 2048 + k * 1024); } while (0)
#define PG8_LDB(dst, b, h) do { _Pragma("unroll") for (int n = 0; n < 2; ++n) _Pragma("unroll") for (int k = 0; k < 2; ++k) dst[n][k] = *(const PG8_LAS bf16x8*)(lds + PG8_SB(b, h) + boff + n * 2048 + k * 1024); } while (0)
#define PG8_MMA(ai, bj, At, Bt) do { __builtin_amdgcn_s_setprio(1); _Pragma("unroll") for (int m = 0; m < 4; ++m) _Pragma("unroll") for (int n = 0; n < 2; ++n) _Pragma("unroll") for (int k = 0; k < 2; ++k) \
        acc[ai][bj][m][n] = __builtin_amdgcn_mfma_f32_16x16x32_bf16(Bt[n][k], At[m][k], acc[ai][bj][m][n], 0, 0, 0); __builtin_amdgcn_s_setprio(0); } while (0)
#define PG8_WAIT_V(n) asm volatile("s_waitcnt vmcnt(" #n ")" ::: "memory")
#define PG8_WAIT_L(n) asm volatile("s_waitcnt lgkmcnt(" #n ")" ::: "memory")
#define PG8_BAR __builtin_amdgcn_s_barrier()
#define PG8_SCHED __builtin_amdgcn_sched_barrier(0)
    Unit cur, nxt; int ui = 0;
    if (!S.next(0, cur)) return;
    f32x4 acc[2][2][4][2];
#pragma unroll
    for (int a = 0; a < 2; ++a)
#pragma unroll
        for (int b = 0; b < 2; ++b)
#pragma unroll
            for (int m = 0; m < 4; ++m)
#pragma unroll
                for (int n = 0; n < 2; ++n) acc[a][b][m][n] = (f32x4){0.f, 0.f, 0.f, 0.f};
    bf16x8 At[4][2], B0[2][2], B1[2][2];
    const char* cA = (const char*)g.A + (size_t)cur.pm * tstep; const char* cB = (const char*)g.Bt + (size_t)cur.pn * tstep;
    S.a_ready(cur);
    if constexpr (SP2) {
        PG8_STAGE(PG8_SB(0, 0), cB, voffB); PG8_STAGE(PG8_SB(0, 1), cB + hstep, voffB); PG8_STAGE(PG8_SA(0, 0), cA, voffA); PG8_STAGE(PG8_SA(0, 1), cA + hstep, voffA);
        if (wr == 1) PG8_BAR;
        PG8_WAIT_V(2); PG8_BAR;
        PG8_STAGE(PG8_SB(1, 0), cB + kstep, voffB); PG8_STAGE(PG8_SA(1, 0), cA + kstep, voffA); PG8_STAGE(PG8_SB(1, 1), cB + hstep + kstep, voffB);
        PG8_WAIT_V(6); PG8_BAR;
    } else {
        PG8_STAGE(PG8_SB(0, 0), cB, voffB); PG8_STAGE(PG8_SA(0, 0), cA, voffA); PG8_STAGE(PG8_SB(0, 1), cB + hstep, voffB); PG8_STAGE(PG8_SA(0, 1), cA + hstep, voffA);
        if (wr == 1) PG8_BAR;
        PG8_WAIT_V(4); PG8_BAR;
        PG8_STAGE(PG8_SB(1, 0), cB + kstep, voffB); PG8_STAGE(PG8_SA(1, 0), cA + kstep, voffA); PG8_STAGE(PG8_SB(1, 1), cB + hstep + kstep, voffB);
        PG8_WAIT_V(6); PG8_BAR;
    }
    for (;;) {
        const bool has_next = S.next(ui + 1, nxt);
        const char* nA = has_next ? (const char*)g.A + (size_t)nxt.pm * tstep : cA; const char* nB = has_next ? (const char*)g.Bt + (size_t)nxt.pn * tstep : cB;
        for (int t = 0; t < nt; t += 2) {
            const bool last = (t == nt - 2);
            const char* a1 = cA + (size_t)(t + 1) * kstep;
            const char* a2 = last ? nA : cA + (size_t)(t + 2) * kstep; const char* b2 = last ? nB : cB + (size_t)(t + 2) * kstep;
            const char* a3 = a2 + kstep; const char* b3 = b2 + kstep;
            if (last && has_next) S.a_ready(nxt);
            if constexpr (SP2) {
            PG8_LDB(B0, 0, 0); PG8_LDB(B1, 0, 1); PG8_SCHED; PG8_LDA(At, 0, 0); PG8_STAGE(PG8_SA(1, 1), a1 + hstep, voffA);
            PG8_WAIT_V(8); PG8_WAIT_L(0); PG8_BAR; PG8_MMA(0, 0, At, B0); PG8_MMA(0, 1, At, B1); PG8_BAR; PG8_SCHED;
            PG8_LDA(At, 0, 1); PG8_STAGE(PG8_SB(0, 0), b2, voffB); PG8_STAGE(PG8_SB(0, 1), b2 + hstep, voffB); PG8_STAGE(PG8_SA(0, 0), a2, voffA);
            PG8_WAIT_V(8); PG8_WAIT_L(0); PG8_BAR; PG8_MMA(1, 0, At, B0); PG8_MMA(1, 1, At, B1); PG8_BAR; PG8_SCHED;
            PG8_LDB(B0, 1, 0); PG8_LDB(B1, 1, 1); PG8_SCHED; PG8_LDA(At, 1, 0); PG8_STAGE(PG8_SA(0, 1), a2 + hstep, voffA);
            PG8_WAIT_V(8); PG8_WAIT_L(0); PG8_BAR; PG8_MMA(0, 0, At, B0); PG8_MMA(0, 1, At, B1); PG8_BAR; PG8_SCHED;
            PG8_LDA(At, 1, 1); PG8_STAGE(PG8_SB(1, 0), b3, voffB); PG8_STAGE(PG8_SB(1, 1), b3 + hstep, voffB); PG8_STAGE(PG8_SA(1, 0), a3, voffA);
            PG8_WAIT_V(8); PG8_WAIT_L(0); PG8_BAR; PG8_MMA(1, 0, At, B0); PG8_MMA(1, 1, At, B1); PG8_BAR; PG8_SCHED;
            } else {
            PG8_LDB(B0, 0, 0); PG8_SCHED; PG8_LDA(At, 0, 0); PG8_STAGE(PG8_SA(1, 1), a1 + hstep, voffA);
            PG8_WAIT_L(8); PG8_BAR; PG8_WAIT_L(0); PG8_MMA(0, 0, At, B0); PG8_BAR; PG8_SCHED;
            PG8_LDB(B1, 0, 1); PG8_STAGE(PG8_SB(0, 0), b2, voffB);
            PG8_BAR; PG8_WAIT_L(0); PG8_MMA(0, 1, At, B1); PG8_BAR;
            PG8_LDA(At, 0, 1); PG8_STAGE(PG8_SA(0, 0), a2, voffA);
            PG8_BAR; PG8_WAIT_L(0); PG8_MMA(1, 0, At, B0); PG8_BAR; PG8_SCHED;
            PG8_STAGE(PG8_SB(0, 1), b2 + hstep, voffB);
            PG8_WAIT_V(6); PG8_BAR; PG8_MMA(1, 1, At, B1); PG8_BAR;
            PG8_LDB(B0, 1, 0); PG8_SCHED; PG8_LDA(At, 1, 0); PG8_STAGE(PG8_SA(0, 1), a2 + hstep, voffA);
            PG8_WAIT_L(8); PG8_BAR; PG8_WAIT_L(0); PG8_MMA(0, 0, At, B0); PG8_BAR; PG8_SCHED;
            PG8_LDB(B1, 1, 1); PG8_STAGE(PG8_SB(1, 0), b3, voffB);
            PG8_BAR; PG8_WAIT_L(0); PG8_MMA(0, 1, At, B1); PG8_BAR;
            PG8_LDA(At, 1, 1); PG8_STAGE(PG8_SA(1, 0), a3, voffA);
            PG8_BAR; PG8_WAIT_L(0); PG8_MMA(1, 0, At, B0); PG8_BAR; PG8_SCHED;
            PG8_STAGE(PG8_SB(1, 1), b3 + hstep, voffB);
            PG8_WAIT_V(6); PG8_BAR; PG8_MMA(1, 1, At, B1); PG8_BAR;
            }
        }
        if constexpr (ALIGN_EPI) { if (wr == 0) PG8_BAR; }
        if constexpr (!Epi::AFTER_DRAIN) { E(acc, cur, wr, wc, fr, fq); S.done(cur); }
        if (!has_next) break;
#pragma unroll
        for (int a = 0; a < 2; ++a)
#pragma unroll
            for (int b = 0; b < 2; ++b)
#pragma unroll
                for (int m = 0; m < 4; ++m)
#pragma unroll
                    for (int n = 0; n < 2; ++n) acc[a][b][m][n] = (f32x4){0.f, 0.f, 0.f, 0.f};
        cur = nxt; cA = nA; cB = nB; ++ui;
        if constexpr (ALIGN_EPI) { if (wr == 1) PG8_BAR; }
    }
    PG8_WAIT_V(0);
    if constexpr (!ALIGN_EPI) { if (wr == 0) PG8_BAR; }
    PG8_BAR;
    if constexpr (Epi::AFTER_DRAIN) { E.fused(acc, cur, wr, wc, fr, fq, lds, wid, lane); S.done(cur); }
#undef PG8_SA
#undef PG8_SB
#undef PG8_STAGE
#undef PG8_LDA
#undef PG8_LDB
#undef PG8_MMA
#undef PG8_WAIT_V
#undef PG8_WAIT_L
#undef PG8_BAR
#undef PG8_SCHED
}
}

#define LAS __attribute__((address_space(3)))
typedef unsigned short bf16_t;
typedef short bf16x8 __attribute__((ext_vector_type(8)));
typedef float f32x4 __attribute__((ext_vector_type(4)));
typedef float f32x16 __attribute__((ext_vector_type(16)));
typedef unsigned u32x4 __attribute__((ext_vector_type(4)));
typedef unsigned u32x2 __attribute__((ext_vector_type(2)));
using pg8::cvtpk; using pg8::pack8; using pg8::unpack8;
constexpr int NTHREADS = 512, NWAVES = 8;
constexpr int MH = 16384, DM = 1024, SEQ = 4096, NB_H = 4, NLAYER = 4, NP1 = 7168, NV2 = 2048, PLE = 256, NHEAD = 8;
constexpr size_t MiB = 1u << 20;
constexpr size_t LW_IN = 0, LW_A = (size_t)9216 * 1024, LW_B = LW_A + 1048576, LW_O = LW_B + 1048576, LW_G = LW_O + 1048576, LW_P = LW_G + 1048576, LW_TOTAL = LW_P + 262144;
constexpr size_t WS_W = 1 * MiB, WS_PROJ = 108 * MiB, WS_VT2 = 332 * MiB, WS_X0 = 396 * MiB, WS_X1 = 428 * MiB, WS_BRA = 460 * MiB, WS_BRB = 492 * MiB, WS_PB = 524 * MiB, WS_S0 = 532 * MiB, WS_S1 = 533 * MiB, WS_END = 534 * MiB;
static_assert(WS_W + LW_TOTAL * 2 * NLAYER <= WS_PROJ, "weights fit");
constexpr int TMP_LD = NP1 / 2;
constexpr int LDS_BYTES = 147456;
constexpr float EPS = 1e-6f;

struct Args {
    const float *x, *p, *norm_g, *w_in, *a_ln_g, *a_ln_b, *a_ws, *a_bs, *lam_q, *lam_k, *subln_g, *w_a_out, *w_b_out, *w_o, *ple_norm_g, *w_ple, *w_ple_gate, *final_g;
    float* out; unsigned char* ws;
};

__device__ __forceinline__ float wave_sum(float v) {
#pragma unroll
    for (int o = 1; o < 64; o <<= 1) v += __shfl_xor(v, o);
    return v;
}
#define LDS_WAIT() asm volatile("s_waitcnt lgkmcnt(0)" ::: "memory")

__device__ __forceinline__ void tr_item(const float* W, int K, int N, const float* scale, bf16_t* WT, int dst_row0, LAS float* scr, int k0, int n0, int lane) {
    f32x4 v[8];
#pragma unroll
    for (int i = 0; i < 8; ++i) v[i] = *(const f32x4*)(W + (size_t)(k0 + 4 * i + (lane >> 4)) * N + n0 + (lane & 15) * 4);
#pragma unroll
    for (int i = 0; i < 8; ++i) { const int kk = 4 * i + (lane >> 4); f32x4 x = v[i]; if (scale) x = x * scale[k0 + kk]; *(LAS f32x4*)(scr + kk * 68 + (lane & 15) * 4) = x; }
    LDS_WAIT(); asm volatile("" ::: "memory");
    bf16_t* o = WT + (size_t)(dst_row0 + lane) * K + k0;
#pragma unroll
    for (int j = 0; j < 4; ++j) { const LAS float* s = scr + (8 * j) * 68 + lane;
        u32x4 w; w.x = cvtpk(s[0 * 68], s[1 * 68]); w.y = cvtpk(s[2 * 68], s[3 * 68]); w.z = cvtpk(s[4 * 68], s[5 * 68]); w.w = cvtpk(s[6 * 68], s[7 * 68]);
        *(u32x4*)(o + 8 * j) = w; }
    LDS_WAIT(); asm volatile("" ::: "memory");
}
typedef const __attribute__((address_space(4))) Args* cargs_t;
__device__ __forceinline__ void weights_prologue(cargs_t ap, LAS unsigned char* lds, int gw, int ngw, int wave, int lane) {
    LAS float* scr = (LAS float*)(lds + wave * 16384);
    bf16_t* WT = (bf16_t*)(ap->ws + WS_W);
    constexpr int I_IN = 32 * 144, I_SQ = 32 * 16, I_P = 8 * 16, I_L = I_IN + 4 * I_SQ + I_P;
    for (int it = gw; it < I_L * NLAYER; it += ngw) {
        const int l = it / I_L; int r = it % I_L; bf16_t* wl = WT + (size_t)l * LW_TOTAL;
        if (r < I_IN) { const int kb = r / 144, nb = r % 144, n0 = nb * 64; const int osec = n0 >> 10;
            const int nsec = (int)((0x654832170ull >> (4 * osec)) & 0xFull);
            tr_item(ap->w_in + (size_t)l * 1024 * 9216, 1024, 9216, ap->norm_g + l * 1024, wl + LW_IN, nsec * 1024 + (n0 & 1023), scr, kb * 32, n0, lane);
            continue; }
        r -= I_IN;
        if (r < 4 * I_SQ) { const int which = r / I_SQ; const int rr = r % I_SQ; const int kb = rr / 16, nb = rr % 16;
            const float* src = which == 0 ? ap->w_a_out : which == 1 ? ap->w_b_out : which == 2 ? ap->w_o : ap->w_ple_gate;
            const size_t off = which == 0 ? LW_A : which == 1 ? LW_B : which == 2 ? LW_O : LW_G;
            tr_item(src + (size_t)l * 1048576, 1024, 1024, which == 3 ? ap->ple_norm_g + l * 1024 : nullptr, wl + off, nb * 64, scr, kb * 32, nb * 64, lane);
            continue; }
        r -= 4 * I_SQ;
        { const int kb = r / 16, nb = r % 16; tr_item(ap->w_ple + (size_t)l * 262144, 256, 1024, nullptr, wl + LW_P, nb * 64, scr, kb * 32, nb * 64, lane); }
    }
}

__device__ __forceinline__ void init_rows(const float* x, bf16_t* XB, float* S, int gw, int ngw, int lane) {
    asm volatile("" : "+v"(lane)); asm volatile("" : "+s"(gw));
    for (int m = gw; m < MH; m += ngw) {
        const f32x4* xr = (const f32x4*)(x + (size_t)m * DM) + lane; float s = 0.f; f32x4 v[4];
#pragma unroll
        for (int j = 0; j < 4; ++j) { v[j] = xr[64 * j]; s += (v[j][0] * v[j][0] + v[j][1] * v[j][1]) + (v[j][2] * v[j][2] + v[j][3] * v[j][3]); }
        s = wave_sum(s);
        u32x2* o = (u32x2*)(XB + (size_t)m * DM) + lane;
#pragma unroll
        for (int j = 0; j < 4; ++j) { u32x2 w; w.x = cvtpk(v[j][0], v[j][1]); w.y = cvtpk(v[j][2], v[j][3]); o[64 * j] = w; }
        if (lane < 16) S[(size_t)m * 16 + lane] = lane == 0 ? s : 0.f;
    }
}
__device__ __forceinline__ void final_rows(float* out, const float* g, int gw, int ngw, int lane) {
    asm volatile("" : "+v"(lane)); asm volatile("" : "+s"(gw));
    for (int m = gw; m < MH; m += ngw) {
        f32x4* xr = (f32x4*)(out + (size_t)m * DM) + lane; float s = 0.f; f32x4 v[4];
#pragma unroll
        for (int j = 0; j < 4; ++j) { v[j] = xr[64 * j]; s += (v[j][0] * v[j][0] + v[j][1] * v[j][1]) + (v[j][2] * v[j][2] + v[j][3] * v[j][3]); }
        const float rs = rsqrtf(wave_sum(s) * (1.0f / DM) + EPS);
#pragma unroll
        for (int j = 0; j < 4; ++j) { const f32x4 gg = ((const f32x4*)g)[64 * j + lane]; xr[64 * j] = v[j] * rs * gg; }
    }
}
__device__ __forceinline__ void convert_p(const float* p, bf16_t* PB, int gtid, int nthr) {
    asm volatile("" : "+v"(gtid));
    for (int i = gtid; i < MH * PLE / 8; i += nthr) { const f32x4 a = ((const f32x4*)p)[2 * i], b = ((const f32x4*)p)[2 * i + 1]; ((u32x4*)PB)[i] = pack8(a, b); }
}

__device__ __forceinline__ void gmlp_unit(LAS unsigned char* lds, const bf16_t* PROJ, const bf16_t* VT2, bf16_t* BRA, const float* lng, const float* lnb, const float* ws, const float* bs, int c, int gh) {
    int tid_ = threadIdx.x; asm volatile("" : "+v"(tid_)); const int tid = tid_, lane = tid & 63, l32 = lane & 31, hi = lane >> 5; const int w = __builtin_amdgcn_readfirstlane(tid >> 6);
    const int tok0 = c * 128;
    LAS float* red = (LAS float*)lds;
    LAS float* stat = (LAS float*)(lds + 32768);
    LAS unsigned char* T = lds + 34816;
    { const int sc = tid & 15, rg = tid >> 4; float s[8], q[8];
#pragma unroll
      for (int j = 0; j < 8; ++j) { s[j] = 0.f; q[j] = 0.f; }
      for (int i = 0; i < 32; ++i) { const u32x4 wv = *(const u32x4*)(VT2 + (size_t)(rg + 32 * i) * MH + tok0 + sc * 8); f32x4 a, b; unpack8(wv, a, b);
#pragma unroll
          for (int j = 0; j < 4; ++j) { s[j] += a[j]; q[j] += a[j] * a[j]; s[4 + j] += b[j]; q[4 + j] += b[j] * b[j]; } }
#pragma unroll
      for (int j = 0; j < 8; ++j) { red[rg * 256 + sc * 8 + j] = s[j]; red[rg * 256 + 128 + sc * 8 + j] = q[j]; } }
    __syncthreads();
    if (tid < 128) { float s = 0.f, q = 0.f;
        for (int i = 0; i < 32; ++i) { s += red[i * 256 + tid]; q += red[i * 256 + 128 + tid]; }
        const float mean = s * (1.0f / 1024.0f); const float var = q * (1.0f / 1024.0f) - mean * mean;
        stat[2 * tid] = mean; stat[2 * tid + 1] = rsqrtf(var + EPS); }
    __syncthreads();
    const int tb = w & 3, dh = w >> 2;
    u32x4 pre[4];
#pragma unroll
    for (int i = 0; i < 4; ++i) { const int p = tid + 512 * i; pre[i] = *(const u32x4*)(VT2 + (size_t)(gh * 512 + (p >> 4)) * MH + tok0 + (p & 15) * 8); }
    for (int gi = 0; gi < 4; ++gi) { const int g = gh * 4 + gi;
#pragma unroll
        for (int i = 0; i < 4; ++i) { const int p = tid + 512 * i, d = p >> 4, sc = p & 15;
            f32x4 a, b; unpack8(pre[i], a, b);
            const float gg = lng[g * 128 + d], bb = lnb[g * 128 + d];
#pragma unroll
            for (int j = 0; j < 4; ++j) { a[j] = (a[j] - stat[2 * (sc * 8 + j)]) * stat[2 * (sc * 8 + j) + 1] * gg + bb; b[j] = (b[j] - stat[2 * (sc * 8 + 4 + j)]) * stat[2 * (sc * 8 + 4 + j) + 1] * gg + bb; }
            *(LAS u32x4*)(T + d * 272 + sc * 16) = pack8(a, b); }
        if (gi < 3) {
#pragma unroll
            for (int i = 0; i < 4; ++i) { const int p = tid + 512 * i; pre[i] = *(const u32x4*)(VT2 + (size_t)((g + 1) * 128 + (p >> 4)) * MH + tok0 + (p & 15) * 8); } }
        __syncthreads();
        f32x16 acc0 = {}, acc1 = {};
        const float* wrow = ws + (size_t)g * 16384 + (size_t)(32 * tb + l32) * 128 + 8 * hi;
        const int trow = 32 * tb + l32;
        for (int ks = 0; ks < 2 * tb + 2; ++ks) {
            f32x4 wa = *(const f32x4*)(wrow + 16 * ks), wb = *(const f32x4*)(wrow + 16 * ks + 4); const int s0 = 16 * ks + 8 * hi;
#pragma unroll
            for (int j = 0; j < 4; ++j) { if (s0 + j > trow) wa[j] = 0.f; if (s0 + 4 + j > trow) wb[j] = 0.f; }
            const bf16x8 A = __builtin_bit_cast(bf16x8, pack8(wa, wb));
            const bf16x8 B0 = *(const LAS bf16x8*)(T + (64 * dh + l32) * 272 + (16 * ks + 8 * hi) * 2);
            const bf16x8 B1 = *(const LAS bf16x8*)(T + (64 * dh + 32 + l32) * 272 + (16 * ks + 8 * hi) * 2);
            acc0 = __builtin_amdgcn_mfma_f32_32x32x16_bf16(A, B0, acc0, 0, 0, 0);
            acc1 = __builtin_amdgcn_mfma_f32_32x32x16_bf16(A, B1, acc1, 0, 0, 0);
        }
        LAS float* Yb = (LAS float*)(lds + 71680);
#pragma unroll
        for (int r = 0; r < 16; ++r) { const int t = 32 * tb + (r & 3) + 8 * (r >> 2) + 4 * hi; const float bv = bs[g * 128 + t];
            Yb[t * 132 + 64 * dh + l32] = acc0[r] + bv; Yb[t * 132 + 64 * dh + 32 + l32] = acc1[r] + bv; }
        __syncthreads();
#pragma unroll
        for (int i = 0; i < 4; ++i) { const int p = tid + 512 * i, t = p >> 4, c8 = p & 15; const size_t tok = (size_t)(tok0 + t); const int col = g * 128 + c8 * 8;
            f32x4 u0, u1, z0, z1; unpack8(*(const u32x4*)(PROJ + tok * NP1 + col), u0, u1); unpack8(*(const u32x4*)(PROJ + tok * NP1 + 1024 + col), z0, z1);
            const f32x4 y0 = *(const LAS f32x4*)(Yb + t * 132 + c8 * 8), y1 = *(const LAS f32x4*)(Yb + t * 132 + c8 * 8 + 4);
            *(u32x4*)(BRA + tok * DM + col) = pack8(u0 * y0 * z0, u1 * y1 * z1); }
        __syncthreads();
    }
}

constexpr int AT_KS = 17408, AT_VS = 18432, AT_VOFF = 2 * AT_KS;
__device__ __forceinline__ void attn_unit(LAS unsigned char* lds, const bf16_t* PROJ, const bf16_t* VT2, bf16_t* BRB, const float* subg, float lam, float lam_init, int b, int h, int qb) {
    int tid_ = threadIdx.x; asm volatile("" : "+v"(tid_)); const int tid = tid_, lane = tid & 63, l32 = lane & 31, hi = lane >> 5; const int w = __builtin_amdgcn_readfirstlane(tid >> 6); const int map = w >> 2, wq = w & 3;
    const int rowbase = b * SEQ, q0 = qb * 128, myq = q0 + wq * 32 + l32, NT = 2 * qb + 2;
    bf16x8 qf[4];
    { const bf16_t* qp = PROJ + (size_t)(rowbase + myq) * NP1 + 2048 + h * 128 + map * 64 + hi * 8;
#pragma unroll
      for (int ks = 0; ks < 4; ++ks) qf[ks] = *(const bf16x8*)(qp + ks * 16); }
    const bf16_t* ksrc[2]; const bf16_t* vsrc[2]; int kdst[2], vdst[2];
#pragma unroll
    for (int i = 0; i < 2; ++i) { const int p = tid + 512 * i;
        ksrc[i] = PROJ + (size_t)(rowbase + (p >> 4)) * NP1 + 3072 + h * 128 + (p & 15) * 8; kdst[i] = (p >> 4) * 272 + (p & 15) * 16;
        vsrc[i] = VT2 + (size_t)(1024 + h * 128 + (p >> 3)) * MH + rowbase + (p & 7) * 8; vdst[i] = AT_VOFF + (p >> 3) * 144 + (((p & 7) >> 1) * 16 + (p & 1) * 4) * 2; }
    u32x4 kr[2], vr[2];
#pragma unroll
    for (int i = 0; i < 2; ++i) { kr[i] = *(const u32x4*)(ksrc[i]); vr[i] = *(const u32x4*)(vsrc[i]); }
#pragma unroll
    for (int i = 0; i < 2; ++i) { *(LAS u32x4*)(lds + kdst[i]) = kr[i]; *(LAS u32x2*)(lds + vdst[i]) = (u32x2){vr[i].x, vr[i].y}; *(LAS u32x2*)(lds + vdst[i] + 16) = (u32x2){vr[i].z, vr[i].w}; }
    __syncthreads();
    f32x16 O[4]; O[0] = f32x16{}; O[1] = f32x16{}; O[2] = f32x16{}; O[3] = f32x16{};
    float m_run = -1e30f, l_run = 0.f;
    for (int t = 0; t < NT; ++t) {
        const int buf = t & 1, kv0 = 64 * t;
        if (t + 1 < NT) {
#pragma unroll
            for (int i = 0; i < 2; ++i) { kr[i] = *(const u32x4*)(ksrc[i] + (size_t)(kv0 + 64) * NP1); vr[i] = *(const u32x4*)(vsrc[i] + kv0 + 64); } }
        if (kv0 <= q0 + wq * 32 + 31) {
            LAS unsigned char* Kb = lds + buf * AT_KS + l32 * 272 + map * 128 + hi * 16;
            LAS unsigned char* Vb = lds + AT_VOFF + buf * AT_VS + l32 * 144 + hi * 16;
            f32x16 S0 = {}, S1 = {};
            { bf16x8 kf[8];
#pragma unroll
              for (int ks = 0; ks < 4; ++ks) { kf[2 * ks] = *(const LAS bf16x8*)(Kb + ks * 32); kf[2 * ks + 1] = *(const LAS bf16x8*)(Kb + 32 * 272 + ks * 32); }
              __builtin_amdgcn_sched_barrier(0);
#pragma unroll
              for (int ks = 0; ks < 4; ++ks) { S0 = __builtin_amdgcn_mfma_f32_32x32x16_bf16(kf[2 * ks], qf[ks], S0, 0, 0, 0); S1 = __builtin_amdgcn_mfma_f32_32x32x16_bf16(kf[2 * ks + 1], qf[ks], S1, 0, 0, 0); } }
            u32x4 va[8], vb[8];
#pragma unroll
            for (int j = 0; j < 2; ++j)
#pragma unroll
                for (int db = 0; db < 4; ++db) va[j * 4 + db] = *(const LAS u32x4*)(Vb + db * 32 * 144 + j * 32);
            __builtin_amdgcn_sched_barrier(0);
            if (t >= NT - 2) {
#pragma unroll
                for (int r = 0; r < 16; ++r) { const int kv = kv0 + (r & 3) + 8 * (r >> 2) + 4 * hi; if (kv > myq) S0[r] = -1e30f; if (kv + 32 > myq) S1[r] = -1e30f; } }
            float mx = __builtin_fmaxf(__builtin_fmaxf(S0[0], S1[0]), __builtin_fmaxf(S0[1], S1[1]));
#pragma unroll
            for (int r = 2; r < 16; r += 2) { mx = __builtin_fmaxf(__builtin_fmaxf(mx, S0[r]), S1[r]); mx = __builtin_fmaxf(__builtin_fmaxf(mx, S0[r + 1]), S1[r + 1]); }
            mx = fmaxf(mx, __shfl_xor(mx, 32));
            if (__any(mx > m_run)) { const float mnew = fmaxf(m_run, mx), alpha = __builtin_amdgcn_exp2f(m_run - mnew); m_run = mnew; l_run *= alpha;
#pragma unroll
                for (int db = 0; db < 4; ++db)
#pragma unroll
                    for (int r = 0; r < 16; ++r) O[db][r] *= alpha; }
            pg8::f32x2 ps2 = {0.f, 0.f};
#pragma unroll
            for (int r = 0; r < 16; r += 2) { S0[r] = __builtin_amdgcn_exp2f(S0[r] - m_run); S0[r + 1] = __builtin_amdgcn_exp2f(S0[r + 1] - m_run); ps2 += (pg8::f32x2){S0[r], S0[r + 1]}; }
            bf16x8 pf[4];
#pragma unroll
            for (int j = 0; j < 2; ++j) { u32x4 pw;
#pragma unroll
                for (int i = 0; i < 4; ++i) pw[i] = cvtpk(S0[8 * j + 2 * i], S0[8 * j + 2 * i + 1]);
                pf[j] = __builtin_bit_cast(bf16x8, pw); }
#pragma unroll
            for (int j = 2; j < 4; ++j)
#pragma unroll
                for (int db = 0; db < 4; ++db) vb[(j - 2) * 4 + db] = *(const LAS u32x4*)(Vb + db * 32 * 144 + j * 32);
            __builtin_amdgcn_sched_barrier(0);
#pragma unroll
            for (int j = 0; j < 2; ++j)
#pragma unroll
                for (int db = 0; db < 4; ++db) O[db] = __builtin_amdgcn_mfma_f32_32x32x16_bf16(__builtin_bit_cast(bf16x8, va[j * 4 + db]), pf[j], O[db], 0, 0, 0);
#pragma unroll
            for (int r = 0; r < 16; r += 2) { S1[r] = __builtin_amdgcn_exp2f(S1[r] - m_run); S1[r + 1] = __builtin_amdgcn_exp2f(S1[r + 1] - m_run); ps2 += (pg8::f32x2){S1[r], S1[r + 1]}; }
#pragma unroll
            for (int j = 2; j < 4; ++j) { u32x4 pw;
#pragma unroll
                for (int i = 0; i < 4; ++i) pw[i] = cvtpk(S1[8 * (j & 1) + 2 * i], S1[8 * (j & 1) + 2 * i + 1]);
                pf[j] = __builtin_bit_cast(bf16x8, pw); }
#pragma unroll
            for (int k = 0; k < 8; ++k) { __builtin_amdgcn_sched_group_barrier(0x008, 1, 0); __builtin_amdgcn_sched_group_barrier(0x002, 6, 0); }
            __builtin_amdgcn_sched_barrier(0);
            l_run += ps2.x + ps2.y;
#pragma unroll
            for (int j = 2; j < 4; ++j)
#pragma unroll
                for (int db = 0; db < 4; ++db) O[db] = __builtin_amdgcn_mfma_f32_32x32x16_bf16(__builtin_bit_cast(bf16x8, vb[(j - 2) * 4 + db]), pf[j], O[db], 0, 0, 0);
        }
        if (t + 1 < NT) {
#pragma unroll
            for (int i = 0; i < 2; ++i) { *(LAS u32x4*)(lds + (buf ^ 1) * AT_KS + kdst[i]) = kr[i]; *(LAS u32x2*)(lds + (buf ^ 1) * AT_VS + vdst[i]) = (u32x2){vr[i].x, vr[i].y}; *(LAS u32x2*)(lds + (buf ^ 1) * AT_VS + vdst[i] + 16) = (u32x2){vr[i].z, vr[i].w}; } }
        __syncthreads();
    }
    const float inv = 1.0f / (l_run + __shfl_xor(l_run, 32));
    LAS float* X = (LAS float*)lds + wq * 4096 + lane;
    if (map == 1) { const float sc = -lam * inv;
#pragma unroll
        for (int db = 0; db < 4; ++db)
#pragma unroll
            for (int r = 0; r < 16; ++r) X[(db * 16 + r) * 64] = O[db][r] * sc; }
    __syncthreads();
    if (map == 0) { float ss = 0.f;
#pragma unroll
        for (int db = 0; db < 4; ++db)
#pragma unroll
            for (int r = 0; r < 16; ++r) { const float o = O[db][r] * inv + X[(db * 16 + r) * 64]; O[db][r] = o; ss += o * o; }
        ss += __shfl_xor(ss, 32);
        const float rs = rsqrtf(ss * (1.0f / 128.0f) + EPS) * (1.0f - lam_init);
        LAS float* Zr = (LAS float*)(lds + 65536) + (wq * 32 + l32) * 132;
#pragma unroll
        for (int db = 0; db < 4; ++db)
#pragma unroll
            for (int rg = 0; rg < 4; ++rg) { const int d = 32 * db + 8 * rg + 4 * hi; const f32x4 gg = *(const f32x4*)(subg + d);
                *(LAS f32x4*)(Zr + d) = (f32x4){O[db][4 * rg] * rs * gg[0], O[db][4 * rg + 1] * rs * gg[1], O[db][4 * rg + 2] * rs * gg[2], O[db][4 * rg + 3] * rs * gg[3]}; } }
    __syncthreads();
#pragma unroll
    for (int i = 0; i < 4; ++i) { const int p = tid + 512 * i, q = p >> 4, c8 = p & 15; const size_t row = (size_t)(rowbase + q0 + q);
        f32x4 z0, z1; unpack8(*(const u32x4*)(PROJ + row * NP1 + 4096 + h * 128 + c8 * 8), z0, z1);
        const LAS float* zp = (const LAS float*)(lds + 65536) + q * 132 + c8 * 8;
        const f32x4 v0 = *(const LAS f32x4*)zp, v1 = *(const LAS f32x4*)(zp + 4);
        *(u32x4*)(BRB + row * DM + h * 128 + c8 * 8) = pack8(v0 * z0, v1 * z1); }
    __syncthreads();
}

#define RLX_AGENT __ATOMIC_RELAXED, __HIP_MEMORY_SCOPE_AGENT
#define XB_TMO      128
#define XB_XCNT(j)  (256  + 64 * (j))
#define XB_XSUB(j)  (1280 + 64 * (j))
#define XB_XGEN(j)  (2304 + 64 * (j))
#define XB_TOP      3328
#define XB_TOPGEN   3392
#define XCD_BAR_WORDS 3456
#define XB_SPIN_CAP (1u << 18)

__device__ __forceinline__ unsigned xb_ld(unsigned* p)              { return __hip_atomic_load(p, __ATOMIC_RELAXED, __HIP_MEMORY_SCOPE_AGENT); }
__device__ __forceinline__ unsigned xb_add(unsigned* p, unsigned v) { return __hip_atomic_fetch_add(p, v, __ATOMIC_RELAXED, __HIP_MEMORY_SCOPE_AGENT); }
__device__ __forceinline__ unsigned xb_xcc_id() { return (unsigned)__builtin_amdgcn_s_getreg((3 << 11) | 20) & 0xFu; }
#define XB_SPIN(cond, bar) do { unsigned _sp = 0; while (cond) { __builtin_amdgcn_s_sleep(1); \
    if ((++_sp & 255u) == 0u) { if (xb_ld(&(bar)[XB_TMO])) break; if (_sp > XB_SPIN_CAP) { atomicAdd(&(bar)[XB_TMO], 1u); break; } } } } while (0)

struct XcdBarrier {
    unsigned* bar; unsigned x;
    volatile LAS unsigned* st;
};

__device__ __forceinline__ XcdBarrier xcd_barrier_post(unsigned* bar, volatile LAS unsigned* st) {
    XcdBarrier b; b.bar = bar; b.x = xb_xcc_id(); b.st = st;
    if (threadIdx.x == 0) (void)xb_add(&bar[XB_XCNT(b.x)], 1u);
    return b;
}
__device__ __forceinline__ void xcd_barrier_complete(unsigned* bar, unsigned x, unsigned& nloc, unsigned& nx) {
    const unsigned G = gridDim.x * gridDim.y * gridDim.z;
    unsigned sum, cnt, mine, sp = 0u;
    for (;;) {
        sum = 0u; cnt = 0u; mine = 0u;
#pragma unroll
        for (unsigned j = 0; j < 16; ++j) { const unsigned c = xb_ld(&bar[XB_XCNT(j)]); sum += c; cnt += (c > 0u) ? 1u : 0u; mine = (j == x) ? c : mine; }
        if (sum == G) break;
        __builtin_amdgcn_s_sleep(1);
        if ((++sp & 255u) == 0u) { if (xb_ld(&bar[XB_TMO])) break; if (sp > XB_SPIN_CAP) { atomicAdd(&bar[XB_TMO], 1u); break; } }
    }
    nloc = mine > 0u ? mine : 1u; nx = cnt > 0u ? cnt : 1u;
}

__device__ __forceinline__ void xcd_barrier(const XcdBarrier& b) {
    asm volatile("s_waitcnt vmcnt(0)" ::: "memory");
    __syncthreads();
    if (threadIdx.x == 0) {
        unsigned* bar = b.bar;
        __builtin_amdgcn_s_waitcnt(0);
        unsigned nloc = b.st[0], nx = b.st[1];
        if (nloc == 0u) { xcd_barrier_complete(bar, b.x, nloc, nx); b.st[0] = nloc; b.st[1] = nx; }
        const unsigned old = xb_add(&bar[XB_XSUB(b.x)], 1u);
        const unsigned gen = old / nloc;
        if (old + 1u == (gen + 1u) * nloc) {
            __builtin_amdgcn_fence(__ATOMIC_RELEASE, "agent");
            asm volatile("s_waitcnt vmcnt(0)" ::: "memory");
            const unsigned og = xb_add(&bar[XB_TOP], 1u);
            const unsigned tg = og / nx;
            if (og + 1u == (tg + 1u) * nx) xb_add(&bar[XB_TOPGEN], 1u);
            else XB_SPIN(xb_ld(&bar[XB_TOPGEN]) == tg, bar);
            __builtin_amdgcn_fence(__ATOMIC_ACQUIRE, "agent");
            xb_add(&bar[XB_XGEN(b.x)], 1u);
            asm volatile("s_waitcnt vmcnt(0)" ::: "memory");
        } else {
            XB_SPIN(xb_ld(&bar[XB_XGEN(b.x)]) == gen, bar);
            __builtin_amdgcn_fence(__ATOMIC_ACQUIRE, "agent");
            asm volatile("s_waitcnt vmcnt(0)" ::: "memory");
        }
    }
    __syncthreads();
}


__global__ void __launch_bounds__(NTHREADS, 2) mega_fwd(Args a_unused) {
    extern __shared__ __attribute__((aligned(16))) unsigned char lds_raw[];
    LAS unsigned char* lds = (LAS unsigned char*)lds_raw;
    cg::grid_group grid = cg::this_grid();
    const int tid = threadIdx.x, lane = tid & 63, wave = __builtin_amdgcn_readfirstlane(tid >> 6);
    const int G = gridDim.x, bx = blockIdx.x;
    const int vcu = (G % 8 == 0) ? (bx % 8) * (G / 8) + bx / 8 : bx;
    const int gw = vcu * NWAVES + wave, ngw = G * NWAVES;
#define ARGS() cargs_t ap = (cargs_t)__builtin_amdgcn_kernarg_segment_ptr(); asm volatile("" : "+s"(ap)); unsigned char* const ws = ap->ws
#define GSYNC() xcd_barrier(xbar)
#define WSP(T, off) ((T*)(ws + (off)))
#define XBP(ci) ((bf16_t*)(ws + ((ci) ? WS_X1 : WS_X0)))
#define SXP(ci) ((float*)(ws + ((ci) ? WS_S1 : WS_S0)))
#define TMPP ((float*)(ws + WS_PROJ + 4096))
    if (tid < 64) ((LAS unsigned*)(lds + 147200))[tid] = 0u;
    __syncthreads();
    grid.sync();
    XcdBarrier xbar;
    { ARGS(); xbar = xcd_barrier_post((unsigned*)ws, (volatile LAS unsigned*)(lds + 147200)); }
    { ARGS(); weights_prologue(ap, lds, gw, ngw, wave, lane); }

#define DUMP_BF16(buf_off, nelem) do { ARGS(); const bf16_t* B_ = WSP(bf16_t, buf_off); float* o_ = ap->out; \
    for (size_t i_ = (size_t)bx * NTHREADS + tid; i_ < (size_t)2 * MH * DM; i_ += (size_t)G * NTHREADS) o_[i_] = __uint_as_float((unsigned)B_[i_ % (size_t)(nelem)] << 16); } while (0)
    for (int hf = 0; hf < 2; ++hf) {
        { ARGS(); init_rows(ap->x + (size_t)hf * MH * DM, XBP(0), SXP(0), gw, ngw, lane); }
        GSYNC();
        int c = 0;
        for (int l = 0; l < NLAYER; ++l) {
            { ARGS(); convert_p(ap->p + ((size_t)l * 2 * MH + (size_t)hf * MH) * PLE, WSP(bf16_t, WS_PB), bx * NTHREADS + tid, G * NTHREADS); }
#if !defined(ONLY) || ONLY == 0
            { ARGS(); const bf16_t* wl = WSP(bf16_t, WS_W) + (size_t)l * LW_TOTAL;
              pg8::Gemm g{XBP(c), wl + LW_IN, MH, NP1, DM}; pg8::StaticOrder S; S.init(MH, NP1, G, bx);
              pg8::Epi E{0, WSP(bf16_t, WS_PROJ), NP1, nullptr, 0, nullptr, 0, nullptr, SXP(c), nullptr, nullptr, nullptr};
              pg8::gemm_phase<pg8::Epi, pg8::StaticOrder, true, true>(lds, g, S, E); }
#endif
#if !defined(ONLY) || ONLY == 1
            { ARGS(); const bf16_t* wl = WSP(bf16_t, WS_W) + (size_t)l * LW_TOTAL;
              pg8::Gemm g{wl + LW_IN + (size_t)NP1 * DM, XBP(c), NV2, MH, DM}; pg8::StaticOrder S; S.init(NV2, MH, G, bx);
              pg8::Epi E{1, WSP(bf16_t, WS_VT2), MH, nullptr, 0, nullptr, 0, nullptr, SXP(c), nullptr, nullptr, nullptr};
              pg8::gemm_phase<pg8::Epi, pg8::StaticOrder, true, true>(lds, g, S, E); }
#endif
            GSYNC();
#if defined(STOP_AFTER) && STOP_AFTER == 1
            DUMP_BF16(WS_PROJ, (size_t)MH * NP1); return;
#endif
#if defined(STOP_AFTER) && STOP_AFTER == 11
            DUMP_BF16(WS_VT2, (size_t)MH * NV2); return;
#endif
#ifndef NO_GMLP
            { ARGS();
              for (int u = vcu; u < 256; u += G)
                gmlp_unit(lds, WSP(bf16_t, WS_PROJ), WSP(bf16_t, WS_VT2), WSP(bf16_t, WS_BRA), ap->a_ln_g + l * 1024, ap->a_ln_b + l * 1024, ap->a_ws + (size_t)l * 131072, ap->a_bs + l * 1024, u >> 1, u & 1); }
#endif
#ifdef NO_ATTN
            { ARGS(); const bf16_t* PR = WSP(bf16_t, WS_PROJ); bf16_t* B = WSP(bf16_t, WS_BRB);
              for (int i = bx * NTHREADS + tid; i < MH * DM / 8; i += G * NTHREADS) { const int row = i >> 7, c8 = i & 127; *(u32x4*)(B + (size_t)row * DM + c8 * 8) = *(const u32x4*)(PR + (size_t)row * NP1 + 4096 + c8 * 8); } }
#endif
#ifdef NO_GMLP
            { ARGS(); const bf16_t* PR = WSP(bf16_t, WS_PROJ); bf16_t* B = WSP(bf16_t, WS_BRA);
              for (int i = bx * NTHREADS + tid; i < MH * DM / 8; i += G * NTHREADS) { const int row = i >> 7, c8 = i & 127; *(u32x4*)(B + (size_t)row * DM + c8 * 8) = *(const u32x4*)(PR + (size_t)row * NP1 + c8 * 8); } }
#endif
#ifndef NO_ATTN
            { ARGS();
              const float lam_init = 0.8f - 0.6f * expf(-0.3f * (float)l);
              const float d0 = wave_sum(ap->lam_q[l * 128 + lane] * ap->lam_k[l * 128 + lane]), d1 = wave_sum(ap->lam_q[l * 128 + 64 + lane] * ap->lam_k[l * 128 + 64 + lane]);
              const float lam = expf(d0) - expf(d1) + lam_init;
              for (int pu = vcu; pu < 512; pu += G) { const int bh = pu >> 4, s = pu & 15;
                  attn_unit(lds, WSP(bf16_t, WS_PROJ), WSP(bf16_t, WS_VT2), WSP(bf16_t, WS_BRB), ap->subln_g + l * 128, lam, lam_init, bh >> 3, bh & 7, 31 - s);
                  attn_unit(lds, WSP(bf16_t, WS_PROJ), WSP(bf16_t, WS_VT2), WSP(bf16_t, WS_BRB), ap->subln_g + l * 128, lam, lam_init, bh >> 3, bh & 7, s); } }
#endif
            GSYNC();
#if !defined(ONLY) || ONLY == 2
            { ARGS(); const bf16_t* wl = WSP(bf16_t, WS_W) + (size_t)l * LW_TOTAL;
              pg8::Gemm g{WSP(bf16_t, WS_BRA), wl + LW_A, MH, DM, DM}; pg8::StaticOrder S; S.init(MH, DM, G, bx);
              pg8::Epi E{2, WSP(bf16_t, WS_PROJ) + 2048, NP1, nullptr, 0, nullptr, 0, WSP(bf16_t, WS_PROJ) + 5120, nullptr, nullptr, nullptr, nullptr};
              pg8::gemm_phase<pg8::Epi, pg8::StaticOrder, true, true>(lds, g, S, E); }
#endif
#if !defined(ONLY) || ONLY == 3
            { ARGS(); const bf16_t* wl = WSP(bf16_t, WS_W) + (size_t)l * LW_TOTAL;
              pg8::Gemm g{WSP(bf16_t, WS_BRB), wl + LW_B, MH, DM, DM}; pg8::StaticOrder S; S.init(MH, DM, G, bx);
              pg8::Epi E{3, XBP(1 - c), DM, nullptr, 0, nullptr, 0, WSP(bf16_t, WS_PROJ) + 6144, nullptr, nullptr, WSP(bf16_t, WS_PROJ) + 2048, nullptr};
              pg8::gemm_phase<pg8::Epi, pg8::StaticOrder, true, true>(lds, g, S, E); }
#endif
            GSYNC();
#if defined(STOP_AFTER) && STOP_AFTER == 3
            if (c == 0) DUMP_BF16(WS_X1, (size_t)MH * DM); else DUMP_BF16(WS_X0, (size_t)MH * DM); return;
#endif
#if !defined(ONLY) || ONLY == 4
            { ARGS(); const bf16_t* wl = WSP(bf16_t, WS_W) + (size_t)l * LW_TOTAL; float* out = ap->out + (size_t)hf * MH * DM;
              pg8::Gemm g{XBP(1 - c), wl + LW_O, MH, DM, DM}; pg8::StaticOrder S; S.init(MH, DM, G, bx);
              pg8::Epi E{4, XBP(c), DM, nullptr, 0, l == 0 ? ap->x + (size_t)hf * MH * DM : (const float*)nullptr, DM, nullptr, nullptr, SXP(c), nullptr, XBP(c)};
              pg8::gemm_phase<pg8::Epi, pg8::StaticOrder, true, true>(lds, g, S, E); }
#endif
            GSYNC();
#if defined(STOP_AFTER) && STOP_AFTER == 4
            if (c == 0) DUMP_BF16(WS_X0, (size_t)MH * DM); else DUMP_BF16(WS_X1, (size_t)MH * DM); return;
#endif
#if !defined(ONLY) || ONLY == 5
            { ARGS(); const bf16_t* wl = WSP(bf16_t, WS_W) + (size_t)l * LW_TOTAL;
              pg8::Gemm g{XBP(c), wl + LW_G, MH, DM, DM}; pg8::StaticOrder S; S.init(MH, DM, G, bx);
              pg8::Epi E{5, WSP(bf16_t, WS_PROJ) + 2048, NP1, nullptr, 0, nullptr, 0, nullptr, SXP(c), nullptr, nullptr, nullptr};
              pg8::gemm_phase<pg8::Epi, pg8::StaticOrder, true, true>(lds, g, S, E); }
#endif
#if !defined(ONLY) || ONLY == 6
            { ARGS(); const bf16_t* wl = WSP(bf16_t, WS_W) + (size_t)l * LW_TOTAL; float* out = ap->out + (size_t)hf * MH * DM;
              pg8::Gemm g{WSP(bf16_t, WS_PB), wl + LW_P, MH, DM, PLE}; pg8::StaticOrder S; S.init(MH, DM, G, bx);
              pg8::Epi E{6, XBP(1 - c), DM, l == NLAYER - 1 ? out : (float*)nullptr, DM, nullptr, 0, nullptr, nullptr, SXP(1 - c), WSP(bf16_t, WS_PROJ) + 2048, XBP(c)};
              pg8::gemm_phase<pg8::Epi, pg8::StaticOrder, true, true>(lds, g, S, E); }
#endif
            GSYNC();
#if defined(STOP_AFTER) && STOP_AFTER == 5
            if (c == 0) DUMP_BF16(WS_X1, (size_t)MH * DM); else DUMP_BF16(WS_X0, (size_t)MH * DM); return;
#endif
            c ^= 1;
        }
        { ARGS(); final_rows(ap->out + (size_t)hf * MH * DM, ap->final_g, gw, ngw, lane); }
    }
}

extern "C" void kernel_launch(void* const* d_in, const int* in_sizes, int n_in, void* d_out, int out_size, void* d_ws, size_t ws_size, hipStream_t stream) {
    static int grid = 0;
    if (grid == 0) {
        if (n_in != 18 || ws_size < WS_END) { fprintf(stderr, "kernel_launch: unexpected n_in %d / ws_size %zu (need %zu)\n", n_in, ws_size, (size_t)WS_END); grid = -1; return; }
        int dev = 0, cus = 0, per_cu = 0;
        hipGetDevice(&dev); hipDeviceGetAttribute(&cus, hipDeviceAttributeMultiprocessorCount, dev);
        if (hipFuncSetAttribute((const void*)mega_fwd, hipFuncAttributeMaxDynamicSharedMemorySize, LDS_BYTES) != hipSuccess) { fprintf(stderr, "kernel_launch: hipFuncSetAttribute failed\n"); grid = -1; return; }
        if (hipOccupancyMaxActiveBlocksPerMultiprocessor(&per_cu, (const void*)mega_fwd, NTHREADS, LDS_BYTES) != hipSuccess || per_cu < 1) { fprintf(stderr, "kernel_launch: occupancy query gives %d\n", per_cu); per_cu = 1; }
        (void)hipGetLastError();
        grid = cus;
    }
    if (grid < 0) return;
    if (hipMemsetAsync(d_ws, 0, 16384, stream) != hipSuccess) { fprintf(stderr, "kernel_launch: memset failed\n"); return; }
    Args a{};
    const float** f = (const float**)&a;
    for (int i = 0; i < 18; ++i) f[i] = (const float*)d_in[i];
    a.out = (float*)d_out; a.ws = (unsigned char*)d_ws;
    void* args[] = {&a};
    hipError_t e = hipLaunchCooperativeKernel((const void*)mega_fwd, dim3(grid), dim3(NTHREADS), args, LDS_BYTES, stream);
    if (e != hipSuccess) fprintf(stderr, "cooperative launch failed: %s (grid %d)\n", hipGetErrorString(e), grid);
}
```

```cpp
#include <hip/hip_runtime.h>
#include <hip/hip_cooperative_groups.h>
#include <cstdio>
#include <cstdint>
namespace cg = cooperative_groups;
template <int M> __device__ __forceinline__ float xor_lt32(float v) { return __builtin_bit_cast(float, __builtin_amdgcn_ds_swizzle(__builtin_bit_cast(int, v), (M << 10) | 0x1F)); }
__device__ __forceinline__ float xor32_add(float v) { const unsigned b = __builtin_bit_cast(unsigned, v); auto rr = __builtin_amdgcn_permlane32_swap(b, b, false, false); return __builtin_bit_cast(float, (unsigned)rr[0]) + __builtin_bit_cast(float, (unsigned)rr[1]); }
__device__ __forceinline__ float xor32_max(float v) { const unsigned b = __builtin_bit_cast(unsigned, v); auto rr = __builtin_amdgcn_permlane32_swap(b, b, false, false); return fmaxf(__builtin_bit_cast(float, (unsigned)rr[0]), __builtin_bit_cast(float, (unsigned)rr[1])); }
__device__ __forceinline__ int lane_id_() { int l_; asm volatile("v_mbcnt_lo_u32_b32 %0, -1, 0\n\tv_mbcnt_hi_u32_b32 %0, -1, %0" : "=&v"(l_)); return l_; }
namespace pg8 {
#define PG8_LAS __attribute__((address_space(3)))
typedef unsigned short bf16_t;
typedef short bf16x8 __attribute__((ext_vector_type(8)));
typedef float f32x4 __attribute__((ext_vector_type(4)));
typedef unsigned u32x4 __attribute__((ext_vector_type(4)));
constexpr int BM = 256, BK = 64, HALF = 128, HTB = HALF * BK * 2  , STAGE_BYTES = 8 * HTB, NXCD = 8, WGM = 8;

__host__ __device__ __forceinline__ int lds_byte(int r, int c) { const int st = (r >> 4) * 2 + (c >> 5), rr = r & 15, cc = c & 31, ob = rr * 64 + cc * 2; return st * 1024 + (ob ^ (((ob >> 9) & 1) << 5)); }
__host__ __device__ __forceinline__ void stage_rc(int b, int& R, int& C) { const int st = b / 1024, sb = b % 1024, swz = sb ^ (((sb >> 9) & 1) << 5); R = (st >> 1) * 16 + swz / 64; C = (st & 1) * 32 + (swz % 64) / 2; }
__host__ __device__ __forceinline__ int perm32(int rho) { const int n = rho >> 4, i = rho & 15; return 8 * (i >> 2) + 4 * n + (i & 3); }

struct Unit { int pm, pn; };
struct Gemm { const bf16_t* A; const bf16_t* Bt; int M, N, K; };

struct StaticOrder {
    int nM, nN, nwg, G, c;
    __host__ __device__ void init(int M, int N, int G_, int c_) { nM = M / BM; nN = N / BM; nwg = nM * nN; G = G_; c = c_; }
    __host__ __device__ bool next(int i, Unit& u) const {
        const long L = (long)i * G + c; if (L >= nwg) return false;
        int wgid = (int)L; { const int q = nwg / NXCD, r = nwg % NXCD, xcd = wgid % NXCD, off = wgid / NXCD; wgid = (xcd < r ? xcd * (q + 1) : r * (q + 1) + (xcd - r) * q) + off; }
        const int nig = WGM * nN, gid = wgid / nig, fm = gid * WGM, gsz = (nM - fm) < WGM ? (nM - fm) : WGM;
        u.pm = fm + ((wgid % nig) % gsz); u.pn = (wgid % nig) / gsz; return true;
    }
    __device__ __forceinline__ void a_ready(const Unit&) const {}
    __device__ __forceinline__ void done(const Unit&) const {}
};

__device__ __forceinline__ unsigned cvt_pk_bf16(float lo, float hi) { unsigned r; asm volatile("v_cvt_pk_bf16_f32 %0, %1, %2" : "=v"(r) : "v"(lo), "v"(hi)); return r; }
typedef float f32x2 __attribute__((ext_vector_type(2)));
__device__ __forceinline__ f32x2 gelu_pk(f32x2 v) {
    const f32x2 av = __builtin_elementwise_abs(v), d = av * 0.2316418882f + 1.0f;
    f32x2 t; t.x = __builtin_amdgcn_rcpf(d.x); t.y = __builtin_amdgcn_rcpf(d.y);
    f32x2 q = t * 0.5307027145f + (-0.7265760135f); q = q * t + 0.7107068705f; q = q * t + (-0.142248368f); q = q * t + 0.127414796f; q = q * t;
    const f32x2 s = (v * v) * (-0.72134752044f);
    f32x2 e; e.x = __builtin_amdgcn_exp2f(s.x); e.y = __builtin_amdgcn_exp2f(s.y);
    const f32x2 m = v * (q * e), r = v - m;
    f32x2 o; o.x = v.x < 0.f ? m.x : r.x; o.y = v.y < 0.f ? m.y : r.y; return o;
}

typedef float f32x2_t __attribute__((ext_vector_type(2))); typedef __bf16 bf16x2_t __attribute__((ext_vector_type(2)));
__device__ __forceinline__ unsigned cvtpk(float lo, float hi) { f32x2_t v = {lo, hi}; bf16x2_t b = __builtin_convertvector(v, bf16x2_t); return __builtin_bit_cast(unsigned, b); }
__device__ __forceinline__ u32x4 pack8(f32x4 a, f32x4 b) { u32x4 w; w.x = cvtpk(a[0], a[1]); w.y = cvtpk(a[2], a[3]); w.z = cvtpk(b[0], b[1]); w.w = cvtpk(b[2], b[3]); return w; }
__device__ __forceinline__ void unpack8(u32x4 w, f32x4& a, f32x4& b) {
    a[0] = __uint_as_float(w.x << 16); a[1] = __uint_as_float(w.x & 0xffff0000u); a[2] = __uint_as_float(w.y << 16); a[3] = __uint_as_float(w.y & 0xffff0000u);
    b[0] = __uint_as_float(w.z << 16); b[1] = __uint_as_float(w.z & 0xffff0000u); b[2] = __uint_as_float(w.w << 16); b[3] = __uint_as_float(w.w & 0xffff0000u); }
__device__ __forceinline__ float sigm(float x) { return __builtin_amdgcn_rcpf(1.0f + __builtin_amdgcn_exp2f(-1.4426950408889634f * x)); }
__device__ __forceinline__ f32x4 sigm4(f32x4 v) { f32x4 o; o[0] = sigm(v[0]); o[1] = sigm(v[1]); o[2] = sigm(v[2]); o[3] = sigm(v[3]); return o; }
__device__ __forceinline__ f32x4 gelu4(f32x4 v) { f32x2 a = gelu_pk((f32x2){v[0], v[1]}), b = gelu_pk((f32x2){v[2], v[3]}); return (f32x4){a.x, a.y, b.x, b.y}; }
__device__ __forceinline__ float row_rstd(const float* S, int row) {
    const f32x4* p = (const f32x4*)(S + (size_t)row * 16); const f32x4 s = (p[0] + p[1]) + (p[2] + p[3]);
    return rsqrtf(((s[0] + s[1]) + (s[2] + s[3])) * (1.0f / 1024.0f) + 1e-6f); }
constexpr float QSCALE = 0.125f * 1.4426950408889634f;
struct Epi {
    static constexpr bool PERM = true, AFTER_DRAIN = false;
    int mode; bf16_t* Ob; int ldo; float* Of; int ldf; const float* Fin; int ldi; const bf16_t* G; const float* S; float* Sn; const bf16_t* T16; const bf16_t* Xin;
    __device__ __forceinline__ void operator()(const f32x4 (&acc)[2][2][4][2], const Unit& u, int wr, int wc, int fr, int fq) const {
        const int row0 = u.pm * BM + wr * 64 + fr, col0 = u.pn * BM + wc * 32 + 8 * fq;
        if (mode == 1) {
            const int sec = u.pm >> 2; f32x4 rc[2][2];
            { const int lane_ = fq * 16 + fr; const float mine = row_rstd(S, col0 + (fr >> 3) * HALF + (fr & 7));
#pragma unroll
              for (int bj = 0; bj < 2; ++bj)
#pragma unroll
                  for (int n = 0; n < 2; ++n)
#pragma unroll
                      for (int j = 0; j < 4; ++j) rc[bj][n][j] = __shfl(mine, (lane_ & 48) + bj * 8 + n * 4 + j); }
#pragma unroll
            for (int ai = 0; ai < 2; ++ai)
#pragma unroll
                for (int m = 0; m < 4; ++m) { const int row = row0 + ai * HALF + m * 16;
#pragma unroll
                    for (int bj = 0; bj < 2; ++bj) { f32x4 v0 = acc[ai][bj][m][0] * rc[bj][0], v1 = acc[ai][bj][m][1] * rc[bj][1];
                        if (sec == 0) { v0 = gelu4(v0); v1 = gelu4(v1); }
                        *(u32x4*)(Ob + (size_t)row * ldo + col0 + bj * HALF) = pack8(v0, v1); }
                    if (m & 1) asm volatile("" ::: "memory"); }
            return;
        }
        const int sec = u.pn >> 2;
        if (mode == 0 || mode == 5) {
#pragma unroll
            for (int ai = 0; ai < 2; ++ai) {
                float rsr[4];
#pragma unroll
                for (int m = 0; m < 4; ++m) { const f32x4 p = ((const f32x4*)(S + (size_t)(row0 + ai * HALF + m * 16) * 16))[fq]; float s_ = (p[0] + p[1]) + (p[2] + p[3]);
                    s_ += __shfl_xor(s_, 16); s_ += __shfl_xor(s_, 32); rsr[m] = rsqrtf(s_ * (1.0f / 1024.0f) + 1e-6f); }
#pragma unroll
                for (int m = 0; m < 4; ++m) { const int row = row0 + ai * HALF + m * 16; const float rs = rsr[m];
#pragma unroll
                    for (int bj = 0; bj < 2; ++bj) { const int col = col0 + bj * HALF; f32x4 v0 = acc[ai][bj][m][0] * rs, v1 = acc[ai][bj][m][1] * rs;
                        if (mode == 0) {
                            if (sec == 0) { v0 = gelu4(v0); v1 = gelu4(v1); }
                            else if (sec == 1 || sec == 4) { v0 = v0 * sigm4(v0); v1 = v1 * sigm4(v1); }
                            else if (sec == 2) { v0 = v0 * QSCALE; v1 = v1 * QSCALE; }
                            else if (sec >= 5) { v0 = sigm4(v0); v1 = sigm4(v1); }
                            *(u32x4*)(Ob + (size_t)row * ldo + col) = pack8(v0, v1);
                        } else { *(u32x4*)(Ob + (size_t)row * ldo + col) = pack8(sigm4(v0), sigm4(v1)); } }
                    asm volatile("" ::: "memory"); }
            }
            return;
        }
#pragma unroll
        for (int ai = 0; ai < 2; ++ai)
#pragma unroll
            for (int mh = 0; mh < 2; ++mh) {
                u32x4 gq[2][2], tq[2][2], xq[2][2]; f32x4 ta[2][2][2];
#pragma unroll
                for (int mm = 0; mm < 2; ++mm)
#pragma unroll
                    for (int bj = 0; bj < 2; ++bj) { const int row = row0 + ai * HALF + (2 * mh + mm) * 16, col = col0 + bj * HALF;
                        if (mode == 2 || mode == 3) gq[mm][bj] = *(const u32x4*)(G + (size_t)row * 7168 + col);
                        if (mode == 4 && Fin) { const float* t = Fin + (size_t)row * ldi + col; ta[mm][bj][0] = *(const f32x4*)t; ta[mm][bj][1] = *(const f32x4*)(t + 4); }
                        if ((mode == 4 && !Fin) || mode == 6) xq[mm][bj] = *(const u32x4*)(Xin + (size_t)row * 1024 + col);
                        if (mode == 3 || mode == 6) tq[mm][bj] = *(const u32x4*)(T16 + (size_t)row * 7168 + col);
                    }
#pragma unroll
                for (int mm = 0; mm < 2; ++mm) { const int m = 2 * mh + mm; const int row = row0 + ai * HALF + m * 16; float ss = 0.f;
#pragma unroll
                    for (int bj = 0; bj < 2; ++bj) { const int col = col0 + bj * HALF; f32x4 v0 = acc[ai][bj][m][0], v1 = acc[ai][bj][m][1];
                        if (mode == 2) { f32x4 g0, g1; unpack8(gq[mm][bj], g0, g1); *(u32x4*)(Ob + (size_t)row * ldo + col) = pack8(v0 * g0, v1 * g1); }
                        else if (mode == 3) { f32x4 g0, g1, t0, t1; unpack8(gq[mm][bj], g0, g1); unpack8(tq[mm][bj], t0, t1); v0 = t0 + v0 * g0; v1 = t1 + v1 * g1; *(u32x4*)(Ob + (size_t)row * ldo + col) = pack8(v0, v1); }
                        else { if (mode == 4) { if (Fin) { v0 = ta[mm][bj][0] + v0; v1 = ta[mm][bj][1] + v1; } else { f32x4 x0, x1; unpack8(xq[mm][bj], x0, x1); v0 = x0 + v0; v1 = x1 + v1; } }
                            else { f32x4 t0, t1, x0, x1; unpack8(tq[mm][bj], t0, t1); unpack8(xq[mm][bj], x0, x1); v0 = x0 + v0 * t0; v1 = x1 + v1 * t1; }
                            if (Of) { float* o = Of + (size_t)row * ldf + col; *(f32x4*)o = v0; *(f32x4*)(o + 4) = v1; }
                            *(u32x4*)(Ob + (size_t)row * ldo + col) = pack8(v0, v1);
                            ss += (v0[0] * v0[0] + v0[1] * v0[1]) + (v0[2] * v0[2] + v0[3] * v0[3]) + (v1[0] * v1[0] + v1[1] * v1[1]) + (v1[2] * v1[2] + v1[3] * v1[3]); } }
                    if (mode == 4 || mode == 6) { ss += __shfl_xor(ss, 16); ss += __shfl_xor(ss, 32); if (fq == 0) Sn[(size_t)row * 16 + u.pn * 4 + wc] = ss; } }
                asm volatile("" ::: "memory");
            }
    }
};
template <class Epi, class Sched, bool ALIGN_EPI = false, bool SP2 = false>
__device__ __forceinline__ void gemm_phase(PG8_LAS unsigned char* lds, const Gemm g, const Sched& S, const Epi& E) {
    int tid_ = threadIdx.x; asm volatile("" : "+v"(tid_)); const int tid = tid_, wid = __builtin_amdgcn_readfirstlane(tid >> 6), lane = tid & 63, wr = wid >> 2, wc = wid & 3, fr = lane & 15, fq = lane >> 4;
    int K_ = g.K; asm volatile("" : "+s"(K_)); const int K = K_, nt = K / BK;
    unsigned voffA[2], voffB[2];
#pragma unroll
    for (int i = 0; i < 2; ++i) { int R, C; stage_rc(tid * 16 + i * 8192, R, C); const int Rb = Epi::PERM ? ((R & ~31) + perm32(R & 31)) : R;
        voffA[i] = (unsigned)(R * K + C) * 2u; voffB[i] = (unsigned)(Rb * K + C) * 2u; }
    const size_t kstep = (size_t)(BK * 2);
    const size_t hstep = (size_t)HALF * K * 2;
    const size_t tstep = 2 * hstep;
    const unsigned ldsw = (unsigned)wid * 1024u;
    const int aoff = lds_byte(wr * 64 + fr, fq * 8), boff = lds_byte(wc * 32 + fr, fq * 8);
#define PG8_SA(b, h) (((b) * 2 + (h)) * HTB)
#define PG8_SB(b, h) ((4 + (b) * 2 + (h)) * HTB)
#define PG8_STAGE(bufoff, gbase, voff) do { _Pragma("unroll") for (int _i = 0; _i < 2; ++_i) \
        __builtin_amdgcn_global_load_lds((const unsigned*)((const char*)(gbase) + (voff)[_i]), (PG8_LAS unsigned*)(lds + (bufoff) + ldsw + _i * 8192), 16, 0, 0); } while (0)
#define PG8_LDA(dst, b, h) do { _Pragma("unroll") for (int m = 0; m < 4; ++m) _Pragma("unroll") for (int k = 0; k < 2; ++k) dst[m][k] = *(const PG8_LAS bf16x8*)(lds + PG8_SA(b, h) + aoff + m * 2048 + k * 1024); } while (0)
#define PG8_LDB(dst, b, h) do { _Pragma("unroll") for (int n = 0; n < 2; ++n) _Pragma("unroll") for (int k = 0; k < 2; ++k) dst[n][k] = *(const PG8_LAS bf16x8*)(lds + PG8_SB(b, h) + boff + n * 2048 + k * 1024); } while (0)
#define PG8_MMA(ai, bj, At, Bt) do { __builtin_amdgcn_s_setprio(1); _Pragma("unroll") for (int m = 0; m < 4; ++m) _Pragma("unroll") for (int n = 0; n < 2; ++n) _Pragma("unroll") for (int k = 0; k < 2; ++k) \
        acc[ai][bj][m][n] = __builtin_amdgcn_mfma_f32_16x16x32_bf16(Bt[n][k], At[m][k], acc[ai][bj][m][n], 0, 0, 0); __builtin_amdgcn_s_setprio(0); } while (0)
#define PG8_WAIT_V(n) asm volatile("s_waitcnt vmcnt(" #n ")" ::: "memory")
#define PG8_WAIT_L(n) asm volatile("s_waitcnt lgkmcnt(" #n ")" ::: "memory")
#define PG8_BAR __builtin_amdgcn_s_barrier()
#define PG8_SCHED __builtin_amdgcn_sched_barrier(0)
    Unit cur, nxt; int ui = 0;
    if (!S.next(0, cur)) return;
    f32x4 acc[2][2][4][2];
#pragma unroll
    for (int a = 0; a < 2; ++a)
#pragma unroll
        for (int b = 0; b < 2; ++b)
#pragma unroll
            for (int m = 0; m < 4; ++m)
#pragma unroll
                for (int n = 0; n < 2; ++n) acc[a][b][m][n] = (f32x4){0.f, 0.f, 0.f, 0.f};
    bf16x8 At[4][2], B0[2][2], B1[2][2];
    const char* cA = (const char*)g.A + (size_t)cur.pm * tstep; const char* cB = (const char*)g.Bt + (size_t)cur.pn * tstep;
    S.a_ready(cur);
    if constexpr (SP2) {
        PG8_STAGE(PG8_SB(0, 0), cB, voffB); PG8_STAGE(PG8_SB(0, 1), cB + hstep, voffB); PG8_STAGE(PG8_SA(0, 0), cA, voffA); PG8_STAGE(PG8_SA(0, 1), cA + hstep, voffA);
        if (wr == 1) PG8_BAR;
        PG8_WAIT_V(2); PG8_BAR;
        PG8_STAGE(PG8_SB(1, 0), cB + kstep, voffB); PG8_STAGE(PG8_SA(1, 0), cA + kstep, voffA); PG8_STAGE(PG8_SB(1, 1), cB + hstep + kstep, voffB);
        PG8_WAIT_V(6); PG8_BAR;
    } else {
        PG8_STAGE(PG8_SB(0, 0), cB, voffB); PG8_STAGE(PG8_SA(0, 0), cA, voffA); PG8_STAGE(PG8_SB(0, 1), cB + hstep, voffB); PG8_STAGE(PG8_SA(0, 1), cA + hstep, voffA);
        if (wr == 1) PG8_BAR;
        PG8_WAIT_V(4); PG8_BAR;
        PG8_STAGE(PG8_SB(1, 0), cB + kstep, voffB); PG8_STAGE(PG8_SA(1, 0), cA + kstep, voffA); PG8_STAGE(PG8_SB(1, 1), cB + hstep + kstep, voffB);
        PG8_WAIT_V(6); PG8_BAR;
    }
    for (;;) {
        const bool has_next = S.next(ui + 1, nxt);
        const char* nA = has_next ? (const char*)g.A + (size_t)nxt.pm * tstep : cA; const char* nB = has_next ? (const char*)g.Bt + (size_t)nxt.pn * tstep : cB;
        for (int t = 0; t < nt; t += 2) {
            const bool last = (t == nt - 2);
            const char* a1 = cA + (size_t)(t + 1) * kstep;
            const char* a2 = last ? nA : cA + (size_t)(t + 2) * kstep; const char* b2 = last ? nB : cB + (size_t)(t + 2) * kstep;
            const char* a3 = a2 + kstep; const char* b3 = b2 + kstep;
            if (last && has_next) S.a_ready(nxt);
            if constexpr (SP2) {
            PG8_LDB(B0, 0, 0); PG8_LDB(B1, 0, 1); PG8_SCHED; PG8_LDA(At, 0, 0); PG8_STAGE(PG8_SA(1, 1), a1 + hstep, voffA);
            PG8_WAIT_V(8); PG8_WAIT_L(0); PG8_BAR; PG8_MMA(0, 0, At, B0); PG8_MMA(0, 1, At, B1); PG8_BAR; PG8_SCHED;
            PG8_LDA(At, 0, 1); PG8_STAGE(PG8_SB(0, 0), b2, voffB); PG8_STAGE(PG8_SB(0, 1), b2 + hstep, voffB); PG8_STAGE(PG8_SA(0, 0), a2, voffA);
            PG8_WAIT_V(8); PG8_WAIT_L(0); PG8_BAR; PG8_MMA(1, 0, At, B0); PG8_MMA(1, 1, At, B1); PG8_BAR; PG8_SCHED;
            PG8_LDB(B0, 1, 0); PG8_LDB(B1, 1, 1); PG8_SCHED; PG8_LDA(At, 1, 0); PG8_STAGE(PG8_SA(0, 1), a2 + hstep, voffA);
            PG8_WAIT_V(8); PG8_WAIT_L(0); PG8_BAR; PG8_MMA(0, 0, At, B0); PG8_MMA(0, 1, At, B1); PG8_BAR; PG8_SCHED;
            PG8_LDA(At, 1, 1); PG8_STAGE(PG8_SB(1, 0), b3, voffB); PG8_STAGE(PG8_SB(1, 1), b3 + hstep, voffB); PG8_STAGE(PG8_SA(1, 0), a3, voffA);
            PG8_WAIT_V(8); PG8_WAIT_L(0); PG8_BAR; PG8_MMA(1, 0, At, B0); PG8_MMA(1, 1, At, B1); PG8_BAR; PG8_SCHED;
            } else {
            PG8_LDB(B0, 0, 0); PG8_SCHED; PG8_LDA(At, 0, 0); PG8_STAGE(PG8_SA(1, 1), a1 + hstep, voffA);
            PG8_WAIT_L(8); PG8_BAR; PG8_WAIT_L(0); PG8_MMA(0, 0, At, B0); PG8_BAR; PG8_SCHED;
            PG8_LDB(B1, 0, 1); PG8_STAGE(PG8_SB(0, 0), b2, voffB);
            PG8_BAR; PG8_WAIT_L(0); PG8_MMA(0, 1, At, B1); PG8_BAR;
            PG8_LDA(At, 0, 1); PG8_STAGE(PG8_SA(0, 0), a2, voffA);
            PG8_BAR; PG8_WAIT_L(0); PG8_MMA(1, 0, At, B0); PG8_BAR; PG8_SCHED;
            PG8_STAGE(PG8_SB(0, 1), b2 + hstep, voffB);
            PG8_WAIT_V(6); PG8_BAR; PG8_MMA(1, 1, At, B1); PG8_BAR;
            PG8_LDB(B0, 1, 0); PG8_SCHED; PG8_LDA(At, 1, 0); PG8_STAGE(PG8_SA(0, 1), a2 + hstep, voffA);
            PG8_WAIT_L(8); PG8_BAR; PG8_WAIT_L(0); PG8_MMA(0, 0, At, B0); PG8_BAR; PG8_SCHED;
            PG8_LDB(B1, 1, 1); PG8_STAGE(PG8_SB(1, 0), b3, voffB);
            PG8_BAR; PG8_WAIT_L(0); PG8_MMA(0, 1, At, B1); PG8_BAR;
            PG8_LDA(At, 1, 1); PG8_STAGE(PG8_SA(1, 0), a3, voffA);
            PG8_BAR; PG8_WAIT_L(0); PG8_MMA(1, 0, At, B0); PG8_BAR; PG8_SCHED;
            PG8_STAGE(PG8_SB(1, 1), b3 + hstep, voffB);
            PG8_WAIT_V(6); PG8_BAR; PG8_MMA(1, 1, At, B1); PG8_BAR;
            }
        }
        if constexpr (ALIGN_EPI) { if (wr == 0) PG8_BAR; }
        if constexpr (!Epi::AFTER_DRAIN) { E(acc, cur, wr, wc, fr, fq); S.done(cur); }
        if (!has_next) break;
#pragma unroll
        for (int a = 0; a < 2; ++a)
#pragma unroll
            for (int b = 0; b < 2; ++b)
#pragma unroll
                for (int m = 0; m < 4; ++m)
#pragma unroll
                    for (int n = 0; n < 2; ++n) acc[a][b][m][n] = (f32x4){0.f, 0.f, 0.f, 0.f};
        cur = nxt; cA = nA; cB = nB; ++ui;
        if constexpr (ALIGN_EPI) { if (wr == 1) PG8_BAR; }
    }
    PG8_WAIT_V(0);
    if constexpr (!ALIGN_EPI) { if (wr == 0) PG8_BAR; }
    PG8_BAR;
    if constexpr (Epi::AFTER_DRAIN) { E.fused(acc, cur, wr, wc, fr, fq, lds, wid, lane); S.done(cur); }
#undef PG8_SA
#undef PG8_SB
#undef PG8_STAGE
#undef PG8_LDA
#undef PG8_LDB
#undef PG8_MMA
#undef PG8_WAIT_V
#undef PG8_WAIT_L
#undef PG8_BAR
#undef PG8_SCHED
}
}

#define LAS __attribute__((address_space(3)))
typedef unsigned short bf16_t;
typedef short bf16x8 __attribute__((ext_vector_type(8)));
typedef float f32x4 __attribute__((ext_vector_type(4)));
typedef float f32x16 __attribute__((ext_vector_type(16)));
typedef unsigned u32x4 __attribute__((ext_vector_type(4)));
typedef unsigned u32x2 __attribute__((ext_vector_type(2)));
using pg8::cvtpk; using pg8::pack8; using pg8::unpack8;
constexpr int NTHREADS = 512, NWAVES = 8;
constexpr int MH = 16384, DM = 1024, SEQ = 4096, NB_H = 4, NLAYER = 4, NP1 = 7168, NV2 = 2048, PLE = 256, NHEAD = 8;
constexpr size_t MiB = 1u << 20;
constexpr size_t LW_IN = 0, LW_A = (size_t)9216 * 1024, LW_B = LW_A + 1048576, LW_O = LW_B + 1048576, LW_G = LW_O + 1048576, LW_P = LW_G + 1048576, LW_TOTAL = LW_P + 262144;
constexpr size_t WS_W = 1 * MiB, WS_PROJ = 108 * MiB, WS_VT2 = 332 * MiB, WS_X0 = 396 * MiB, WS_X1 = 428 * MiB, WS_BRA = 460 * MiB, WS_BRB = 492 * MiB, WS_PB = 524 * MiB, WS_S0 = 532 * MiB, WS_S1 = 533 * MiB, WS_END = 534 * MiB;
static_assert(WS_W + LW_TOTAL * 2 * NLAYER <= WS_PROJ, "weights fit");
constexpr int TMP_LD = NP1 / 2;
constexpr int LDS_BYTES = 147456;
constexpr float EPS = 1e-6f;

struct Args {
    const float *x, *p, *norm_g, *w_in, *a_ln_g, *a_ln_b, *a_ws, *a_bs, *lam_q, *lam_k, *subln_g, *w_a_out, *w_b_out, *w_o, *ple_norm_g, *w_ple, *w_ple_gate, *final_g;
    float* out; unsigned char* ws;
};

__device__ __forceinline__ float wave_sum(float v) {
#pragma unroll
    for (int o = 1; o < 64; o <<= 1) v += __shfl_xor(v, o);
    return v;
}
#define LDS_WAIT() asm volatile("s_waitcnt lgkmcnt(0)" ::: "memory")

__device__ __forceinline__ void tr_item(const float* W, int K, int N, const float* scale, bf16_t* WT, int dst_row0, LAS float* scr, int k0, int n0, int lane) {
    f32x4 v[8];
#pragma unroll
    for (int i = 0; i < 8; ++i) v[i] = *(const f32x4*)(W + (size_t)(k0 + 4 * i + (lane >> 4)) * N + n0 + (lane & 15) * 4);
#pragma unroll
    for (int i = 0; i < 8; ++i) { const int kk = 4 * i + (lane >> 4); f32x4 x = v[i]; if (scale) x = x * scale[k0 + kk]; *(LAS f32x4*)(scr + kk * 68 + (lane & 15) * 4) = x; }
    LDS_WAIT(); asm volatile("" ::: "memory");
    bf16_t* o = WT + (size_t)(dst_row0 + lane) * K + k0;
#pragma unroll
    for (int j = 0; j < 4; ++j) { const LAS float* s = scr + (8 * j) * 68 + lane;
        u32x4 w; w.x = cvtpk(s[0 * 68], s[1 * 68]); w.y = cvtpk(s[2 * 68], s[3 * 68]); w.z = cvtpk(s[4 * 68], s[5 * 68]); w.w = cvtpk(s[6 * 68], s[7 * 68]);
        *(u32x4*)(o + 8 * j) = w; }
    LDS_WAIT(); asm volatile("" ::: "memory");
}
typedef const __attribute__((address_space(4))) Args* cargs_t;
__device__ __forceinline__ void weights_prologue(cargs_t ap, LAS unsigned char* lds, int gw, int ngw, int wave, int lane) {
    LAS float* scr = (LAS float*)(lds + wave * 16384);
    bf16_t* WT = (bf16_t*)(ap->ws + WS_W);
    constexpr int I_IN = 32 * 144, I_SQ = 32 * 16, I_P = 8 * 16, I_L = I_IN + 4 * I_SQ + I_P;
    for (int it = gw; it < I_L * NLAYER; it += ngw) {
        const int l = it / I_L; int r = it % I_L; bf16_t* wl = WT + (size_t)l * LW_TOTAL;
        if (r < I_IN) { const int kb = r / 144, nb = r % 144, n0 = nb * 64; const int osec = n0 >> 10;
            const int nsec = (int)((0x654832170ull >> (4 * osec)) & 0xFull);
            tr_item(ap->w_in + (size_t)l * 1024 * 9216, 1024, 9216, ap->norm_g + l * 1024, wl + LW_IN, nsec * 1024 + (n0 & 1023), scr, kb * 32, n0, lane);
            continue; }
        r -= I_IN;
        if (r < 4 * I_SQ) { const int which = r / I_SQ; const int rr = r % I_SQ; const int kb = rr / 16, nb = rr % 16;
            const float* src = which == 0 ? ap->w_a_out : which == 1 ? ap->w_b_out : which == 2 ? ap->w_o : ap->w_ple_gate;
            const size_t off = which == 0 ? LW_A : which == 1 ? LW_B : which == 2 ? LW_O : LW_G;
            tr_item(src + (size_t)l * 1048576, 1024, 1024, which == 3 ? ap->ple_norm_g + l * 1024 : nullptr, wl + off, nb * 64, scr, kb * 32, nb * 64, lane);
            continue; }
        r -= 4 * I_SQ;
        { const int kb = r / 16, nb = r % 16; tr_item(ap->w_ple + (size_t)l * 262144, 256, 1024, nullptr, wl + LW_P, nb * 64, scr, kb * 32, nb * 64, lane); }
    }
}

__device__ __forceinline__ void init_rows(const float* x, bf16_t* XB, float* S, int gw, int ngw, int lane) {
    asm volatile("" : "+v"(lane)); asm volatile("" : "+s"(gw));
    for (int m = gw; m < MH; m += ngw) {
        const f32x4* xr = (const f32x4*)(x + (size_t)m * DM) + lane; float s = 0.f; f32x4 v[4];
#pragma unroll
        for (int j = 0; j < 4; ++j) { v[j] = xr[64 * j]; s += (v[j][0] * v[j][0] + v[j][1] * v[j][1]) + (v[j][2] * v[j][2] + v[j][3] * v[j][3]); }
        s = wave_sum(s);
        u32x2* o = (u32x2*)(XB + (size_t)m * DM) + lane;
#pragma unroll
        for (int j = 0; j < 4; ++j) { u32x2 w; w.x = cvtpk(v[j][0], v[j][1]); w.y = cvtpk(v[j][2], v[j][3]); o[64 * j] = w; }
        if (lane < 16) S[(size_t)m * 16 + lane] = lane == 0 ? s : 0.f;
    }
}
__device__ __forceinline__ void final_rows(float* out, const float* g, int gw, int ngw, int lane) {
    asm volatile("" : "+v"(lane)); asm volatile("" : "+s"(gw));
    for (int m = gw; m < MH; m += ngw) {
        f32x4* xr = (f32x4*)(out + (size_t)m * DM) + lane; float s = 0.f; f32x4 v[4];
#pragma unroll
        for (int j = 0; j < 4; ++j) { v[j] = xr[64 * j]; s += (v[j][0] * v[j][0] + v[j][1] * v[j][1]) + (v[j][2] * v[j][2] + v[j][3] * v[j][3]); }
        const float rs = rsqrtf(wave_sum(s) * (1.0f / DM) + EPS);
#pragma unroll
        for (int j = 0; j < 4; ++j) { const f32x4 gg = ((const f32x4*)g)[64 * j + lane]; xr[64 * j] = v[j] * rs * gg; }
    }
}
__device__ __forceinline__ void convert_p(const float* p, bf16_t* PB, int gtid, int nthr) {
    asm volatile("" : "+v"(gtid));
    for (int i = gtid; i < MH * PLE / 8; i += nthr) { const f32x4 a = ((const f32x4*)p)[2 * i], b = ((const f32x4*)p)[2 * i + 1]; ((u32x4*)PB)[i] = pack8(a, b); }
}

__device__ __forceinline__ void gmlp_unit(LAS unsigned char* lds, const bf16_t* PROJ, const bf16_t* VT2, bf16_t* BRA, const float* lng, const float* lnb, const float* ws, const float* bs, int c, int gh) {
    int tid_ = threadIdx.x; asm volatile("" : "+v"(tid_)); const int tid = tid_, lane = tid & 63, l32 = lane & 31, hi = lane >> 5; const int w = __builtin_amdgcn_readfirstlane(tid >> 6);
    const int tok0 = c * 128;
    LAS float* red = (LAS float*)lds;
    LAS float* stat = (LAS float*)(lds + 32768);
    LAS unsigned char* T = lds + 34816;
    { const int sc = tid & 15, rg = tid >> 4; float s[8], q[8];
#pragma unroll
      for (int j = 0; j < 8; ++j) { s[j] = 0.f; q[j] = 0.f; }
      for (int i = 0; i < 32; ++i) { const u32x4 wv = *(const u32x4*)(VT2 + (size_t)(rg + 32 * i) * MH + tok0 + sc * 8); f32x4 a, b; unpack8(wv, a, b);
#pragma unroll
          for (int j = 0; j < 4; ++j) { s[j] += a[j]; q[j] += a[j] * a[j]; s[4 + j] += b[j]; q[4 + j] += b[j] * b[j]; } }
#pragma unroll
      for (int j = 0; j < 8; ++j) { red[rg * 256 + sc * 8 + j] = s[j]; red[rg * 256 + 128 + sc * 8 + j] = q[j]; } }
    __syncthreads();
    if (tid < 128) { float s = 0.f, q = 0.f;
        for (int i = 0; i < 32; ++i) { s += red[i * 256 + tid]; q += red[i * 256 + 128 + tid]; }
        const float mean = s * (1.0f / 1024.0f); const float var = q * (1.0f / 1024.0f) - mean * mean;
        stat[2 * tid] = mean; stat[2 * tid + 1] = rsqrtf(var + EPS); }
    __syncthreads();
    const int tb = w & 3, dh = w >> 2;
    u32x4 pre[4];
#pragma unroll
    for (int i = 0; i < 4; ++i) { const int p = tid + 512 * i; pre[i] = *(const u32x4*)(VT2 + (size_t)(gh * 512 + (p >> 4)) * MH + tok0 + (p & 15) * 8); }
    for (int gi = 0; gi < 4; ++gi) { const int g = gh * 4 + gi;
#pragma unroll
        for (int i = 0; i < 4; ++i) { const int p = tid + 512 * i, d = p >> 4, sc = p & 15;
            f32x4 a, b; unpack8(pre[i], a, b);
            const float gg = lng[g * 128 + d], bb = lnb[g * 128 + d];
#pragma unroll
            for (int j = 0; j < 4; ++j) { a[j] = (a[j] - stat[2 * (sc * 8 + j)]) * stat[2 * (sc * 8 + j) + 1] * gg + bb; b[j] = (b[j] - stat[2 * (sc * 8 + 4 + j)]) * stat[2 * (sc * 8 + 4 + j) + 1] * gg + bb; }
            *(LAS u32x4*)(T + d * 272 + sc * 16) = pack8(a, b); }
        if (gi < 3) {
#pragma unroll
            for (int i = 0; i < 4; ++i) { const int p = tid + 512 * i; pre[i] = *(const u32x4*)(VT2 + (size_t)((g + 1) * 128 + (p >> 4)) * MH + tok0 + (p & 15) * 8); } }
        __syncthreads();
        f32x16 acc0 = {}, acc1 = {};
        const float* wrow = ws + (size_t)g * 16384 + (size_t)(32 * tb + l32) * 128 + 8 * hi;
        const int trow = 32 * tb + l32;
        for (int ks = 0; ks < 2 * tb + 2; ++ks) {
            f32x4 wa = *(const f32x4*)(wrow + 16 * ks), wb = *(const f32x4*)(wrow + 16 * ks + 4); const int s0 = 16 * ks + 8 * hi;
#pragma unroll
            for (int j = 0; j < 4; ++j) { if (s0 + j > trow) wa[j] = 0.f; if (s0 + 4 + j > trow) wb[j] = 0.f; }
            const bf16x8 A = __builtin_bit_cast(bf16x8, pack8(wa, wb));
            const bf16x8 B0 = *(const LAS bf16x8*)(T + (64 * dh + l32) * 272 + (16 * ks + 8 * hi) * 2);
            const bf16x8 B1 = *(const LAS bf16x8*)(T + (64 * dh + 32 + l32) * 272 + (16 * ks + 8 * hi) * 2);
            acc0 = __builtin_amdgcn_mfma_f32_32x32x16_bf16(A, B0, acc0, 0, 0, 0);
            acc1 = __builtin_amdgcn_mfma_f32_32x32x16_bf16(A, B1, acc1, 0, 0, 0);
        }
        LAS float* Yb = (LAS float*)(lds + 71680);
#pragma unroll
        for (int r = 0; r < 16; ++r) { const int t = 32 * tb + (r & 3) + 8 * (r >> 2) + 4 * hi; const float bv = bs[g * 128 + t];
            Yb[t * 132 + 64 * dh + l32] = acc0[r] + bv; Yb[t * 132 + 64 * dh + 32 + l32] = acc1[r] + bv; }
        __syncthreads();
#pragma unroll
        for (int i = 0; i < 4; ++i) { const int p = tid + 512 * i, t = p >> 4, c8 = p & 15; const size_t tok = (size_t)(tok0 + t); const int col = g * 128 + c8 * 8;
            f32x4 u0, u1, z0, z1; unpack8(*(const u32x4*)(PROJ + tok * NP1 + col), u0, u1); unpack8(*(const u32x4*)(PROJ + tok * NP1 + 1024 + col), z0, z1);
            const f32x4 y0 = *(const LAS f32x4*)(Yb + t * 132 + c8 * 8), y1 = *(const LAS f32x4*)(Yb + t * 132 + c8 * 8 + 4);
            *(u32x4*)(BRA + tok * DM + col) = pack8(u0 * y0 * z0, u1 * y1 * z1); }
        __syncthreads();
    }
}

constexpr int AT_KS = 17408, AT_VS = 18432, AT_VOFF = 2 * AT_KS;
__device__ __forceinline__ void attn_unit(LAS unsigned char* lds, const bf16_t* PROJ, const bf16_t* VT2, bf16_t* BRB, const float* subg, float lam, float lam_init, int b, int h, int qb) {
    int tid_ = threadIdx.x; asm volatile("" : "+v"(tid_)); const int tid = tid_, lane = tid & 63, l32 = lane & 31, hi = lane >> 5; const int w = __builtin_amdgcn_readfirstlane(tid >> 6); const int map = w >> 2, wq = w & 3;
    const int rowbase = b * SEQ, q0 = qb * 128, myq = q0 + wq * 32 + l32, NT = 2 * qb + 2;
    bf16x8 qf[4];
    { const bf16_t* qp = PROJ + (size_t)(rowbase + myq) * NP1 + 2048 + h * 128 + map * 64 + hi * 8;
#pragma unroll
      for (int ks = 0; ks < 4; ++ks) qf[ks] = *(const bf16x8*)(qp + ks * 16); }
    const bf16_t* ksrc[2]; const bf16_t* vsrc[2]; int kdst[2], vdst[2];
#pragma unroll
    for (int i = 0; i < 2; ++i) { const int p = tid + 512 * i;
        ksrc[i] = PROJ + (size_t)(rowbase + (p >> 4)) * NP1 + 3072 + h * 128 + (p & 15) * 8; kdst[i] = (p >> 4) * 272 + (p & 15) * 16;
        vsrc[i] = VT2 + (size_t)(1024 + h * 128 + (p >> 3)) * MH + rowbase + (p & 7) * 8; vdst[i] = AT_VOFF + (p >> 3) * 144 + (((p & 7) >> 1) * 16 + (p & 1) * 4) * 2; }
    u32x4 kr[2], vr[2];
#pragma unroll
    for (int i = 0; i < 2; ++i) { kr[i] = *(const u32x4*)(ksrc[i]); vr[i] = *(const u32x4*)(vsrc[i]); }
#pragma unroll
    for (int i = 0; i < 2; ++i) { *(LAS u32x4*)(lds + kdst[i]) = kr[i]; *(LAS u32x2*)(lds + vdst[i]) = (u32x2){vr[i].x, vr[i].y}; *(LAS u32x2*)(lds + vdst[i] + 16) = (u32x2){vr[i].z, vr[i].w}; }
    __syncthreads();
    f32x16 O[4]; O[0] = f32x16{}; O[1] = f32x16{}; O[2] = f32x16{}; O[3] = f32x16{};
    float m_run = -1e30f, l_run = 0.f;
    for (int t = 0; t < NT; ++t) {
        const int buf = t & 1, kv0 = 64 * t;
        if (t + 1 < NT) {
#pragma unroll
            for (int i = 0; i < 2; ++i) { kr[i] = *(const u32x4*)(ksrc[i] + (size_t)(kv0 + 64) * NP1); vr[i] = *(const u32x4*)(vsrc[i] + kv0 + 64); } }
        if (kv0 <= q0 + wq * 32 + 31) {
            LAS unsigned char* Kb = lds + buf * AT_KS + l32 * 272 + map * 128 + hi * 16;
            LAS unsigned char* Vb = lds + AT_VOFF + buf * AT_VS + l32 * 144 + hi * 16;
            f32x16 S0 = {}, S1 = {};
            { bf16x8 kf[8];
#pragma unroll
              for (int ks = 0; ks < 4; ++ks) { kf[2 * ks] = *(const LAS bf16x8*)(Kb + ks * 32); kf[2 * ks + 1] = *(const LAS bf16x8*)(Kb + 32 * 272 + ks * 32); }
              __builtin_amdgcn_sched_barrier(0);
#pragma unroll
              for (int ks = 0; ks < 4; ++ks) { S0 = __builtin_amdgcn_mfma_f32_32x32x16_bf16(kf[2 * ks], qf[ks], S0, 0, 0, 0); S1 = __builtin_amdgcn_mfma_f32_32x32x16_bf16(kf[2 * ks + 1], qf[ks], S1, 0, 0, 0); } }
            u32x4 va[8], vb[8];
#pragma unroll
            for (int j = 0; j < 2; ++j)
#pragma unroll
                for (int db = 0; db < 4; ++db) va[j * 4 + db] = *(const LAS u32x4*)(Vb + db * 32 * 144 + j * 32);
            __builtin_amdgcn_sched_barrier(0);
            if (t >= NT - 2) {
#pragma unroll
                for (int r = 0; r < 16; ++r) { const int kv = kv0 + (r & 3) + 8 * (r >> 2) + 4 * hi; if (kv > myq) S0[r] = -1e30f; if (kv + 32 > myq) S1[r] = -1e30f; } }
            float mx = __builtin_fmaxf(__builtin_fmaxf(S0[0], S1[0]), __builtin_fmaxf(S0[1], S1[1]));
#pragma unroll
            for (int r = 2; r < 16; r += 2) { mx = __builtin_fmaxf(__builtin_fmaxf(mx, S0[r]), S1[r]); mx = __builtin_fmaxf(__builtin_fmaxf(mx, S0[r + 1]), S1[r + 1]); }
            if (__any(mx > m_run + 8.0f)) { mx = fmaxf(mx, __shfl_xor(mx, 32)); const float mnew = fmaxf(m_run, mx), alpha = __builtin_amdgcn_exp2f(m_run - mnew); m_run = mnew; l_run *= alpha;
#pragma unroll
                for (int db = 0; db < 4; ++db)
#pragma unroll
                    for (int r = 0; r < 16; ++r) O[db][r] *= alpha; }
            pg8::f32x2 ps2 = {0.f, 0.f};
#pragma unroll
            for (int r = 0; r < 16; r += 2) { S0[r] = __builtin_amdgcn_exp2f(S0[r] - m_run); S0[r + 1] = __builtin_amdgcn_exp2f(S0[r + 1] - m_run); ps2 += (pg8::f32x2){S0[r], S0[r + 1]}; }
            bf16x8 pf[4];
#pragma unroll
            for (int j = 0; j < 2; ++j) { u32x4 pw;
#pragma unroll
                for (int i = 0; i < 4; ++i) pw[i] = cvtpk(S0[8 * j + 2 * i], S0[8 * j + 2 * i + 1]);
                pf[j] = __builtin_bit_cast(bf16x8, pw); }
#pragma unroll
            for (int j = 2; j < 4; ++j)
#pragma unroll
                for (int db = 0; db < 4; ++db) vb[(j - 2) * 4 + db] = *(const LAS u32x4*)(Vb + db * 32 * 144 + j * 32);
            __builtin_amdgcn_sched_barrier(0);
#pragma unroll
            for (int j = 0; j < 2; ++j)
#pragma unroll
                for (int db = 0; db < 4; ++db) O[db] = __builtin_amdgcn_mfma_f32_32x32x16_bf16(__builtin_bit_cast(bf16x8, va[j * 4 + db]), pf[j], O[db], 0, 0, 0);
#pragma unroll
            for (int r = 0; r < 16; r += 2) { S1[r] = __builtin_amdgcn_exp2f(S1[r] - m_run); S1[r + 1] = __builtin_amdgcn_exp2f(S1[r + 1] - m_run); ps2 += (pg8::f32x2){S1[r], S1[r + 1]}; }
#pragma unroll
            for (int j = 2; j < 4; ++j) { u32x4 pw;
#pragma unroll
                for (int i = 0; i < 4; ++i) pw[i] = cvtpk(S1[8 * (j & 1) + 2 * i], S1[8 * (j & 1) + 2 * i + 1]);
                pf[j] = __builtin_bit_cast(bf16x8, pw); }
#pragma unroll
            for (int k = 0; k < 8; ++k) { __builtin_amdgcn_sched_group_barrier(0x008, 1, 0); __builtin_amdgcn_sched_group_barrier(0x002, 6, 0); }
            __builtin_amdgcn_sched_barrier(0);
            l_run += ps2.x + ps2.y;
#pragma unroll
            for (int j = 2; j < 4; ++j)
#pragma unroll
                for (int db = 0; db < 4; ++db) O[db] = __builtin_amdgcn_mfma_f32_32x32x16_bf16(__builtin_bit_cast(bf16x8, vb[(j - 2) * 4 + db]), pf[j], O[db], 0, 0, 0);
        }
        if (t + 1 < NT) {
#pragma unroll
            for (int i = 0; i < 2; ++i) { *(LAS u32x4*)(lds + (buf ^ 1) * AT_KS + kdst[i]) = kr[i]; *(LAS u32x2*)(lds + (buf ^ 1) * AT_VS + vdst[i]) = (u32x2){vr[i].x, vr[i].y}; *(LAS u32x2*)(lds + (buf ^ 1) * AT_VS + vdst[i] + 16) = (u32x2){vr[i].z, vr[i].w}; } }
        __syncthreads();
    }
    const float inv = 1.0f / (l_run + __shfl_xor(l_run, 32));
    LAS float* X = (LAS float*)lds + wq * 4096 + lane;
    if (map == 1) { const float sc = -lam * inv;
#pragma unroll
        for (int db = 0; db < 4; ++db)
#pragma unroll
            for (int r = 0; r < 16; ++r) X[(db * 16 + r) * 64] = O[db][r] * sc; }
    __syncthreads();
    if (map == 0) { float ss = 0.f;
#pragma unroll
        for (int db = 0; db < 4; ++db)
#pragma unroll
            for (int r = 0; r < 16; ++r) { const float o = O[db][r] * inv + X[(db * 16 + r) * 64]; O[db][r] = o; ss += o * o; }
        ss += __shfl_xor(ss, 32);
        const float rs = rsqrtf(ss * (1.0f / 128.0f) + EPS) * (1.0f - lam_init);
        LAS float* Zr = (LAS float*)(lds + 65536) + (wq * 32 + l32) * 132;
#pragma unroll
        for (int db = 0; db < 4; ++db)
#pragma unroll
            for (int rg = 0; rg < 4; ++rg) { const int d = 32 * db + 8 * rg + 4 * hi; const f32x4 gg = *(const f32x4*)(subg + d);
                *(LAS f32x4*)(Zr + d) = (f32x4){O[db][4 * rg] * rs * gg[0], O[db][4 * rg + 1] * rs * gg[1], O[db][4 * rg + 2] * rs * gg[2], O[db][4 * rg + 3] * rs * gg[3]}; } }
    __syncthreads();
#pragma unroll
    for (int i = 0; i < 4; ++i) { const int p = tid + 512 * i, q = p >> 4, c8 = p & 15; const size_t row = (size_t)(rowbase + q0 + q);
        f32x4 z0, z1; unpack8(*(const u32x4*)(PROJ + row * NP1 + 4096 + h * 128 + c8 * 8), z0, z1);
        const LAS float* zp = (const LAS float*)(lds + 65536) + q * 132 + c8 * 8;
        const f32x4 v0 = *(const LAS f32x4*)zp, v1 = *(const LAS f32x4*)(zp + 4);
        *(u32x4*)(BRB + row * DM + h * 128 + c8 * 8) = pack8(v0 * z0, v1 * z1); }
    __syncthreads();
}

#define RLX_AGENT __ATOMIC_RELAXED, __HIP_MEMORY_SCOPE_AGENT
#define XB_TMO      128
#define XB_XCNT(j)  (256  + 64 * (j))
#define XB_XSUB(j)  (1280 + 64 * (j))
#define XB_XGEN(j)  (2304 + 64 * (j))
#define XB_TOP      3328
#define XB_TOPGEN   3392
#define XCD_BAR_WORDS 3456
#define XB_SPIN_CAP (1u << 18)

__device__ __forceinline__ unsigned xb_ld(unsigned* p)              { return __hip_atomic_load(p, __ATOMIC_RELAXED, __HIP_MEMORY_SCOPE_AGENT); }
__device__ __forceinline__ unsigned xb_add(unsigned* p, unsigned v) { return __hip_atomic_fetch_add(p, v, __ATOMIC_RELAXED, __HIP_MEMORY_SCOPE_AGENT); }
__device__ __forceinline__ unsigned xb_xcc_id() { return (unsigned)__builtin_amdgcn_s_getreg((3 << 11) | 20) & 0xFu; }
#define XB_SPIN(cond, bar) do { unsigned _sp = 0; while (cond) { __builtin_amdgcn_s_sleep(1); \
    if ((++_sp & 255u) == 0u) { if (xb_ld(&(bar)[XB_TMO])) break; if (_sp > XB_SPIN_CAP) { atomicAdd(&(bar)[XB_TMO], 1u); break; } } } } while (0)

struct XcdBarrier {
    unsigned* bar; unsigned x;
    volatile LAS unsigned* st;
};

__device__ __forceinline__ XcdBarrier xcd_barrier_post(unsigned* bar, volatile LAS unsigned* st) {
    XcdBarrier b; b.bar = bar; b.x = xb_xcc_id(); b.st = st;
    if (threadIdx.x == 0) (void)xb_add(&bar[XB_XCNT(b.x)], 1u);
    return b;
}
__device__ __forceinline__ void xcd_barrier_complete(unsigned* bar, unsigned x, unsigned& nloc, unsigned& nx) {
    const unsigned G = gridDim.x * gridDim.y * gridDim.z;
    unsigned sum, cnt, mine, sp = 0u;
    for (;;) {
        sum = 0u; cnt = 0u; mine = 0u;
#pragma unroll
        for (unsigned j = 0; j < 16; ++j) { const unsigned c = xb_ld(&bar[XB_XCNT(j)]); sum += c; cnt += (c > 0u) ? 1u : 0u; mine = (j == x) ? c : mine; }
        if (sum == G) break;
        __builtin_amdgcn_s_sleep(1);
        if ((++sp & 255u) == 0u) { if (xb_ld(&bar[XB_TMO])) break; if (sp > XB_SPIN_CAP) { atomicAdd(&bar[XB_TMO], 1u); break; } }
    }
    nloc = mine > 0u ? mine : 1u; nx = cnt > 0u ? cnt : 1u;
}

__device__ __forceinline__ void xcd_barrier(const XcdBarrier& b) {
    asm volatile("s_waitcnt vmcnt(0)" ::: "memory");
    __syncthreads();
    if (threadIdx.x == 0) {
        unsigned* bar = b.bar;
        __builtin_amdgcn_s_waitcnt(0);
        unsigned nloc = b.st[0], nx = b.st[1];
        if (nloc == 0u) { xcd_barrier_complete(bar, b.x, nloc, nx); b.st[0] = nloc; b.st[1] = nx; }
        const unsigned old = xb_add(&bar[XB_XSUB(b.x)], 1u);
        const unsigned gen = old / nloc;
        if (old + 1u == (gen + 1u) * nloc) {
            __builtin_amdgcn_fence(__ATOMIC_RELEASE, "agent");
            asm volatile("s_waitcnt vmcnt(0)" ::: "memory");
            const unsigned og = xb_add(&bar[XB_TOP], 1u);
            const unsigned tg = og / nx;
            if (og + 1u == (tg + 1u) * nx) xb_add(&bar[XB_TOPGEN], 1u);
            else XB_SPIN(xb_ld(&bar[XB_TOPGEN]) == tg, bar);
            __builtin_amdgcn_fence(__ATOMIC_ACQUIRE, "agent");
            xb_add(&bar[XB_XGEN(b.x)], 1u);
            asm volatile("s_waitcnt vmcnt(0)" ::: "memory");
        } else {
            XB_SPIN(xb_ld(&bar[XB_XGEN(b.x)]) == gen, bar);
            __builtin_amdgcn_fence(__ATOMIC_ACQUIRE, "agent");
            asm volatile("s_waitcnt vmcnt(0)" ::: "memory");
        }
    }
    __syncthreads();
}


__global__ void __launch_bounds__(NTHREADS, 2) mega_fwd(Args a_unused) {
    extern __shared__ __attribute__((aligned(16))) unsigned char lds_raw[];
    LAS unsigned char* lds = (LAS unsigned char*)lds_raw;
    cg::grid_group grid = cg::this_grid();
    const int tid = threadIdx.x, lane = tid & 63, wave = __builtin_amdgcn_readfirstlane(tid >> 6);
    const int G = gridDim.x, bx = blockIdx.x;
    const int vcu = (G % 8 == 0) ? (bx % 8) * (G / 8) + bx / 8 : bx;
    const int gw = vcu * NWAVES + wave, ngw = G * NWAVES;
#define ARGS() cargs_t ap = (cargs_t)__builtin_amdgcn_kernarg_segment_ptr(); asm volatile("" : "+s"(ap)); unsigned char* const ws = ap->ws
#define GSYNC() xcd_barrier(xbar)
#define WSP(T, off) ((T*)(ws + (off)))
#define XBP(ci) ((bf16_t*)(ws + ((ci) ? WS_X1 : WS_X0)))
#define SXP(ci) ((float*)(ws + ((ci) ? WS_S1 : WS_S0)))
#define TMPP ((float*)(ws + WS_PROJ + 4096))
    if (tid < 64) ((LAS unsigned*)(lds + 147200))[tid] = 0u;
    __syncthreads();
    grid.sync();
    XcdBarrier xbar;
    { ARGS(); xbar = xcd_barrier_post((unsigned*)ws, (volatile LAS unsigned*)(lds + 147200)); }
    { ARGS(); weights_prologue(ap, lds, gw, ngw, wave, lane); }

#define DUMP_BF16(buf_off, nelem) do { ARGS(); const bf16_t* B_ = WSP(bf16_t, buf_off); float* o_ = ap->out; \
    for (size_t i_ = (size_t)bx * NTHREADS + tid; i_ < (size_t)2 * MH * DM; i_ += (size_t)G * NTHREADS) o_[i_] = __uint_as_float((unsigned)B_[i_ % (size_t)(nelem)] << 16); } while (0)
    for (int hf = 0; hf < 2; ++hf) {
        { ARGS(); init_rows(ap->x + (size_t)hf * MH * DM, XBP(0), SXP(0), gw, ngw, lane); }
        GSYNC();
        int c = 0;
        for (int l = 0; l < NLAYER; ++l) {
            { ARGS(); convert_p(ap->p + ((size_t)l * 2 * MH + (size_t)hf * MH) * PLE, WSP(bf16_t, WS_PB), bx * NTHREADS + tid, G * NTHREADS); }
#if !defined(ONLY) || ONLY == 0
            { ARGS(); const bf16_t* wl = WSP(bf16_t, WS_W) + (size_t)l * LW_TOTAL;
              pg8::Gemm g{XBP(c), wl + LW_IN, MH, NP1, DM}; pg8::StaticOrder S; S.init(MH, NP1, G, bx);
              pg8::Epi E{0, WSP(bf16_t, WS_PROJ), NP1, nullptr, 0, nullptr, 0, nullptr, SXP(c), nullptr, nullptr, nullptr};
              pg8::gemm_phase<pg8::Epi, pg8::StaticOrder, true, true>(lds, g, S, E); }
#endif
#if !defined(ONLY) || ONLY == 1
            { ARGS(); const bf16_t* wl = WSP(bf16_t, WS_W) + (size_t)l * LW_TOTAL;
              pg8::Gemm g{wl + LW_IN + (size_t)NP1 * DM, XBP(c), NV2, MH, DM}; pg8::StaticOrder S; S.init(NV2, MH, G, bx);
              pg8::Epi E{1, WSP(bf16_t, WS_VT2), MH, nullptr, 0, nullptr, 0, nullptr, SXP(c), nullptr, nullptr, nullptr};
              pg8::gemm_phase<pg8::Epi, pg8::StaticOrder, true, true>(lds, g, S, E); }
#endif
            GSYNC();
#if defined(STOP_AFTER) && STOP_AFTER == 1
            DUMP_BF16(WS_PROJ, (size_t)MH * NP1); return;
#endif
#if defined(STOP_AFTER) && STOP_AFTER == 11
            DUMP_BF16(WS_VT2, (size_t)MH * NV2); return;
#endif
#ifndef NO_GMLP
            { ARGS();
              for (int u = vcu; u < 256; u += G)
                gmlp_unit(lds, WSP(bf16_t, WS_PROJ), WSP(bf16_t, WS_VT2), WSP(bf16_t, WS_BRA), ap->a_ln_g + l * 1024, ap->a_ln_b + l * 1024, ap->a_ws + (size_t)l * 131072, ap->a_bs + l * 1024, u >> 1, u & 1); }
#endif
#ifdef NO_ATTN
            { ARGS(); const bf16_t* PR = WSP(bf16_t, WS_PROJ); bf16_t* B = WSP(bf16_t, WS_BRB);
              for (int i = bx * NTHREADS + tid; i < MH * DM / 8; i += G * NTHREADS) { const int row = i >> 7, c8 = i & 127; *(u32x4*)(B + (size_t)row * DM + c8 * 8) = *(const u32x4*)(PR + (size_t)row * NP1 + 4096 + c8 * 8); } }
#endif
#ifdef NO_GMLP
            { ARGS(); const bf16_t* PR = WSP(bf16_t, WS_PROJ); bf16_t* B = WSP(bf16_t, WS_BRA);
              for (int i = bx * NTHREADS + tid; i < MH * DM / 8; i += G * NTHREADS) { const int row = i >> 7, c8 = i & 127; *(u32x4*)(B + (size_t)row * DM + c8 * 8) = *(const u32x4*)(PR + (size_t)row * NP1 + c8 * 8); } }
#endif
#ifndef NO_ATTN
            { ARGS();
              const float lam_init = 0.8f - 0.6f * expf(-0.3f * (float)l);
              const float d0 = wave_sum(ap->lam_q[l * 128 + lane] * ap->lam_k[l * 128 + lane]), d1 = wave_sum(ap->lam_q[l * 128 + 64 + lane] * ap->lam_k[l * 128 + 64 + lane]);
              const float lam = expf(d0) - expf(d1) + lam_init;
              for (int pu = vcu; pu < 512; pu += G) { const int bh = pu >> 4, s = pu & 15;
                  attn_unit(lds, WSP(bf16_t, WS_PROJ), WSP(bf16_t, WS_VT2), WSP(bf16_t, WS_BRB), ap->subln_g + l * 128, lam, lam_init, bh >> 3, bh & 7, 31 - s);
                  attn_unit(lds, WSP(bf16_t, WS_PROJ), WSP(bf16_t, WS_VT2), WSP(bf16_t, WS_BRB), ap->subln_g + l * 128, lam, lam_init, bh >> 3, bh & 7, s); } }
#endif
            GSYNC();
#if !defined(ONLY) || ONLY == 2
            { ARGS(); const bf16_t* wl = WSP(bf16_t, WS_W) + (size_t)l * LW_TOTAL;
              pg8::Gemm g{WSP(bf16_t, WS_BRA), wl + LW_A, MH, DM, DM}; pg8::StaticOrder S; S.init(MH, DM, G, bx);
              pg8::Epi E{2, WSP(bf16_t, WS_PROJ) + 2048, NP1, nullptr, 0, nullptr, 0, WSP(bf16_t, WS_PROJ) + 5120, nullptr, nullptr, nullptr, nullptr};
              pg8::gemm_phase<pg8::Epi, pg8::StaticOrder, true, true>(lds, g, S, E); }
#endif
#if !defined(ONLY) || ONLY == 3
            { ARGS(); const bf16_t* wl = WSP(bf16_t, WS_W) + (size_t)l * LW_TOTAL;
              pg8::Gemm g{WSP(bf16_t, WS_BRB), wl + LW_B, MH, DM, DM}; pg8::StaticOrder S; S.init(MH, DM, G, bx);
              pg8::Epi E{3, XBP(1 - c), DM, nullptr, 0, nullptr, 0, WSP(bf16_t, WS_PROJ) + 6144, nullptr, nullptr, WSP(bf16_t, WS_PROJ) + 2048, nullptr};
              pg8::gemm_phase<pg8::Epi, pg8::StaticOrder, true, true>(lds, g, S, E); }
#endif
            GSYNC();
#if defined(STOP_AFTER) && STOP_AFTER == 3
            if (c == 0) DUMP_BF16(WS_X1, (size_t)MH * DM); else DUMP_BF16(WS_X0, (size_t)MH * DM); return;
#endif
#if !defined(ONLY) || ONLY == 4
            { ARGS(); const bf16_t* wl = WSP(bf16_t, WS_W) + (size_t)l * LW_TOTAL; float* out = ap->out + (size_t)hf * MH * DM;
              pg8::Gemm g{XBP(1 - c), wl + LW_O, MH, DM, DM}; pg8::StaticOrder S; S.init(MH, DM, G, bx);
              pg8::Epi E{4, XBP(c), DM, nullptr, 0, l == 0 ? ap->x + (size_t)hf * MH * DM : (const float*)nullptr, DM, nullptr, nullptr, SXP(c), nullptr, XBP(c)};
              pg8::gemm_phase<pg8::Epi, pg8::StaticOrder, true, true>(lds, g, S, E); }
#endif
            GSYNC();
#if defined(STOP_AFTER) && STOP_AFTER == 4
            if (c == 0) DUMP_BF16(WS_X0, (size_t)MH * DM); else DUMP_BF16(WS_X1, (size_t)MH * DM); return;
#endif
#if !defined(ONLY) || ONLY == 5
            { ARGS(); const bf16_t* wl = WSP(bf16_t, WS_W) + (size_t)l * LW_TOTAL;
              pg8::Gemm g{XBP(c), wl + LW_G, MH, DM, DM}; pg8::StaticOrder S; S.init(MH, DM, G, bx);
              pg8::Epi E{5, WSP(bf16_t, WS_PROJ) + 2048, NP1, nullptr, 0, nullptr, 0, nullptr, SXP(c), nullptr, nullptr, nullptr};
              pg8::gemm_phase<pg8::Epi, pg8::StaticOrder, true, true>(lds, g, S, E); }
#endif
#if !defined(ONLY) || ONLY == 6
            { ARGS(); const bf16_t* wl = WSP(bf16_t, WS_W) + (size_t)l * LW_TOTAL; float* out = ap->out + (size_t)hf * MH * DM;
              pg8::Gemm g{WSP(bf16_t, WS_PB), wl + LW_P, MH, DM, PLE}; pg8::StaticOrder S; S.init(MH, DM, G, bx);
              pg8::Epi E{6, XBP(1 - c), DM, l == NLAYER - 1 ? out : (float*)nullptr, DM, nullptr, 0, nullptr, nullptr, SXP(1 - c), WSP(bf16_t, WS_PROJ) + 2048, XBP(c)};
              pg8::gemm_phase<pg8::Epi, pg8::StaticOrder, true, true>(lds, g, S, E); }
#endif
            GSYNC();
#if defined(STOP_AFTER) && STOP_AFTER == 5
            if (c == 0) DUMP_BF16(WS_X1, (size_t)MH * DM); else DUMP_BF16(WS_X0, (size_t)MH * DM); return;
#endif
            c ^= 1;
        }
        { ARGS(); final_rows(ap->out + (size_t)hf * MH * DM, ap->final_g, gw, ngw, lane); }
    }
}

extern "C" void kernel_launch(void* const* d_in, const int* in_sizes, int n_in, void* d_out, int out_size, void* d_ws, size_t ws_size, hipStream_t stream) {
    static int grid = 0;
    if (grid == 0) {
        if (n_in != 18 || ws_size < WS_END) { fprintf(stderr, "kernel_launch: unexpected n_in %d / ws_size %zu (need %zu)\n", n_in, ws_size, (size_t)WS_END); grid = -1; return; }
        int dev = 0, cus = 0, per_cu = 0;
        hipGetDevice(&dev); hipDeviceGetAttribute(&cus, hipDeviceAttributeMultiprocessorCount, dev);
        if (hipFuncSetAttribute((const void*)mega_fwd, hipFuncAttributeMaxDynamicSharedMemorySize, LDS_BYTES) != hipSuccess) { fprintf(stderr, "kernel_launch: hipFuncSetAttribute failed\n"); grid = -1; return; }
        if (hipOccupancyMaxActiveBlocksPerMultiprocessor(&per_cu, (const void*)mega_fwd, NTHREADS, LDS_BYTES) != hipSuccess || per_cu < 1) { fprintf(stderr, "kernel_launch: occupancy query gives %d\n", per_cu); per_cu = 1; }
        (void)hipGetLastError();
        grid = cus;
    }
    if (grid < 0) return;
    if (hipMemsetAsync(d_ws, 0, 16384, stream) != hipSuccess) { fprintf(stderr, "kernel_launch: memset failed\n"); return; }
    Args a{};
    const float** f = (const float**)&a;
    for (int i = 0; i < 18; ++i) f[i] = (const float*)d_in[i];
    a.out = (float*)d_out; a.ws = (unsigned char*)d_ws;
    void* args[] = {&a};
    hipError_t e = hipLaunchCooperativeKernel((const void*)mega_fwd, dim3(grid), dim3(NTHREADS), args, LDS_BYTES, stream);
    if (e != hipSuccess) fprintf(stderr, "cooperative launch failed: %s (grid %d)\n", hipGetErrorString(e), grid);
}
```

```cpp
#include <hip/hip_runtime.h>
#include <hip/hip_cooperative_groups.h>
#include <cstdio>
#include <cstdint>
namespace cg = cooperative_groups;
template <int M> __device__ __forceinline__ float xor_lt32(float v) { return __builtin_bit_cast(float, __builtin_amdgcn_ds_swizzle(__builtin_bit_cast(int, v), (M << 10) | 0x1F)); }
__device__ __forceinline__ float xor32_add(float v) { const unsigned b = __builtin_bit_cast(unsigned, v); auto rr = __builtin_amdgcn_permlane32_swap(b, b, false, false); return __builtin_bit_cast(float, (unsigned)rr[0]) + __builtin_bit_cast(float, (unsigned)rr[1]); }
__device__ __forceinline__ float xor32_max(float v) { const unsigned b = __builtin_bit_cast(unsigned, v); auto rr = __builtin_amdgcn_permlane32_swap(b, b, false, false); return fmaxf(__builtin_bit_cast(float, (unsigned)rr[0]), __builtin_bit_cast(float, (unsigned)rr[1])); }
__device__ __forceinline__ int lane_id_() { int l_; asm volatile("v_mbcnt_lo_u32_b32 %0, -1, 0\n\tv_mbcnt_hi_u32_b32 %0, -1, %0" : "=&v"(l_)); return l_; }
namespace pg8 {
#define PG8_LAS __attribute__((address_space(3)))
typedef unsigned short bf16_t;
typedef short bf16x8 __attribute__((ext_vector_type(8)));
typedef float f32x4 __attribute__((ext_vector_type(4)));
typedef unsigned u32x4 __attribute__((ext_vector_type(4)));
constexpr int BM = 256, BK = 64, HALF = 128, HTB = HALF * BK * 2  , STAGE_BYTES = 8 * HTB, NXCD = 8, WGM = 8;

__host__ __device__ __forceinline__ int lds_byte(int r, int c) { const int st = (r >> 4) * 2 + (c >> 5), rr = r & 15, cc = c & 31, ob = rr * 64 + cc * 2; return st * 1024 + (ob ^ (((ob >> 9) & 1) << 5)); }
__host__ __device__ __forceinline__ void stage_rc(int b, int& R, int& C) { const int st = b / 1024, sb = b % 1024, swz = sb ^ (((sb >> 9) & 1) << 5); R = (st >> 1) * 16 + swz / 64; C = (st & 1) * 32 + (swz % 64) / 2; }
__host__ __device__ __forceinline__ int perm32(int rho) { const int n = rho >> 4, i = rho & 15; return 8 * (i >> 2) + 4 * n + (i & 3); }

struct Unit { int pm, pn; };
struct Gemm { const bf16_t* A; const bf16_t* Bt; int M, N, K; };

struct StaticOrder {
    int nM, nN, nwg, G, c;
    __host__ __device__ void init(int M, int N, int G_, int c_) { nM = M / BM; nN = N / BM; nwg = nM * nN; G = G_; c = c_; }
    __host__ __device__ bool next(int i, Unit& u) const {
        const long L = (long)i * G + c; if (L >= nwg) return false;
        int wgid = (int)L; { const int q = nwg / NXCD, r = nwg % NXCD, xcd = wgid % NXCD, off = wgid / NXCD; wgid = (xcd < r ? xcd * (q + 1) : r * (q + 1) + (xcd - r) * q) + off; }
        const int nig = WGM * nN, gid = wgid / nig, fm = gid * WGM, gsz = (nM - fm) < WGM ? (nM - fm) : WGM;
        u.pm = fm + ((wgid % nig) % gsz); u.pn = (wgid % nig) / gsz; return true;
    }
    __device__ __forceinline__ void a_ready(const Unit&) const {}
    __device__ __forceinline__ void done(const Unit&) const {}
};

__device__ __forceinline__ unsigned cvt_pk_bf16(float lo, float hi) { unsigned r; asm volatile("v_cvt_pk_bf16_f32 %0, %1, %2" : "=v"(r) : "v"(lo), "v"(hi)); return r; }
typedef float f32x2 __attribute__((ext_vector_type(2)));
__device__ __forceinline__ f32x2 gelu_pk(f32x2 v) {
    const f32x2 av = __builtin_elementwise_abs(v), d = av * 0.2316418882f + 1.0f;
    f32x2 t; t.x = __builtin_amdgcn_rcpf(d.x); t.y = __builtin_amdgcn_rcpf(d.y);
    f32x2 q = t * 0.5307027145f + (-0.7265760135f); q = q * t + 0.7107068705f; q = q * t + (-0.142248368f); q = q * t + 0.127414796f; q = q * t;
    const f32x2 s = (v * v) * (-0.72134752044f);
    f32x2 e; e.x = __builtin_amdgcn_exp2f(s.x); e.y = __builtin_amdgcn_exp2f(s.y);
    const f32x2 m = v * (q * e), r = v - m;
    f32x2 o; o.x = v.x < 0.f ? m.x : r.x; o.y = v.y < 0.f ? m.y : r.y; return o;
}

typedef float f32x2_t __attribute__((ext_vector_type(2))); typedef __bf16 bf16x2_t __attribute__((ext_vector_type(2)));
__device__ __forceinline__ unsigned cvtpk(float lo, float hi) { f32x2_t v = {lo, hi}; bf16x2_t b = __builtin_convertvector(v, bf16x2_t); return __builtin_bit_cast(unsigned, b); }
__device__ __forceinline__ u32x4 pack8(f32x4 a, f32x4 b) { u32x4 w; w.x = cvtpk(a[0], a[1]); w.y = cvtpk(a[2], a[3]); w.z = cvtpk(b[0], b[1]); w.w = cvtpk(b[2], b[3]); return w; }
__device__ __forceinline__ void unpack8(u32x4 w, f32x4& a, f32x4& b) {
    a[0] = __uint_as_float(w.x << 16); a[1] = __uint_as_float(w.x & 0xffff0000u); a[2] = __uint_as_float(w.y << 16); a[3] = __uint_as_float(w.y & 0xffff0000u);
    b[0] = __uint_as_float(w.z << 16); b[1] = __uint_as_float(w.z & 0xffff0000u); b[2] = __uint_as_float(w.w << 16); b[3] = __uint_as_float(w.w & 0xffff0000u); }
__device__ __forceinline__ float sigm(float x) { return __builtin_amdgcn_rcpf(1.0f + __builtin_amdgcn_exp2f(-1.4426950408889634f * x)); }
__device__ __forceinline__ f32x4 sigm4(f32x4 v) { f32x4 o; o[0] = sigm(v[0]); o[1] = sigm(v[1]); o[2] = sigm(v[2]); o[3] = sigm(v[3]); return o; }
__device__ __forceinline__ f32x4 gelu4(f32x4 v) { f32x2 a = gelu_pk((f32x2){v[0], v[1]}), b = gelu_pk((f32x2){v[2], v[3]}); return (f32x4){a.x, a.y, b.x, b.y}; }
__device__ __forceinline__ float row_rstd(const float* S, int row) {
    const f32x4* p = (const f32x4*)(S + (size_t)row * 16); const f32x4 s = (p[0] + p[1]) + (p[2] + p[3]);
    return rsqrtf(((s[0] + s[1]) + (s[2] + s[3])) * (1.0f / 1024.0f) + 1e-6f); }
constexpr float QSCALE = 0.125f * 1.4426950408889634f;
struct Epi {
    static constexpr bool PERM = true, AFTER_DRAIN = false;
    int mode; bf16_t* Ob; int ldo; float* Of; int ldf; const float* Fin; int ldi; const bf16_t* G; const float* S; float* Sn; const bf16_t* T16; const bf16_t* Xin; const PG8_LAS float* rtab; int rbase;
    __device__ __forceinline__ void operator()(const f32x4 (&acc)[2][2][4][2], const Unit& u, int wr, int wc, int fr, int fq) const {
        const int row0 = u.pm * BM + wr * 64 + fr, col0 = u.pn * BM + wc * 32 + 8 * fq;
        if (mode == 1) {
            const int sec = u.pm >> 2; f32x4 rc[2][2];
#pragma unroll
            for (int bj = 0; bj < 2; ++bj)
#pragma unroll
                for (int n = 0; n < 2; ++n) rc[bj][n] = *(const PG8_LAS f32x4*)(rtab + (col0 + bj * HALF + 4 * n - rbase));
#pragma unroll
            for (int ai = 0; ai < 2; ++ai)
#pragma unroll
                for (int m = 0; m < 4; ++m) { const int row = row0 + ai * HALF + m * 16;
#pragma unroll
                    for (int bj = 0; bj < 2; ++bj) { f32x4 v0 = acc[ai][bj][m][0] * rc[bj][0], v1 = acc[ai][bj][m][1] * rc[bj][1];
                        if (sec == 0) { v0 = gelu4(v0); v1 = gelu4(v1); }
                        *(u32x4*)(Ob + (size_t)row * ldo + col0 + bj * HALF) = pack8(v0, v1); }
                    if (m & 1) asm volatile("" ::: "memory"); }
            return;
        }
        const int sec = u.pn >> 2;
        if (mode == 0 || mode == 5) {
#pragma unroll
            for (int ai = 0; ai < 2; ++ai) {
                float rsr[4];
#pragma unroll
                for (int m = 0; m < 4; ++m) {
                    if (mode == 0) { rsr[m] = rtab[row0 + ai * HALF + m * 16 - rbase]; }
                    else { const f32x4 p = ((const f32x4*)(S + (size_t)(row0 + ai * HALF + m * 16) * 16))[fq]; float s_ = (p[0] + p[1]) + (p[2] + p[3]);
                        s_ += __shfl_xor(s_, 16); s_ += __shfl_xor(s_, 32); rsr[m] = rsqrtf(s_ * (1.0f / 1024.0f) + 1e-6f); } }
#pragma unroll
                for (int m = 0; m < 4; ++m) { const int row = row0 + ai * HALF + m * 16; const float rs = rsr[m];
#pragma unroll
                    for (int bj = 0; bj < 2; ++bj) { const int col = col0 + bj * HALF; f32x4 v0 = acc[ai][bj][m][0] * rs, v1 = acc[ai][bj][m][1] * rs;
                        if (mode == 0) {
                            if (sec == 0) { v0 = gelu4(v0); v1 = gelu4(v1); }
                            else if (sec == 1 || sec == 4) { v0 = v0 * sigm4(v0); v1 = v1 * sigm4(v1); }
                            else if (sec == 2) { v0 = v0 * QSCALE; v1 = v1 * QSCALE; }
                            else if (sec >= 5) { v0 = sigm4(v0); v1 = sigm4(v1); }
                            *(u32x4*)(Ob + (size_t)row * ldo + col) = pack8(v0, v1);
                        } else { *(u32x4*)(Ob + (size_t)row * ldo + col) = pack8(sigm4(v0), sigm4(v1)); } }
                    asm volatile("" ::: "memory"); }
            }
            return;
        }
#pragma unroll
        for (int ai = 0; ai < 2; ++ai)
#pragma unroll
            for (int mh = 0; mh < 2; ++mh) {
                u32x4 gq[2][2], tq[2][2], xq[2][2]; f32x4 ta[2][2][2];
#pragma unroll
                for (int mm = 0; mm < 2; ++mm)
#pragma unroll
                    for (int bj = 0; bj < 2; ++bj) { const int row = row0 + ai * HALF + (2 * mh + mm) * 16, col = col0 + bj * HALF;
                        if (mode == 2 || mode == 3) gq[mm][bj] = *(const u32x4*)(G + (size_t)row * 7168 + col);
                        if (mode == 4 && Fin) { const float* t = Fin + (size_t)row * ldi + col; ta[mm][bj][0] = *(const f32x4*)t; ta[mm][bj][1] = *(const f32x4*)(t + 4); }
                        if ((mode == 4 && !Fin) || mode == 6) xq[mm][bj] = *(const u32x4*)(Xin + (size_t)row * 1024 + col);
                        if (mode == 3 || mode == 6) tq[mm][bj] = *(const u32x4*)(T16 + (size_t)row * 7168 + col);
                    }
#pragma unroll
                for (int mm = 0; mm < 2; ++mm) { const int m = 2 * mh + mm; const int row = row0 + ai * HALF + m * 16; float ss = 0.f;
#pragma unroll
                    for (int bj = 0; bj < 2; ++bj) { const int col = col0 + bj * HALF; f32x4 v0 = acc[ai][bj][m][0], v1 = acc[ai][bj][m][1];
                        if (mode == 2) { f32x4 g0, g1; unpack8(gq[mm][bj], g0, g1); *(u32x4*)(Ob + (size_t)row * ldo + col) = pack8(v0 * g0, v1 * g1); }
                        else if (mode == 3) { f32x4 g0, g1, t0, t1; unpack8(gq[mm][bj], g0, g1); unpack8(tq[mm][bj], t0, t1); v0 = t0 + v0 * g0; v1 = t1 + v1 * g1; *(u32x4*)(Ob + (size_t)row * ldo + col) = pack8(v0, v1); }
                        else { if (mode == 4) { if (Fin) { v0 = ta[mm][bj][0] + v0; v1 = ta[mm][bj][1] + v1; } else { f32x4 x0, x1; unpack8(xq[mm][bj], x0, x1); v0 = x0 + v0; v1 = x1 + v1; } }
                            else { f32x4 t0, t1, x0, x1; unpack8(tq[mm][bj], t0, t1); unpack8(xq[mm][bj], x0, x1); v0 = x0 + v0 * t0; v1 = x1 + v1 * t1; }
                            if (Of) { float* o = Of + (size_t)row * ldf + col; *(f32x4*)o = v0; *(f32x4*)(o + 4) = v1; }
                            *(u32x4*)(Ob + (size_t)row * ldo + col) = pack8(v0, v1);
                            ss += (v0[0] * v0[0] + v0[1] * v0[1]) + (v0[2] * v0[2] + v0[3] * v0[3]) + (v1[0] * v1[0] + v1[1] * v1[1]) + (v1[2] * v1[2] + v1[3] * v1[3]); } }
                    if (mode == 4 || mode == 6) { ss += __shfl_xor(ss, 16); ss += __shfl_xor(ss, 32); if (fq == 0) Sn[(size_t)row * 16 + u.pn * 4 + wc] = ss; } }
                asm volatile("" ::: "memory");
            }
    }
};
template <class Epi, class Sched, bool ALIGN_EPI = false, bool SP2 = false>
__device__ __forceinline__ void gemm_phase(PG8_LAS unsigned char* lds, const Gemm g, const Sched& S, const Epi& E) {
    int tid_ = threadIdx.x; asm volatile("" : "+v"(tid_)); const int tid = tid_, wid = __builtin_amdgcn_readfirstlane(tid >> 6), lane = tid & 63, wr = wid >> 2, wc = wid & 3, fr = lane & 15, fq = lane >> 4;
    int K_ = g.K; asm volatile("" : "+s"(K_)); const int K = K_, nt = K / BK;
    unsigned voffA[2], voffB[2];
#pragma unroll
    for (int i = 0; i < 2; ++i) { int R, C; stage_rc(tid * 16 + i * 8192, R, C); const int Rb = Epi::PERM ? ((R & ~31) + perm32(R & 31)) : R;
        voffA[i] = (unsigned)(R * K + C) * 2u; voffB[i] = (unsigned)(Rb * K + C) * 2u; }
    const size_t kstep = (size_t)(BK * 2);
    const size_t hstep = (size_t)HALF * K * 2;
    const size_t tstep = 2 * hstep;
    const unsigned ldsw = (unsigned)wid * 1024u;
    const int aoff = lds_byte(wr * 64 + fr, fq * 8), boff = lds_byte(wc * 32 + fr, fq * 8);
#define PG8_SA(b, h) (((b) * 2 + (h)) * HTB)
#define PG8_SB(b, h) ((4 + (b) * 2 + (h)) * HTB)
#define PG8_STAGE(bufoff, gbase, voff) do { _Pragma("unroll") for (int _i = 0; _i < 2; ++_i) \
        __builtin_amdgcn_global_load_lds((const unsigned*)((const char*)(gbase) + (voff)[_i]), (PG8_LAS unsigned*)(lds + (bufoff) + ldsw + _i * 8192), 16, 0, 0); } while (0)
#define PG8_LDA(dst, b, h) do { _Pragma("unroll") for (int m = 0; m < 4; ++m) _Pragma("unroll") for (int k = 0; k < 2; ++k) dst[m][k] = *(const PG8_LAS bf16x8*)(lds + PG8_SA(b, h) + aoff + m * 2048 + k * 1024); } while (0)
#define PG8_LDB(dst, b, h) do { _Pragma("unroll") for (int n = 0; n < 2; ++n) _Pragma("unroll") for (int k = 0; k < 2; ++k) dst[n][k] = *(const PG8_LAS bf16x8*)(lds + PG8_SB(b, h) + boff + n * 2048 + k * 1024); } while (0)
#define PG8_MMA(ai, bj, At, Bt) do { __builtin_amdgcn_s_setprio(1); _Pragma("unroll") for (int m = 0; m < 4; ++m) _Pragma("unroll") for (int n = 0; n < 2; ++n) _Pragma("unroll") for (int k = 0; k < 2; ++k) \
        acc[ai][bj][m][n] = __builtin_amdgcn_mfma_f32_16x16x32_bf16(Bt[n][k], At[m][k], acc[ai][bj][m][n], 0, 0, 0); __builtin_amdgcn_s_setprio(0); } while (0)
#define PG8_WAIT_V(n) asm volatile("s_waitcnt vmcnt(" #n ")" ::: "memory")
#define PG8_WAIT_L(n) asm volatile("s_waitcnt lgkmcnt(" #n ")" ::: "memory")
#define PG8_BAR __builtin_amdgcn_s_barrier()
#define PG8_SCHED __builtin_amdgcn_sched_barrier(0)
    Unit cur, nxt; int ui = 0;
    if (!S.next(0, cur)) return;
    f32x4 acc[2][2][4][2];
#pragma unroll
    for (int a = 0; a < 2; ++a)
#pragma unroll
        for (int b = 0; b < 2; ++b)
#pragma unroll
            for (int m = 0; m < 4; ++m)
#pragma unroll
                for (int n = 0; n < 2; ++n) acc[a][b][m][n] = (f32x4){0.f, 0.f, 0.f, 0.f};
    bf16x8 At[4][2], B0[2][2], B1[2][2];
    const char* cA = (const char*)g.A + (size_t)cur.pm * tstep; const char* cB = (const char*)g.Bt + (size_t)cur.pn * tstep;
    S.a_ready(cur);
    if constexpr (SP2) {
        PG8_STAGE(PG8_SB(0, 0), cB, voffB); PG8_STAGE(PG8_SB(0, 1), cB + hstep, voffB); PG8_STAGE(PG8_SA(0, 0), cA, voffA); PG8_STAGE(PG8_SA(0, 1), cA + hstep, voffA);
        if (wr == 1) PG8_BAR;
        PG8_WAIT_V(2); PG8_BAR;
        PG8_STAGE(PG8_SB(1, 0), cB + kstep, voffB); PG8_STAGE(PG8_SA(1, 0), cA + kstep, voffA); PG8_STAGE(PG8_SB(1, 1), cB + hstep + kstep, voffB);
        PG8_WAIT_V(6); PG8_BAR;
    } else {
        PG8_STAGE(PG8_SB(0, 0), cB, voffB); PG8_STAGE(PG8_SA(0, 0), cA, voffA); PG8_STAGE(PG8_SB(0, 1), cB + hstep, voffB); PG8_STAGE(PG8_SA(0, 1), cA + hstep, voffA);
        if (wr == 1) PG8_BAR;
        PG8_WAIT_V(4); PG8_BAR;
        PG8_STAGE(PG8_SB(1, 0), cB + kstep, voffB); PG8_STAGE(PG8_SA(1, 0), cA + kstep, voffA); PG8_STAGE(PG8_SB(1, 1), cB + hstep + kstep, voffB);
        PG8_WAIT_V(6); PG8_BAR;
    }
    for (;;) {
        const bool has_next = S.next(ui + 1, nxt);
        const char* nA = has_next ? (const char*)g.A + (size_t)nxt.pm * tstep : cA; const char* nB = has_next ? (const char*)g.Bt + (size_t)nxt.pn * tstep : cB;
        for (int t = 0; t < nt; t += 2) {
            const bool last = (t == nt - 2);
            const char* a1 = cA + (size_t)(t + 1) * kstep;
            const char* a2 = last ? nA : cA + (size_t)(t + 2) * kstep; const char* b2 = last ? nB : cB + (size_t)(t + 2) * kstep;
            const char* a3 = a2 + kstep; const char* b3 = b2 + kstep;
            if (last && has_next) S.a_ready(nxt);
            if constexpr (SP2) {
            PG8_LDB(B0, 0, 0); PG8_LDB(B1, 0, 1); PG8_SCHED; PG8_LDA(At, 0, 0); PG8_STAGE(PG8_SA(1, 1), a1 + hstep, voffA);
            PG8_WAIT_V(8); PG8_WAIT_L(0); PG8_BAR; PG8_MMA(0, 0, At, B0); PG8_MMA(0, 1, At, B1); PG8_BAR; PG8_SCHED;
            PG8_LDA(At, 0, 1); PG8_STAGE(PG8_SB(0, 0), b2, voffB); PG8_STAGE(PG8_SB(0, 1), b2 + hstep, voffB); PG8_STAGE(PG8_SA(0, 0), a2, voffA);
            PG8_WAIT_V(8); PG8_WAIT_L(0); PG8_BAR; PG8_MMA(1, 0, At, B0); PG8_MMA(1, 1, At, B1); PG8_BAR; PG8_SCHED;
            PG8_LDB(B0, 1, 0); PG8_LDB(B1, 1, 1); PG8_SCHED; PG8_LDA(At, 1, 0); PG8_STAGE(PG8_SA(0, 1), a2 + hstep, voffA);
            PG8_WAIT_V(8); PG8_WAIT_L(0); PG8_BAR; PG8_MMA(0, 0, At, B0); PG8_MMA(0, 1, At, B1); PG8_BAR; PG8_SCHED;
            PG8_LDA(At, 1, 1); PG8_STAGE(PG8_SB(1, 0), b3, voffB); PG8_STAGE(PG8_SB(1, 1), b3 + hstep, voffB); PG8_STAGE(PG8_SA(1, 0), a3, voffA);
            PG8_WAIT_V(8); PG8_WAIT_L(0); PG8_BAR; PG8_MMA(1, 0, At, B0); PG8_MMA(1, 1, At, B1); PG8_BAR; PG8_SCHED;
            } else {
            PG8_LDB(B0, 0, 0); PG8_SCHED; PG8_LDA(At, 0, 0); PG8_STAGE(PG8_SA(1, 1), a1 + hstep, voffA);
            PG8_WAIT_L(8); PG8_BAR; PG8_WAIT_L(0); PG8_MMA(0, 0, At, B0); PG8_BAR; PG8_SCHED;
            PG8_LDB(B1, 0, 1); PG8_STAGE(PG8_SB(0, 0), b2, voffB);
            PG8_BAR; PG8_WAIT_L(0); PG8_MMA(0, 1, At, B1); PG8_BAR;
            PG8_LDA(At, 0, 1); PG8_STAGE(PG8_SA(0, 0), a2, voffA);
            PG8_BAR; PG8_WAIT_L(0); PG8_MMA(1, 0, At, B0); PG8_BAR; PG8_SCHED;
            PG8_STAGE(PG8_SB(0, 1), b2 + hstep, voffB);
            PG8_WAIT_V(6); PG8_BAR; PG8_MMA(1, 1, At, B1); PG8_BAR;
            PG8_LDB(B0, 1, 0); PG8_SCHED; PG8_LDA(At, 1, 0); PG8_STAGE(PG8_SA(0, 1), a2 + hstep, voffA);
            PG8_WAIT_L(8); PG8_BAR; PG8_WAIT_L(0); PG8_MMA(0, 0, At, B0); PG8_BAR; PG8_SCHED;
            PG8_LDB(B1, 1, 1); PG8_STAGE(PG8_SB(1, 0), b3, voffB);
            PG8_BAR; PG8_WAIT_L(0); PG8_MMA(0, 1, At, B1); PG8_BAR;
            PG8_LDA(At, 1, 1); PG8_STAGE(PG8_SA(1, 0), a3, voffA);
            PG8_BAR; PG8_WAIT_L(0); PG8_MMA(1, 0, At, B0); PG8_BAR; PG8_SCHED;
            PG8_STAGE(PG8_SB(1, 1), b3 + hstep, voffB);
            PG8_WAIT_V(6); PG8_BAR; PG8_MMA(1, 1, At, B1); PG8_BAR;
            }
        }
        if constexpr (ALIGN_EPI) { if (wr == 0) PG8_BAR; }
        if constexpr (!Epi::AFTER_DRAIN) { E(acc, cur, wr, wc, fr, fq); S.done(cur); }
        if (!has_next) break;
#pragma unroll
        for (int a = 0; a < 2; ++a)
#pragma unroll
            for (int b = 0; b < 2; ++b)
#pragma unroll
                for (int m = 0; m < 4; ++m)
#pragma unroll
                    for (int n = 0; n < 2; ++n) acc[a][b][m][n] = (f32x4){0.f, 0.f, 0.f, 0.f};
        cur = nxt; cA = nA; cB = nB; ++ui;
        if constexpr (ALIGN_EPI) { if (wr == 1) PG8_BAR; }
    }
    PG8_WAIT_V(0);
    if constexpr (!ALIGN_EPI) { if (wr == 0) PG8_BAR; }
    PG8_BAR;
    if constexpr (Epi::AFTER_DRAIN) { E.fused(acc, cur, wr, wc, fr, fq, lds, wid, lane); S.done(cur); }
#undef PG8_SA
#undef PG8_SB
#undef PG8_STAGE
#undef PG8_LDA
#undef PG8_LDB
#undef PG8_MMA
#undef PG8_WAIT_V
#undef PG8_WAIT_L
#undef PG8_BAR
#undef PG8_SCHED
}
}

#define LAS __attribute__((address_space(3)))
typedef unsigned short bf16_t;
typedef short bf16x8 __attribute__((ext_vector_type(8)));
typedef float f32x4 __attribute__((ext_vector_type(4)));
typedef float f32x16 __attribute__((ext_vector_type(16)));
typedef unsigned u32x4 __attribute__((ext_vector_type(4)));
typedef unsigned u32x2 __attribute__((ext_vector_type(2)));
using pg8::cvtpk; using pg8::pack8; using pg8::unpack8;
constexpr int NTHREADS = 512, NWAVES = 8;
constexpr int MH = 16384, DM = 1024, SEQ = 4096, NB_H = 4, NLAYER = 4, NP1 = 7168, NV2 = 2048, PLE = 256, NHEAD = 8;
constexpr size_t MiB = 1u << 20;
constexpr size_t LW_IN = 0, LW_A = (size_t)9216 * 1024, LW_B = LW_A + 1048576, LW_O = LW_B + 1048576, LW_G = LW_O + 1048576, LW_P = LW_G + 1048576, LW_TOTAL = LW_P + 262144;
constexpr size_t WS_W = 1 * MiB, WS_PROJ = 108 * MiB, WS_VT2 = 332 * MiB, WS_X0 = 396 * MiB, WS_X1 = 428 * MiB, WS_BRA = 460 * MiB, WS_BRB = 492 * MiB, WS_PB = 524 * MiB, WS_S0 = 532 * MiB, WS_S1 = 533 * MiB, WS_END = 534 * MiB;
static_assert(WS_W + LW_TOTAL * 2 * NLAYER <= WS_PROJ, "weights fit");
constexpr int TMP_LD = NP1 / 2;
constexpr int LDS_BYTES = 147456;
constexpr float EPS = 1e-6f;

struct Args {
    const float *x, *p, *norm_g, *w_in, *a_ln_g, *a_ln_b, *a_ws, *a_bs, *lam_q, *lam_k, *subln_g, *w_a_out, *w_b_out, *w_o, *ple_norm_g, *w_ple, *w_ple_gate, *final_g;
    float* out; unsigned char* ws;
};

__device__ __forceinline__ float wave_sum(float v) {
#pragma unroll
    for (int o = 1; o < 64; o <<= 1) v += __shfl_xor(v, o);
    return v;
}
#define LDS_WAIT() asm volatile("s_waitcnt lgkmcnt(0)" ::: "memory")

__device__ __forceinline__ void tr_item(const float* W, int K, int N, const float* scale, bf16_t* WT, int dst_row0, LAS float* scr, int k0, int n0, int lane) {
    f32x4 v[8];
#pragma unroll
    for (int i = 0; i < 8; ++i) v[i] = *(const f32x4*)(W + (size_t)(k0 + 4 * i + (lane >> 4)) * N + n0 + (lane & 15) * 4);
#pragma unroll
    for (int i = 0; i < 8; ++i) { const int kk = 4 * i + (lane >> 4); f32x4 x = v[i]; if (scale) x = x * scale[k0 + kk]; *(LAS f32x4*)(scr + kk * 68 + (lane & 15) * 4) = x; }
    LDS_WAIT(); asm volatile("" ::: "memory");
    bf16_t* o = WT + (size_t)(dst_row0 + lane) * K + k0;
#pragma unroll
    for (int j = 0; j < 4; ++j) { const LAS float* s = scr + (8 * j) * 68 + lane;
        u32x4 w; w.x = cvtpk(s[0 * 68], s[1 * 68]); w.y = cvtpk(s[2 * 68], s[3 * 68]); w.z = cvtpk(s[4 * 68], s[5 * 68]); w.w = cvtpk(s[6 * 68], s[7 * 68]);
        *(u32x4*)(o + 8 * j) = w; }
    LDS_WAIT(); asm volatile("" ::: "memory");
}
typedef const __attribute__((address_space(4))) Args* cargs_t;
__device__ __forceinline__ void weights_prologue(cargs_t ap, LAS unsigned char* lds, int gw, int ngw, int wave, int lane) {
    LAS float* scr = (LAS float*)(lds + wave * 16384);
    bf16_t* WT = (bf16_t*)(ap->ws + WS_W);
    constexpr int I_IN = 32 * 144, I_SQ = 32 * 16, I_P = 8 * 16, I_L = I_IN + 4 * I_SQ + I_P;
    for (int it = gw; it < I_L * NLAYER; it += ngw) {
        const int l = it / I_L; int r = it % I_L; bf16_t* wl = WT + (size_t)l * LW_TOTAL;
        if (r < I_IN) { const int kb = r / 144, nb = r % 144, n0 = nb * 64; const int osec = n0 >> 10;
            const int nsec = (int)((0x654832170ull >> (4 * osec)) & 0xFull);
            tr_item(ap->w_in + (size_t)l * 1024 * 9216, 1024, 9216, ap->norm_g + l * 1024, wl + LW_IN, nsec * 1024 + (n0 & 1023), scr, kb * 32, n0, lane);
            continue; }
        r -= I_IN;
        if (r < 4 * I_SQ) { const int which = r / I_SQ; const int rr = r % I_SQ; const int kb = rr / 16, nb = rr % 16;
            const float* src = which == 0 ? ap->w_a_out : which == 1 ? ap->w_b_out : which == 2 ? ap->w_o : ap->w_ple_gate;
            const size_t off = which == 0 ? LW_A : which == 1 ? LW_B : which == 2 ? LW_O : LW_G;
            tr_item(src + (size_t)l * 1048576, 1024, 1024, which == 3 ? ap->ple_norm_g + l * 1024 : nullptr, wl + off, nb * 64, scr, kb * 32, nb * 64, lane);
            continue; }
        r -= 4 * I_SQ;
        { const int kb = r / 16, nb = r % 16; tr_item(ap->w_ple + (size_t)l * 262144, 256, 1024, nullptr, wl + LW_P, nb * 64, scr, kb * 32, nb * 64, lane); }
    }
}

__device__ __forceinline__ void init_rows(const float* x, bf16_t* XB, float* S, int gw, int ngw, int lane) {
    asm volatile("" : "+v"(lane)); asm volatile("" : "+s"(gw));
    for (int m = gw; m < MH; m += ngw) {
        const f32x4* xr = (const f32x4*)(x + (size_t)m * DM) + lane; float s = 0.f; f32x4 v[4];
#pragma unroll
        for (int j = 0; j < 4; ++j) { v[j] = xr[64 * j]; s += (v[j][0] * v[j][0] + v[j][1] * v[j][1]) + (v[j][2] * v[j][2] + v[j][3] * v[j][3]); }
        s = wave_sum(s);
        u32x2* o = (u32x2*)(XB + (size_t)m * DM) + lane;
#pragma unroll
        for (int j = 0; j < 4; ++j) { u32x2 w; w.x = cvtpk(v[j][0], v[j][1]); w.y = cvtpk(v[j][2], v[j][3]); o[64 * j] = w; }
        if (lane < 16) S[(size_t)m * 16 + lane] = lane == 0 ? s : 0.f;
    }
}
__device__ __forceinline__ void final_rows(float* out, const float* g, int gw, int ngw, int lane) {
    asm volatile("" : "+v"(lane)); asm volatile("" : "+s"(gw));
    for (int m = gw; m < MH; m += ngw) {
        f32x4* xr = (f32x4*)(out + (size_t)m * DM) + lane; float s = 0.f; f32x4 v[4];
#pragma unroll
        for (int j = 0; j < 4; ++j) { v[j] = xr[64 * j]; s += (v[j][0] * v[j][0] + v[j][1] * v[j][1]) + (v[j][2] * v[j][2] + v[j][3] * v[j][3]); }
        const float rs = rsqrtf(wave_sum(s) * (1.0f / DM) + EPS);
#pragma unroll
        for (int j = 0; j < 4; ++j) { const f32x4 gg = ((const f32x4*)g)[64 * j + lane]; xr[64 * j] = v[j] * rs * gg; }
    }
}
__device__ __forceinline__ void convert_p(const float* p, bf16_t* PB, int gtid, int nthr) {
    asm volatile("" : "+v"(gtid));
    for (int i = gtid; i < MH * PLE / 8; i += nthr) { const f32x4 a = ((const f32x4*)p)[2 * i], b = ((const f32x4*)p)[2 * i + 1]; ((u32x4*)PB)[i] = pack8(a, b); }
}

__device__ __forceinline__ void gmlp_unit(LAS unsigned char* lds, const bf16_t* PROJ, const bf16_t* VT2, bf16_t* BRA, const float* lng, const float* lnb, const float* ws, const float* bs, int c, int gh) {
    int tid_ = threadIdx.x; asm volatile("" : "+v"(tid_)); const int tid = tid_, lane = tid & 63, l32 = lane & 31, hi = lane >> 5; const int w = __builtin_amdgcn_readfirstlane(tid >> 6);
    const int tok0 = c * 128;
    LAS float* red = (LAS float*)lds;
    LAS float* stat = (LAS float*)(lds + 32768);
    LAS unsigned char* T = lds + 34816;
    { const int sc = tid & 15, rg = tid >> 4; float s[8], q[8];
#pragma unroll
      for (int j = 0; j < 8; ++j) { s[j] = 0.f; q[j] = 0.f; }
      for (int i = 0; i < 32; ++i) { const u32x4 wv = *(const u32x4*)(VT2 + (size_t)(rg + 32 * i) * MH + tok0 + sc * 8); f32x4 a, b; unpack8(wv, a, b);
#pragma unroll
          for (int j = 0; j < 4; ++j) { s[j] += a[j]; q[j] += a[j] * a[j]; s[4 + j] += b[j]; q[4 + j] += b[j] * b[j]; } }
#pragma unroll
      for (int j = 0; j < 8; ++j) { red[rg * 256 + sc * 8 + j] = s[j]; red[rg * 256 + 128 + sc * 8 + j] = q[j]; } }
    __syncthreads();
    if (tid < 128) { float s = 0.f, q = 0.f;
        for (int i = 0; i < 32; ++i) { s += red[i * 256 + tid]; q += red[i * 256 + 128 + tid]; }
        const float mean = s * (1.0f / 1024.0f); const float var = q * (1.0f / 1024.0f) - mean * mean;
        stat[2 * tid] = mean; stat[2 * tid + 1] = rsqrtf(var + EPS); }
    __syncthreads();
    const int tb = w & 3, dh = w >> 2;
    u32x4 pre[4];
#pragma unroll
    for (int i = 0; i < 4; ++i) { const int p = tid + 512 * i; pre[i] = *(const u32x4*)(VT2 + (size_t)(gh * 512 + (p >> 4)) * MH + tok0 + (p & 15) * 8); }
    for (int gi = 0; gi < 4; ++gi) { const int g = gh * 4 + gi;
#pragma unroll
        for (int i = 0; i < 4; ++i) { const int p = tid + 512 * i, d = p >> 4, sc = p & 15;
            f32x4 a, b; unpack8(pre[i], a, b);
            const float gg = lng[g * 128 + d], bb = lnb[g * 128 + d];
#pragma unroll
            for (int j = 0; j < 4; ++j) { a[j] = (a[j] - stat[2 * (sc * 8 + j)]) * stat[2 * (sc * 8 + j) + 1] * gg + bb; b[j] = (b[j] - stat[2 * (sc * 8 + 4 + j)]) * stat[2 * (sc * 8 + 4 + j) + 1] * gg + bb; }
            *(LAS u32x4*)(T + d * 272 + sc * 16) = pack8(a, b); }
        if (gi < 3) {
#pragma unroll
            for (int i = 0; i < 4; ++i) { const int p = tid + 512 * i; pre[i] = *(const u32x4*)(VT2 + (size_t)((g + 1) * 128 + (p >> 4)) * MH + tok0 + (p & 15) * 8); } }
        __syncthreads();
        f32x16 acc0 = {}, acc1 = {};
        const float* wrow = ws + (size_t)g * 16384 + (size_t)(32 * tb + l32) * 128 + 8 * hi;
        const int trow = 32 * tb + l32;
        for (int ks = 0; ks < 2 * tb + 2; ++ks) {
            f32x4 wa = *(const f32x4*)(wrow + 16 * ks), wb = *(const f32x4*)(wrow + 16 * ks + 4); const int s0 = 16 * ks + 8 * hi;
#pragma unroll
            for (int j = 0; j < 4; ++j) { if (s0 + j > trow) wa[j] = 0.f; if (s0 + 4 + j > trow) wb[j] = 0.f; }
            const bf16x8 A = __builtin_bit_cast(bf16x8, pack8(wa, wb));
            const bf16x8 B0 = *(const LAS bf16x8*)(T + (64 * dh + l32) * 272 + (16 * ks + 8 * hi) * 2);
            const bf16x8 B1 = *(const LAS bf16x8*)(T + (64 * dh + 32 + l32) * 272 + (16 * ks + 8 * hi) * 2);
            acc0 = __builtin_amdgcn_mfma_f32_32x32x16_bf16(A, B0, acc0, 0, 0, 0);
            acc1 = __builtin_amdgcn_mfma_f32_32x32x16_bf16(A, B1, acc1, 0, 0, 0);
        }
        LAS float* Yb = (LAS float*)(lds + 71680);
#pragma unroll
        for (int r = 0; r < 16; ++r) { const int t = 32 * tb + (r & 3) + 8 * (r >> 2) + 4 * hi; const float bv = bs[g * 128 + t];
            Yb[t * 132 + 64 * dh + l32] = acc0[r] + bv; Yb[t * 132 + 64 * dh + 32 + l32] = acc1[r] + bv; }
        __syncthreads();
#pragma unroll
        for (int i = 0; i < 4; ++i) { const int p = tid + 512 * i, t = p >> 4, c8 = p & 15; const size_t tok = (size_t)(tok0 + t); const int col = g * 128 + c8 * 8;
            f32x4 u0, u1, z0, z1; unpack8(*(const u32x4*)(PROJ + tok * NP1 + col), u0, u1); unpack8(*(const u32x4*)(PROJ + tok * NP1 + 1024 + col), z0, z1);
            const f32x4 y0 = *(const LAS f32x4*)(Yb + t * 132 + c8 * 8), y1 = *(const LAS f32x4*)(Yb + t * 132 + c8 * 8 + 4);
            *(u32x4*)(BRA + tok * DM + col) = pack8(u0 * y0 * z0, u1 * y1 * z1); }
        __syncthreads();
    }
}

constexpr int AT_KS = 17408, AT_VS = 18432, AT_VOFF = 2 * AT_KS;
__device__ __forceinline__ void attn_unit(LAS unsigned char* lds, const bf16_t* PROJ, const bf16_t* VT2, bf16_t* BRB, const float* subg, float lam, float lam_init, int b, int h, int qb) {
    int tid_ = threadIdx.x; asm volatile("" : "+v"(tid_)); const int tid = tid_, lane = tid & 63, l32 = lane & 31, hi = lane >> 5; const int w = __builtin_amdgcn_readfirstlane(tid >> 6); const int map = w >> 2, wq = w & 3;
    const int rowbase = b * SEQ, q0 = qb * 128, myq = q0 + wq * 32 + l32, NT = 2 * qb + 2;
    bf16x8 qf[4];
    { const bf16_t* qp = PROJ + (size_t)(rowbase + myq) * NP1 + 2048 + h * 128 + map * 64 + hi * 8;
#pragma unroll
      for (int ks = 0; ks < 4; ++ks) qf[ks] = *(const bf16x8*)(qp + ks * 16); }
    const bf16_t* ksrc[2]; const bf16_t* vsrc[2]; int kdst[2], vdst[2];
#pragma unroll
    for (int i = 0; i < 2; ++i) { const int p = tid + 512 * i;
        ksrc[i] = PROJ + (size_t)(rowbase + (p >> 4)) * NP1 + 3072 + h * 128 + (p & 15) * 8; kdst[i] = (p >> 4) * 272 + (p & 15) * 16;
        vsrc[i] = VT2 + (size_t)(1024 + h * 128 + (p >> 3)) * MH + rowbase + (p & 7) * 8; vdst[i] = AT_VOFF + (p >> 3) * 144 + (((p & 7) >> 1) * 16 + (p & 1) * 4) * 2; }
    u32x4 kr[2], vr[2];
#pragma unroll
    for (int i = 0; i < 2; ++i) { kr[i] = *(const u32x4*)(ksrc[i]); vr[i] = *(const u32x4*)(vsrc[i]); }
#pragma unroll
    for (int i = 0; i < 2; ++i) { *(LAS u32x4*)(lds + kdst[i]) = kr[i]; *(LAS u32x2*)(lds + vdst[i]) = (u32x2){vr[i].x, vr[i].y}; *(LAS u32x2*)(lds + vdst[i] + 16) = (u32x2){vr[i].z, vr[i].w}; }
    __syncthreads();
    f32x16 O[4]; O[0] = f32x16{}; O[1] = f32x16{}; O[2] = f32x16{}; O[3] = f32x16{};
    float m_run = -1e30f, l_run = 0.f;
    for (int t = 0; t < NT; ++t) {
        const int buf = t & 1, kv0 = 64 * t;
        if (t + 1 < NT) {
#pragma unroll
            for (int i = 0; i < 2; ++i) { kr[i] = *(const u32x4*)(ksrc[i] + (size_t)(kv0 + 64) * NP1); vr[i] = *(const u32x4*)(vsrc[i] + kv0 + 64); } }
        if (kv0 <= q0 + wq * 32 + 31) {
            LAS unsigned char* Kb = lds + buf * AT_KS + l32 * 272 + map * 128 + hi * 16;
            LAS unsigned char* Vb = lds + AT_VOFF + buf * AT_VS + l32 * 144 + hi * 16;
            f32x16 S0 = {}, S1 = {};
            { bf16x8 kf[8];
#pragma unroll
              for (int ks = 0; ks < 4; ++ks) { kf[2 * ks] = *(const LAS bf16x8*)(Kb + ks * 32); kf[2 * ks + 1] = *(const LAS bf16x8*)(Kb + 32 * 272 + ks * 32); }
              __builtin_amdgcn_sched_barrier(0);
#pragma unroll
              for (int ks = 0; ks < 4; ++ks) { S0 = __builtin_amdgcn_mfma_f32_32x32x16_bf16(kf[2 * ks], qf[ks], S0, 0, 0, 0); S1 = __builtin_amdgcn_mfma_f32_32x32x16_bf16(kf[2 * ks + 1], qf[ks], S1, 0, 0, 0); } }
            u32x4 va[8], vb[8];
#pragma unroll
            for (int j = 0; j < 2; ++j)
#pragma unroll
                for (int db = 0; db < 4; ++db) va[j * 4 + db] = *(const LAS u32x4*)(Vb + db * 32 * 144 + j * 32);
            __builtin_amdgcn_sched_barrier(0);
            if (t >= NT - 2) {
#pragma unroll
                for (int r = 0; r < 16; ++r) { const int kv = kv0 + (r & 3) + 8 * (r >> 2) + 4 * hi; if (kv > myq) S0[r] = -1e30f; if (kv + 32 > myq) S1[r] = -1e30f; } }
            float mx = __builtin_fmaxf(__builtin_fmaxf(S0[0], S1[0]), __builtin_fmaxf(S0[1], S1[1]));
#pragma unroll
            for (int r = 2; r < 16; r += 2) { mx = __builtin_fmaxf(__builtin_fmaxf(mx, S0[r]), S1[r]); mx = __builtin_fmaxf(__builtin_fmaxf(mx, S0[r + 1]), S1[r + 1]); }
            if (__any(mx > m_run + 8.0f)) { mx = fmaxf(mx, __shfl_xor(mx, 32)); const float mnew = fmaxf(m_run, mx), alpha = __builtin_amdgcn_exp2f(m_run - mnew); m_run = mnew; l_run *= alpha;
#pragma unroll
                for (int db = 0; db < 4; ++db)
#pragma unroll
                    for (int r = 0; r < 16; ++r) O[db][r] *= alpha; }
            pg8::f32x2 ps2 = {0.f, 0.f};
#pragma unroll
            for (int r = 0; r < 16; r += 2) { S0[r] = __builtin_amdgcn_exp2f(S0[r] - m_run); S0[r + 1] = __builtin_amdgcn_exp2f(S0[r + 1] - m_run); ps2 += (pg8::f32x2){S0[r], S0[r + 1]}; }
            bf16x8 pf[4];
#pragma unroll
            for (int j = 0; j < 2; ++j) { u32x4 pw;
#pragma unroll
                for (int i = 0; i < 4; ++i) pw[i] = cvtpk(S0[8 * j + 2 * i], S0[8 * j + 2 * i + 1]);
                pf[j] = __builtin_bit_cast(bf16x8, pw); }
#pragma unroll
            for (int j = 2; j < 4; ++j)
#pragma unroll
                for (int db = 0; db < 4; ++db) vb[(j - 2) * 4 + db] = *(const LAS u32x4*)(Vb + db * 32 * 144 + j * 32);
            __builtin_amdgcn_sched_barrier(0);
#pragma unroll
            for (int j = 0; j < 2; ++j)
#pragma unroll
                for (int db = 0; db < 4; ++db) O[db] = __builtin_amdgcn_mfma_f32_32x32x16_bf16(__builtin_bit_cast(bf16x8, va[j * 4 + db]), pf[j], O[db], 0, 0, 0);
#pragma unroll
            for (int r = 0; r < 16; r += 2) { S1[r] = __builtin_amdgcn_exp2f(S1[r] - m_run); S1[r + 1] = __builtin_amdgcn_exp2f(S1[r + 1] - m_run); ps2 += (pg8::f32x2){S1[r], S1[r + 1]}; }
#pragma unroll
            for (int j = 2; j < 4; ++j) { u32x4 pw;
#pragma unroll
                for (int i = 0; i < 4; ++i) pw[i] = cvtpk(S1[8 * (j & 1) + 2 * i], S1[8 * (j & 1) + 2 * i + 1]);
                pf[j] = __builtin_bit_cast(bf16x8, pw); }
#pragma unroll
            for (int k = 0; k < 8; ++k) { __builtin_amdgcn_sched_group_barrier(0x008, 1, 0); __builtin_amdgcn_sched_group_barrier(0x002, 6, 0); }
            __builtin_amdgcn_sched_barrier(0);
            l_run += ps2.x + ps2.y;
#pragma unroll
            for (int j = 2; j < 4; ++j)
#pragma unroll
                for (int db = 0; db < 4; ++db) O[db] = __builtin_amdgcn_mfma_f32_32x32x16_bf16(__builtin_bit_cast(bf16x8, vb[(j - 2) * 4 + db]), pf[j], O[db], 0, 0, 0);
        }
        if (t + 1 < NT) {
#pragma unroll
            for (int i = 0; i < 2; ++i) { *(LAS u32x4*)(lds + (buf ^ 1) * AT_KS + kdst[i]) = kr[i]; *(LAS u32x2*)(lds + (buf ^ 1) * AT_VS + vdst[i]) = (u32x2){vr[i].x, vr[i].y}; *(LAS u32x2*)(lds + (buf ^ 1) * AT_VS + vdst[i] + 16) = (u32x2){vr[i].z, vr[i].w}; } }
        __syncthreads();
    }
    const float inv = 1.0f / (l_run + __shfl_xor(l_run, 32));
    LAS float* X = (LAS float*)lds + wq * 4096 + lane;
    if (map == 1) { const float sc = -lam * inv;
#pragma unroll
        for (int db = 0; db < 4; ++db)
#pragma unroll
            for (int r = 0; r < 16; ++r) X[(db * 16 + r) * 64] = O[db][r] * sc; }
    __syncthreads();
    if (map == 0) { float ss = 0.f;
#pragma unroll
        for (int db = 0; db < 4; ++db)
#pragma unroll
            for (int r = 0; r < 16; ++r) { const float o = O[db][r] * inv + X[(db * 16 + r) * 64]; O[db][r] = o; ss += o * o; }
        ss += __shfl_xor(ss, 32);
        const float rs = rsqrtf(ss * (1.0f / 128.0f) + EPS) * (1.0f - lam_init);
        LAS float* Zr = (LAS float*)(lds + 65536) + (wq * 32 + l32) * 132;
#pragma unroll
        for (int db = 0; db < 4; ++db)
#pragma unroll
            for (int rg = 0; rg < 4; ++rg) { const int d = 32 * db + 8 * rg + 4 * hi; const f32x4 gg = *(const f32x4*)(subg + d);
                *(LAS f32x4*)(Zr + d) = (f32x4){O[db][4 * rg] * rs * gg[0], O[db][4 * rg + 1] * rs * gg[1], O[db][4 * rg + 2] * rs * gg[2], O[db][4 * rg + 3] * rs * gg[3]}; } }
    __syncthreads();
#pragma unroll
    for (int i = 0; i < 4; ++i) { const int p = tid + 512 * i, q = p >> 4, c8 = p & 15; const size_t row = (size_t)(rowbase + q0 + q);
        f32x4 z0, z1; unpack8(*(const u32x4*)(PROJ + row * NP1 + 4096 + h * 128 + c8 * 8), z0, z1);
        const LAS float* zp = (const LAS float*)(lds + 65536) + q * 132 + c8 * 8;
        const f32x4 v0 = *(const LAS f32x4*)zp, v1 = *(const LAS f32x4*)(zp + 4);
        *(u32x4*)(BRB + row * DM + h * 128 + c8 * 8) = pack8(v0 * z0, v1 * z1); }
    __syncthreads();
}

#define RLX_AGENT __ATOMIC_RELAXED, __HIP_MEMORY_SCOPE_AGENT
#define XB_TMO      128
#define XB_XCNT(j)  (256  + 64 * (j))
#define XB_XSUB(j)  (1280 + 64 * (j))
#define XB_XGEN(j)  (2304 + 64 * (j))
#define XB_TOP      3328
#define XB_TOPGEN   3392
#define XCD_BAR_WORDS 3456
#define XB_SPIN_CAP (1u << 18)

__device__ __forceinline__ unsigned xb_ld(unsigned* p)              { return __hip_atomic_load(p, __ATOMIC_RELAXED, __HIP_MEMORY_SCOPE_AGENT); }
__device__ __forceinline__ unsigned xb_add(unsigned* p, unsigned v) { return __hip_atomic_fetch_add(p, v, __ATOMIC_RELAXED, __HIP_MEMORY_SCOPE_AGENT); }
__device__ __forceinline__ unsigned xb_xcc_id() { return (unsigned)__builtin_amdgcn_s_getreg((3 << 11) | 20) & 0xFu; }
#define XB_SPIN(cond, bar) do { unsigned _sp = 0; while (cond) { __builtin_amdgcn_s_sleep(1); \
    if ((++_sp & 255u) == 0u) { if (xb_ld(&(bar)[XB_TMO])) break; if (_sp > XB_SPIN_CAP) { atomicAdd(&(bar)[XB_TMO], 1u); break; } } } } while (0)

struct XcdBarrier {
    unsigned* bar; unsigned x;
    volatile LAS unsigned* st;
};

__device__ __forceinline__ XcdBarrier xcd_barrier_post(unsigned* bar, volatile LAS unsigned* st) {
    XcdBarrier b; b.bar = bar; b.x = xb_xcc_id(); b.st = st;
    if (threadIdx.x == 0) (void)xb_add(&bar[XB_XCNT(b.x)], 1u);
    return b;
}
__device__ __forceinline__ void xcd_barrier_complete(unsigned* bar, unsigned x, unsigned& nloc, unsigned& nx) {
    const unsigned G = gridDim.x * gridDim.y * gridDim.z;
    unsigned sum, cnt, mine, sp = 0u;
    for (;;) {
        sum = 0u; cnt = 0u; mine = 0u;
#pragma unroll
        for (unsigned j = 0; j < 16; ++j) { const unsigned c = xb_ld(&bar[XB_XCNT(j)]); sum += c; cnt += (c > 0u) ? 1u : 0u; mine = (j == x) ? c : mine; }
        if (sum == G) break;
        __builtin_amdgcn_s_sleep(1);
        if ((++sp & 255u) == 0u) { if (xb_ld(&bar[XB_TMO])) break; if (sp > XB_SPIN_CAP) { atomicAdd(&bar[XB_TMO], 1u); break; } }
    }
    nloc = mine > 0u ? mine : 1u; nx = cnt > 0u ? cnt : 1u;
}

__device__ __forceinline__ void xcd_barrier(const XcdBarrier& b) {
    asm volatile("s_waitcnt vmcnt(0)" ::: "memory");
    __syncthreads();
    if (threadIdx.x == 0) {
        unsigned* bar = b.bar;
        __builtin_amdgcn_s_waitcnt(0);
        unsigned nloc = b.st[0], nx = b.st[1];
        if (nloc == 0u) { xcd_barrier_complete(bar, b.x, nloc, nx); b.st[0] = nloc; b.st[1] = nx; }
        const unsigned old = xb_add(&bar[XB_XSUB(b.x)], 1u);
        const unsigned gen = old / nloc;
        if (old + 1u == (gen + 1u) * nloc) {
            __builtin_amdgcn_fence(__ATOMIC_RELEASE, "agent");
            asm volatile("s_waitcnt vmcnt(0)" ::: "memory");
            const unsigned og = xb_add(&bar[XB_TOP], 1u);
            const unsigned tg = og / nx;
            if (og + 1u == (tg + 1u) * nx) xb_add(&bar[XB_TOPGEN], 1u);
            else XB_SPIN(xb_ld(&bar[XB_TOPGEN]) == tg, bar);
            __builtin_amdgcn_fence(__ATOMIC_ACQUIRE, "agent");
            xb_add(&bar[XB_XGEN(b.x)], 1u);
            asm volatile("s_waitcnt vmcnt(0)" ::: "memory");
        } else {
            XB_SPIN(xb_ld(&bar[XB_XGEN(b.x)]) == gen, bar);
            __builtin_amdgcn_fence(__ATOMIC_ACQUIRE, "agent");
            asm volatile("s_waitcnt vmcnt(0)" ::: "memory");
        }
    }
    __syncthreads();
}


__global__ void __launch_bounds__(NTHREADS, 2) mega_fwd(Args a_unused) {
    extern __shared__ __attribute__((aligned(16))) unsigned char lds_raw[];
    LAS unsigned char* lds = (LAS unsigned char*)lds_raw;
    cg::grid_group grid = cg::this_grid();
    const int tid = threadIdx.x, lane = tid & 63, wave = __builtin_amdgcn_readfirstlane(tid >> 6);
    const int G = gridDim.x, bx = blockIdx.x;
    const int vcu = (G % 8 == 0) ? (bx % 8) * (G / 8) + bx / 8 : bx;
    const int gw = vcu * NWAVES + wave, ngw = G * NWAVES;
#define ARGS() cargs_t ap = (cargs_t)__builtin_amdgcn_kernarg_segment_ptr(); asm volatile("" : "+s"(ap)); unsigned char* const ws = ap->ws
#define GSYNC() xcd_barrier(xbar)
#define WSP(T, off) ((T*)(ws + (off)))
#define XBP(ci) ((bf16_t*)(ws + ((ci) ? WS_X1 : WS_X0)))
#define SXP(ci) ((float*)(ws + ((ci) ? WS_S1 : WS_S0)))
#define TMPP ((float*)(ws + WS_PROJ + 4096))
    if (tid < 64) ((LAS unsigned*)(lds + 147200))[tid] = 0u;
    __syncthreads();
    grid.sync();
    XcdBarrier xbar;
    { ARGS(); xbar = xcd_barrier_post((unsigned*)ws, (volatile LAS unsigned*)(lds + 147200)); }
    { ARGS(); weights_prologue(ap, lds, gw, ngw, wave, lane); }

#define DUMP_BF16(buf_off, nelem) do { ARGS(); const bf16_t* B_ = WSP(bf16_t, buf_off); float* o_ = ap->out; \
    for (size_t i_ = (size_t)bx * NTHREADS + tid; i_ < (size_t)2 * MH * DM; i_ += (size_t)G * NTHREADS) o_[i_] = __uint_as_float((unsigned)B_[i_ % (size_t)(nelem)] << 16); } while (0)
    for (int hf = 0; hf < 2; ++hf) {
        { ARGS(); init_rows(ap->x + (size_t)hf * MH * DM, XBP(0), SXP(0), gw, ngw, lane); }
        GSYNC();
        int c = 0;
        for (int l = 0; l < NLAYER; ++l) {
            { ARGS(); convert_p(ap->p + ((size_t)l * 2 * MH + (size_t)hf * MH) * PLE, WSP(bf16_t, WS_PB), bx * NTHREADS + tid, G * NTHREADS); }
            int rbase;
            { ARGS(); rbase = 2048 * (bx & 7);
              LAS float* rt = (LAS float*)(lds + 131072); const float* Sx = SXP(c);
              int t_ = threadIdx.x; asm volatile("" : "+v"(t_));
#pragma unroll
              for (int i = 0; i < 4; ++i) { const int r = t_ + 512 * i; const f32x4* p = (const f32x4*)(Sx + (size_t)(rbase + r) * 16); const f32x4 q = (p[0] + p[1]) + (p[2] + p[3]);
                  rt[r] = rsqrtf(((q[0] + q[1]) + (q[2] + q[3])) * (1.0f / 1024.0f) + EPS); }
              __syncthreads(); }
#if !defined(ONLY) || ONLY == 0
            { ARGS(); const bf16_t* wl = WSP(bf16_t, WS_W) + (size_t)l * LW_TOTAL;
              pg8::Gemm g{XBP(c), wl + LW_IN, MH, NP1, DM}; pg8::StaticOrder S; S.init(MH, NP1, G, bx);
              pg8::Epi E{0, WSP(bf16_t, WS_PROJ), NP1, nullptr, 0, nullptr, 0, nullptr, SXP(c), nullptr, nullptr, nullptr, (const LAS float*)(lds + 131072), rbase};
              pg8::gemm_phase<pg8::Epi, pg8::StaticOrder, true, true>(lds, g, S, E); }
#endif
#if !defined(ONLY) || ONLY == 1
            { ARGS(); const bf16_t* wl = WSP(bf16_t, WS_W) + (size_t)l * LW_TOTAL;
              pg8::Gemm g{wl + LW_IN + (size_t)NP1 * DM, XBP(c), NV2, MH, DM}; pg8::StaticOrder S; S.init(NV2, MH, G, bx);
              pg8::Epi E{1, WSP(bf16_t, WS_VT2), MH, nullptr, 0, nullptr, 0, nullptr, SXP(c), nullptr, nullptr, nullptr, (const LAS float*)(lds + 131072), rbase};
              pg8::gemm_phase<pg8::Epi, pg8::StaticOrder, true, true>(lds, g, S, E); }
#endif
            GSYNC();
#if defined(STOP_AFTER) && STOP_AFTER == 1
            DUMP_BF16(WS_PROJ, (size_t)MH * NP1); return;
#endif
#if defined(STOP_AFTER) && STOP_AFTER == 11
            DUMP_BF16(WS_VT2, (size_t)MH * NV2); return;
#endif
#ifndef NO_GMLP
            { ARGS();
              for (int u = vcu; u < 256; u += G)
                gmlp_unit(lds, WSP(bf16_t, WS_PROJ), WSP(bf16_t, WS_VT2), WSP(bf16_t, WS_BRA), ap->a_ln_g + l * 1024, ap->a_ln_b + l * 1024, ap->a_ws + (size_t)l * 131072, ap->a_bs + l * 1024, u >> 1, u & 1); }
#endif
#ifdef NO_ATTN
            { ARGS(); const bf16_t* PR = WSP(bf16_t, WS_PROJ); bf16_t* B = WSP(bf16_t, WS_BRB);
              for (int i = bx * NTHREADS + tid; i < MH * DM / 8; i += G * NTHREADS) { const int row = i >> 7, c8 = i & 127; *(u32x4*)(B + (size_t)row * DM + c8 * 8) = *(const u32x4*)(PR + (size_t)row * NP1 + 4096 + c8 * 8); } }
#endif
#ifdef NO_GMLP
            { ARGS(); const bf16_t* PR = WSP(bf16_t, WS_PROJ); bf16_t* B = WSP(bf16_t, WS_BRA);
              for (int i = bx * NTHREADS + tid; i < MH * DM / 8; i += G * NTHREADS) { const int row = i >> 7, c8 = i & 127; *(u32x4*)(B + (size_t)row * DM + c8 * 8) = *(const u32x4*)(PR + (size_t)row * NP1 + c8 * 8); } }
#endif
#ifndef NO_ATTN
            { ARGS();
              const float lam_init = 0.8f - 0.6f * expf(-0.3f * (float)l);
              const float d0 = wave_sum(ap->lam_q[l * 128 + lane] * ap->lam_k[l * 128 + lane]), d1 = wave_sum(ap->lam_q[l * 128 + 64 + lane] * ap->lam_k[l * 128 + 64 + lane]);
              const float lam = expf(d0) - expf(d1) + lam_init;
              for (int pu = vcu; pu < 512; pu += G) { const int bh = pu >> 4, s = pu & 15;
                  attn_unit(lds, WSP(bf16_t, WS_PROJ), WSP(bf16_t, WS_VT2), WSP(bf16_t, WS_BRB), ap->subln_g + l * 128, lam, lam_init, bh >> 3, bh & 7, 31 - s);
                  attn_unit(lds, WSP(bf16_t, WS_PROJ), WSP(bf16_t, WS_VT2), WSP(bf16_t, WS_BRB), ap->subln_g + l * 128, lam, lam_init, bh >> 3, bh & 7, s); } }
#endif
            GSYNC();
#if !defined(ONLY) || ONLY == 2
            { ARGS(); const bf16_t* wl = WSP(bf16_t, WS_W) + (size_t)l * LW_TOTAL;
              pg8::Gemm g{WSP(bf16_t, WS_BRA), wl + LW_A, MH, DM, DM}; pg8::StaticOrder S; S.init(MH, DM, G, bx);
              pg8::Epi E{2, WSP(bf16_t, WS_PROJ) + 2048, NP1, nullptr, 0, nullptr, 0, WSP(bf16_t, WS_PROJ) + 5120, nullptr, nullptr, nullptr, nullptr, nullptr, 0};
              pg8::gemm_phase<pg8::Epi, pg8::StaticOrder, true, true>(lds, g, S, E); }
#endif
#if !defined(ONLY) || ONLY == 3
            { ARGS(); const bf16_t* wl = WSP(bf16_t, WS_W) + (size_t)l * LW_TOTAL;
              pg8::Gemm g{WSP(bf16_t, WS_BRB), wl + LW_B, MH, DM, DM}; pg8::StaticOrder S; S.init(MH, DM, G, bx);
              pg8::Epi E{3, XBP(1 - c), DM, nullptr, 0, nullptr, 0, WSP(bf16_t, WS_PROJ) + 6144, nullptr, nullptr, WSP(bf16_t, WS_PROJ) + 2048, nullptr, nullptr, 0};
              pg8::gemm_phase<pg8::Epi, pg8::StaticOrder, true, true>(lds, g, S, E); }
#endif
            GSYNC();
#if defined(STOP_AFTER) && STOP_AFTER == 3
            if (c == 0) DUMP_BF16(WS_X1, (size_t)MH * DM); else DUMP_BF16(WS_X0, (size_t)MH * DM); return;
#endif
#if !defined(ONLY) || ONLY == 4
            { ARGS(); const bf16_t* wl = WSP(bf16_t, WS_W) + (size_t)l * LW_TOTAL; float* out = ap->out + (size_t)hf * MH * DM;
              pg8::Gemm g{XBP(1 - c), wl + LW_O, MH, DM, DM}; pg8::StaticOrder S; S.init(MH, DM, G, bx);
              pg8::Epi E{4, XBP(c), DM, nullptr, 0, l == 0 ? ap->x + (size_t)hf * MH * DM : (const float*)nullptr, DM, nullptr, nullptr, SXP(c), nullptr, XBP(c), nullptr, 0};
              pg8::gemm_phase<pg8::Epi, pg8::StaticOrder, true, true>(lds, g, S, E); }
#endif
            GSYNC();
#if defined(STOP_AFTER) && STOP_AFTER == 4
            if (c == 0) DUMP_BF16(WS_X0, (size_t)MH * DM); else DUMP_BF16(WS_X1, (size_t)MH * DM); return;
#endif
#if !defined(ONLY) || ONLY == 5
            { ARGS(); const bf16_t* wl = WSP(bf16_t, WS_W) + (size_t)l * LW_TOTAL;
              pg8::Gemm g{XBP(c), wl + LW_G, MH, DM, DM}; pg8::StaticOrder S; S.init(MH, DM, G, bx);
              pg8::Epi E{5, WSP(bf16_t, WS_PROJ) + 2048, NP1, nullptr, 0, nullptr, 0, nullptr, SXP(c), nullptr, nullptr, nullptr, nullptr, 0};
              pg8::gemm_phase<pg8::Epi, pg8::StaticOrder, true, true>(lds, g, S, E); }
#endif
#if !defined(ONLY) || ONLY == 6
            { ARGS(); const bf16_t* wl = WSP(bf16_t, WS_W) + (size_t)l * LW_TOTAL; float* out = ap->out + (size_t)hf * MH * DM;
              pg8::Gemm g{WSP(bf16_t, WS_PB), wl + LW_P, MH, DM, PLE}; pg8::StaticOrder S; S.init(MH, DM, G, bx);
              pg8::Epi E{6, XBP(1 - c), DM, l == NLAYER - 1 ? out : (float*)nullptr, DM, nullptr, 0, nullptr, nullptr, SXP(1 - c), WSP(bf16_t, WS_PROJ) + 2048, XBP(c), nullptr, 0};
              pg8::gemm_phase<pg8::Epi, pg8::StaticOrder, true, true>(lds, g, S, E); }
#endif
            GSYNC();
#if defined(STOP_AFTER) && STOP_AFTER == 5
            if (c == 0) DUMP_BF16(WS_X1, (size_t)MH * DM); else DUMP_BF16(WS_X0, (size_t)MH * DM); return;
#endif
            c ^= 1;
        }
        { ARGS(); final_rows(ap->out + (size_t)hf * MH * DM, ap->final_g, gw, ngw, lane); }
    }
}

extern "C" void kernel_launch(void* const* d_in, const int* in_sizes, int n_in, void* d_out, int out_size, void* d_ws, size_t ws_size, hipStream_t stream) {
    static int grid = 0;
    if (grid == 0) {
        if (n_in != 18 || ws_size < WS_END) { fprintf(stderr, "kernel_launch: unexpected n_in %d / ws_size %zu (need %zu)\n", n_in, ws_size, (size_t)WS_END); grid = -1; return; }
        int dev = 0, cus = 0, per_cu = 0;
        hipGetDevice(&dev); hipDeviceGetAttribute(&cus, hipDeviceAttributeMultiprocessorCount, dev);
        if (hipFuncSetAttribute((const void*)mega_fwd, hipFuncAttributeMaxDynamicSharedMemorySize, LDS_BYTES) != hipSuccess) { fprintf(stderr, "kernel_launch: hipFuncSetAttribute failed\n"); grid = -1; return; }
        if (hipOccupancyMaxActiveBlocksPerMultiprocessor(&per_cu, (const void*)mega_fwd, NTHREADS, LDS_BYTES) != hipSuccess || per_cu < 1) { fprintf(stderr, "kernel_launch: occupancy query gives %d\n", per_cu); per_cu = 1; }
        (void)hipGetLastError();
        if (cus % 8 != 0) { fprintf(stderr, "kernel_launch: CU count %d is not a multiple of 8\n", cus); grid = -1; return; }
        grid = cus;
    }
    if (grid < 0) return;
    if (hipMemsetAsync(d_ws, 0, 16384, stream) != hipSuccess) { fprintf(stderr, "kernel_launch: memset failed\n"); return; }
    Args a{};
    const float** f = (const float**)&a;
    for (int i = 0; i < 18; ++i) f[i] = (const float*)d_in[i];
    a.out = (float*)d_out; a.ws = (unsigned char*)d_ws;
    void* args[] = {&a};
    hipError_t e = hipLaunchCooperativeKernel((const void*)mega_fwd, dim3(grid), dim3(NTHREADS), args, LDS_BYTES, stream);
    if (e != hipSuccess) fprintf(stderr, "cooperative launch failed: %s (grid %d)\n", hipGetErrorString(e), grid);
}
```

```cpp
#include <hip/hip_runtime.h>
#include <hip/hip_cooperative_groups.h>
#include <cstdio>
#include <cstdint>
namespace cg = cooperative_groups;
template <int M> __device__ __forceinline__ float xor_lt32(float v) { return __builtin_bit_cast(float, __builtin_amdgcn_ds_swizzle(__builtin_bit_cast(int, v), (M << 10) | 0x1F)); }
__device__ __forceinline__ float xor32_add(float v) { const unsigned b = __builtin_bit_cast(unsigned, v); auto rr = __builtin_amdgcn_permlane32_swap(b, b, false, false); return __builtin_bit_cast(float, (unsigned)rr[0]) + __builtin_bit_cast(float, (unsigned)rr[1]); }
__device__ __forceinline__ float xor32_max(float v) { const unsigned b = __builtin_bit_cast(unsigned, v); auto rr = __builtin_amdgcn_permlane32_swap(b, b, false, false); return fmaxf(__builtin_bit_cast(float, (unsigned)rr[0]), __builtin_bit_cast(float, (unsigned)rr[1])); }
__device__ __forceinline__ int lane_id_() { int l_; asm volatile("v_mbcnt_lo_u32_b32 %0, -1, 0\n\tv_mbcnt_hi_u32_b32 %0, -1, %0" : "=&v"(l_)); return l_; }
namespace pg8 {
#define PG8_LAS __attribute__((address_space(3)))
typedef unsigned short bf16_t;
typedef short bf16x8 __attribute__((ext_vector_type(8)));
typedef float f32x4 __attribute__((ext_vector_type(4)));
typedef unsigned u32x4 __attribute__((ext_vector_type(4)));
constexpr int BM = 256, BK = 64, HALF = 128, HTB = HALF * BK * 2  , STAGE_BYTES = 8 * HTB, NXCD = 8, WGM = 8;

__host__ __device__ __forceinline__ int lds_byte(int r, int c) { const int st = (r >> 4) * 2 + (c >> 5), rr = r & 15, cc = c & 31, ob = rr * 64 + cc * 2; return st * 1024 + (ob ^ (((ob >> 9) & 1) << 5)); }
__host__ __device__ __forceinline__ void stage_rc(int b, int& R, int& C) { const int st = b / 1024, sb = b % 1024, swz = sb ^ (((sb >> 9) & 1) << 5); R = (st >> 1) * 16 + swz / 64; C = (st & 1) * 32 + (swz % 64) / 2; }
__host__ __device__ __forceinline__ int perm32(int rho) { const int n = rho >> 4, i = rho & 15; return 8 * (i >> 2) + 4 * n + (i & 3); }

struct Unit { int pm, pn; };
struct Gemm { const bf16_t* A; const bf16_t* Bt; int M, N, K; };

struct StaticOrder {
    int nM, nN, nwg, G, c;
    __host__ __device__ void init(int M, int N, int G_, int c_) { nM = M / BM; nN = N / BM; nwg = nM * nN; G = G_; c = c_; }
    __host__ __device__ bool next(int i, Unit& u) const {
        const long L = (long)i * G + c; if (L >= nwg) return false;
        int wgid = (int)L; { const int q = nwg / NXCD, r = nwg % NXCD, xcd = wgid % NXCD, off = wgid / NXCD; wgid = (xcd < r ? xcd * (q + 1) : r * (q + 1) + (xcd - r) * q) + off; }
        const int nig = WGM * nN, gid = wgid / nig, fm = gid * WGM, gsz = (nM - fm) < WGM ? (nM - fm) : WGM;
        u.pm = fm + ((wgid % nig) % gsz); u.pn = (wgid % nig) / gsz; return true;
    }
    __device__ __forceinline__ void a_ready(const Unit&) const {}
    __device__ __forceinline__ void done(const Unit&) const {}
};

__device__ __forceinline__ unsigned cvt_pk_bf16(float lo, float hi) { unsigned r; asm volatile("v_cvt_pk_bf16_f32 %0, %1, %2" : "=v"(r) : "v"(lo), "v"(hi)); return r; }
typedef float f32x2 __attribute__((ext_vector_type(2)));
__device__ __forceinline__ f32x2 gelu_pk(f32x2 v) {
    const f32x2 av = __builtin_elementwise_abs(v), d = av * 0.2316418882f + 1.0f;
    f32x2 t; t.x = __builtin_amdgcn_rcpf(d.x); t.y = __builtin_amdgcn_rcpf(d.y);
    f32x2 q = t * 0.5307027145f + (-0.7265760135f); q = q * t + 0.7107068705f; q = q * t + (-0.142248368f); q = q * t + 0.127414796f; q = q * t;
    const f32x2 s = (v * v) * (-0.72134752044f);
    f32x2 e; e.x = __builtin_amdgcn_exp2f(s.x); e.y = __builtin_amdgcn_exp2f(s.y);
    const f32x2 m = v * (q * e), r = v - m;
    f32x2 o; o.x = v.x < 0.f ? m.x : r.x; o.y = v.y < 0.f ? m.y : r.y; return o;
}

typedef float f32x2_t __attribute__((ext_vector_type(2))); typedef __bf16 bf16x2_t __attribute__((ext_vector_type(2)));
__device__ __forceinline__ unsigned cvtpk(float lo, float hi) { f32x2_t v = {lo, hi}; bf16x2_t b = __builtin_convertvector(v, bf16x2_t); return __builtin_bit_cast(unsigned, b); }
__device__ __forceinline__ u32x4 pack8(f32x4 a, f32x4 b) { u32x4 w; w.x = cvtpk(a[0], a[1]); w.y = cvtpk(a[2], a[3]); w.z = cvtpk(b[0], b[1]); w.w = cvtpk(b[2], b[3]); return w; }
__device__ __forceinline__ void unpack8(u32x4 w, f32x4& a, f32x4& b) {
    a[0] = __uint_as_float(w.x << 16); a[1] = __uint_as_float(w.x & 0xffff0000u); a[2] = __uint_as_float(w.y << 16); a[3] = __uint_as_float(w.y & 0xffff0000u);
    b[0] = __uint_as_float(w.z << 16); b[1] = __uint_as_float(w.z & 0xffff0000u); b[2] = __uint_as_float(w.w << 16); b[3] = __uint_as_float(w.w & 0xffff0000u); }
__device__ __forceinline__ float sigm(float x) { return __builtin_amdgcn_rcpf(1.0f + __builtin_amdgcn_exp2f(-1.4426950408889634f * x)); }
__device__ __forceinline__ f32x4 sigm4(f32x4 v) { f32x4 o; o[0] = sigm(v[0]); o[1] = sigm(v[1]); o[2] = sigm(v[2]); o[3] = sigm(v[3]); return o; }
__device__ __forceinline__ f32x4 gelu4(f32x4 v) { f32x2 a = gelu_pk((f32x2){v[0], v[1]}), b = gelu_pk((f32x2){v[2], v[3]}); return (f32x4){a.x, a.y, b.x, b.y}; }
__device__ __forceinline__ float row_rstd(const float* S, int row) {
    const f32x4* p = (const f32x4*)(S + (size_t)row * 16); const f32x4 s = (p[0] + p[1]) + (p[2] + p[3]);
    return rsqrtf(((s[0] + s[1]) + (s[2] + s[3])) * (1.0f / 1024.0f) + 1e-6f); }
constexpr float QSCALE = 0.125f * 1.4426950408889634f;
struct Epi {
    static constexpr bool PERM = true, AFTER_DRAIN = false;
    int mode; bf16_t* Ob; int ldo; float* Of; int ldf; const float* Fin; int ldi; const bf16_t* G; const float* S; float* Sn; const bf16_t* T16; const bf16_t* Xin; const PG8_LAS float* rtab; int rbase;
    __device__ __forceinline__ void operator()(const f32x4 (&acc)[2][2][4][2], const Unit& u, int wr, int wc, int fr, int fq) const {
        const int row0 = u.pm * BM + wr * 64 + fr, col0 = u.pn * BM + wc * 32 + 8 * fq;
        if (mode == 1) {
            const int sec = u.pm >> 2; f32x4 rc[2][2];
#pragma unroll
            for (int bj = 0; bj < 2; ++bj)
#pragma unroll
                for (int n = 0; n < 2; ++n) rc[bj][n] = *(const PG8_LAS f32x4*)(rtab + (col0 + bj * HALF + 4 * n - rbase));
#pragma unroll
            for (int ai = 0; ai < 2; ++ai)
#pragma unroll
                for (int m = 0; m < 4; ++m) { const int row = row0 + ai * HALF + m * 16;
#pragma unroll
                    for (int bj = 0; bj < 2; ++bj) { f32x4 v0 = acc[ai][bj][m][0] * rc[bj][0], v1 = acc[ai][bj][m][1] * rc[bj][1];
                        if (sec == 0) { v0 = gelu4(v0); v1 = gelu4(v1); }
                        *(u32x4*)(Ob + (size_t)row * ldo + col0 + bj * HALF) = pack8(v0, v1); }
                    if (m & 1) asm volatile("" ::: "memory"); }
            return;
        }
        const int sec = u.pn >> 2;
        if (mode == 0 || mode == 5) {
#pragma unroll
            for (int ai = 0; ai < 2; ++ai) {
                float rsr[4];
#pragma unroll
                for (int m = 0; m < 4; ++m) {
                    if (mode == 0) { rsr[m] = rtab[row0 + ai * HALF + m * 16 - rbase]; }
                    else { const f32x4 p = ((const f32x4*)(S + (size_t)(row0 + ai * HALF + m * 16) * 16))[fq]; float s_ = (p[0] + p[1]) + (p[2] + p[3]);
                        s_ += __shfl_xor(s_, 16); s_ += __shfl_xor(s_, 32); rsr[m] = rsqrtf(s_ * (1.0f / 1024.0f) + 1e-6f); } }
#pragma unroll
                for (int m = 0; m < 4; ++m) { const int row = row0 + ai * HALF + m * 16; const float rs = rsr[m];
#pragma unroll
                    for (int bj = 0; bj < 2; ++bj) { const int col = col0 + bj * HALF; f32x4 v0 = acc[ai][bj][m][0] * rs, v1 = acc[ai][bj][m][1] * rs;
                        if (mode == 0) {
                            if (sec == 0) { v0 = gelu4(v0); v1 = gelu4(v1); }
                            else if (sec == 1 || sec == 4) { v0 = v0 * sigm4(v0); v1 = v1 * sigm4(v1); }
                            else if (sec == 2) { v0 = v0 * QSCALE; v1 = v1 * QSCALE; }
                            else if (sec >= 5) { v0 = sigm4(v0); v1 = sigm4(v1); }
                            *(u32x4*)(Ob + (size_t)row * ldo + col) = pack8(v0, v1);
                        } else { *(u32x4*)(Ob + (size_t)row * ldo + col) = pack8(sigm4(v0), sigm4(v1)); } }
                    asm volatile("" ::: "memory"); }
            }
            return;
        }
#pragma unroll
        for (int ai = 0; ai < 2; ++ai)
#pragma unroll
            for (int mh = 0; mh < 2; ++mh) {
                u32x4 gq[2][2], tq[2][2], xq[2][2]; f32x4 ta[2][2][2];
#pragma unroll
                for (int mm = 0; mm < 2; ++mm)
#pragma unroll
                    for (int bj = 0; bj < 2; ++bj) { const int row = row0 + ai * HALF + (2 * mh + mm) * 16, col = col0 + bj * HALF;
                        if (mode == 2 || mode == 3) gq[mm][bj] = *(const u32x4*)(G + (size_t)row * 7168 + col);
                        if (mode == 4 && Fin) { const float* t = Fin + (size_t)row * ldi + col; ta[mm][bj][0] = *(const f32x4*)t; ta[mm][bj][1] = *(const f32x4*)(t + 4); }
                        if ((mode == 4 && !Fin) || mode == 6) xq[mm][bj] = *(const u32x4*)(Xin + (size_t)row * 1024 + col);
                        if (mode == 3 || mode == 6) tq[mm][bj] = *(const u32x4*)(T16 + (size_t)row * 7168 + col);
                    }
#pragma unroll
                for (int mm = 0; mm < 2; ++mm) { const int m = 2 * mh + mm; const int row = row0 + ai * HALF + m * 16; float ss = 0.f;
#pragma unroll
                    for (int bj = 0; bj < 2; ++bj) { const int col = col0 + bj * HALF; f32x4 v0 = acc[ai][bj][m][0], v1 = acc[ai][bj][m][1];
                        if (mode == 2) { f32x4 g0, g1; unpack8(gq[mm][bj], g0, g1); *(u32x4*)(Ob + (size_t)row * ldo + col) = pack8(v0 * g0, v1 * g1); }
                        else if (mode == 3) { f32x4 g0, g1, t0, t1; unpack8(gq[mm][bj], g0, g1); unpack8(tq[mm][bj], t0, t1); v0 = t0 + v0 * g0; v1 = t1 + v1 * g1; *(u32x4*)(Ob + (size_t)row * ldo + col) = pack8(v0, v1); }
                        else { if (mode == 4) { if (Fin) { v0 = ta[mm][bj][0] + v0; v1 = ta[mm][bj][1] + v1; } else { f32x4 x0, x1; unpack8(xq[mm][bj], x0, x1); v0 = x0 + v0; v1 = x1 + v1; } }
                            else { f32x4 t0, t1, x0, x1; unpack8(tq[mm][bj], t0, t1); unpack8(xq[mm][bj], x0, x1); v0 = x0 + v0 * t0; v1 = x1 + v1 * t1; }
                            if (Of) { float* o = Of + (size_t)row * ldf + col; *(f32x4*)o = v0; *(f32x4*)(o + 4) = v1; }
                            *(u32x4*)(Ob + (size_t)row * ldo + col) = pack8(v0, v1);
                            ss += (v0[0] * v0[0] + v0[1] * v0[1]) + (v0[2] * v0[2] + v0[3] * v0[3]) + (v1[0] * v1[0] + v1[1] * v1[1]) + (v1[2] * v1[2] + v1[3] * v1[3]); } }
                    if (mode == 4 || mode == 6) { ss += __shfl_xor(ss, 16); ss += __shfl_xor(ss, 32); if (fq == 0) Sn[(size_t)row * 16 + u.pn * 4 + wc] = ss; } }
                asm volatile("" ::: "memory");
            }
    }
};
template <class Epi, class Sched, bool ALIGN_EPI = false, bool SP2 = false>
__device__ __forceinline__ void gemm_phase(PG8_LAS unsigned char* lds, const Gemm g, const Sched& S, const Epi& E) {
    int tid_ = threadIdx.x; asm volatile("" : "+v"(tid_)); const int tid = tid_, wid = __builtin_amdgcn_readfirstlane(tid >> 6), lane = tid & 63, wr = wid >> 2, wc = wid & 3, fr = lane & 15, fq = lane >> 4;
    int K_ = g.K; asm volatile("" : "+s"(K_)); const int K = K_, nt = K / BK;
    unsigned voffA[2], voffB[2];
#pragma unroll
    for (int i = 0; i < 2; ++i) { int R, C; stage_rc(tid * 16 + i * 8192, R, C); const int Rb = Epi::PERM ? ((R & ~31) + perm32(R & 31)) : R;
        voffA[i] = (unsigned)(R * K + C) * 2u; voffB[i] = (unsigned)(Rb * K + C) * 2u; }
    const size_t kstep = (size_t)(BK * 2);
    const size_t hstep = (size_t)HALF * K * 2;
    const size_t tstep = 2 * hstep;
    const unsigned ldsw = (unsigned)wid * 1024u;
    const int aoff = lds_byte(wr * 64 + fr, fq * 8), boff = lds_byte(wc * 32 + fr, fq * 8);
#define PG8_SA(b, h) (((b) * 2 + (h)) * HTB)
#define PG8_SB(b, h) ((4 + (b) * 2 + (h)) * HTB)
#define PG8_STAGE(bufoff, gbase, voff) do { _Pragma("unroll") for (int _i = 0; _i < 2; ++_i) \
        __builtin_amdgcn_global_load_lds((const unsigned*)((const char*)(gbase) + (voff)[_i]), (PG8_LAS unsigned*)(lds + (bufoff) + ldsw + _i * 8192), 16, 0, 0); } while (0)
#define PG8_LDA(dst, b, h) do { _Pragma("unroll") for (int m = 0; m < 4; ++m) _Pragma("unroll") for (int k = 0; k < 2; ++k) dst[m][k] = *(const PG8_LAS bf16x8*)(lds + PG8_SA(b, h) + aoff + m * 2048 + k * 1024); } while (0)
#define PG8_LDB(dst, b, h) do { _Pragma("unroll") for (int n = 0; n < 2; ++n) _Pragma("unroll") for (int k = 0; k < 2; ++k) dst[n][k] = *(const PG8_LAS bf16x8*)(lds + PG8_SB(b, h) + boff + n * 2048 + k * 1024); } while (0)
#define PG8_MMA(ai, bj, At, Bt) do { __builtin_amdgcn_s_setprio(1); _Pragma("unroll") for (int m = 0; m < 4; ++m) _Pragma("unroll") for (int n = 0; n < 2; ++n) _Pragma("unroll") for (int k = 0; k < 2; ++k) \
        acc[ai][bj][m][n] = __builtin_amdgcn_mfma_f32_16x16x32_bf16(Bt[n][k], At[m][k], acc[ai][bj][m][n], 0, 0, 0); __builtin_amdgcn_s_setprio(0); } while (0)
#define PG8_WAIT_V(n) asm volatile("s_waitcnt vmcnt(" #n ")" ::: "memory")
#define PG8_WAIT_L(n) asm volatile("s_waitcnt lgkmcnt(" #n ")" ::: "memory")
#define PG8_BAR __builtin_amdgcn_s_barrier()
#define PG8_SCHED __builtin_amdgcn_sched_barrier(0)
    Unit cur, nxt; int ui = 0;
    if (!S.next(0, cur)) return;
    f32x4 acc[2][2][4][2];
#pragma unroll
    for (int a = 0; a < 2; ++a)
#pragma unroll
        for (int b = 0; b < 2; ++b)
#pragma unroll
            for (int m = 0; m < 4; ++m)
#pragma unroll
                for (int n = 0; n < 2; ++n) acc[a][b][m][n] = (f32x4){0.f, 0.f, 0.f, 0.f};
    bf16x8 At[4][2], B0[2][2], B1[2][2];
    const char* cA = (const char*)g.A + (size_t)cur.pm * tstep; const char* cB = (const char*)g.Bt + (size_t)cur.pn * tstep;
    S.a_ready(cur);
    if constexpr (SP2) {
        PG8_STAGE(PG8_SB(0, 0), cB, voffB); PG8_STAGE(PG8_SB(0, 1), cB + hstep, voffB); PG8_STAGE(PG8_SA(0, 0), cA, voffA); PG8_STAGE(PG8_SA(0, 1), cA + hstep, voffA);
        if (wr == 1) PG8_BAR;
        PG8_WAIT_V(2); PG8_BAR;
        PG8_STAGE(PG8_SB(1, 0), cB + kstep, voffB); PG8_STAGE(PG8_SA(1, 0), cA + kstep, voffA); PG8_STAGE(PG8_SB(1, 1), cB + hstep + kstep, voffB);
        PG8_WAIT_V(6); PG8_BAR;
    } else {
        PG8_STAGE(PG8_SB(0, 0), cB, voffB); PG8_STAGE(PG8_SA(0, 0), cA, voffA); PG8_STAGE(PG8_SB(0, 1), cB + hstep, voffB); PG8_STAGE(PG8_SA(0, 1), cA + hstep, voffA);
        if (wr == 1) PG8_BAR;
        PG8_WAIT_V(4); PG8_BAR;
        PG8_STAGE(PG8_SB(1, 0), cB + kstep, voffB); PG8_STAGE(PG8_SA(1, 0), cA + kstep, voffA); PG8_STAGE(PG8_SB(1, 1), cB + hstep + kstep, voffB);
        PG8_WAIT_V(6); PG8_BAR;
    }
    for (;;) {
        const bool has_next = S.next(ui + 1, nxt);
        const char* nA = has_next ? (const char*)g.A + (size_t)nxt.pm * tstep : cA; const char* nB = has_next ? (const char*)g.Bt + (size_t)nxt.pn * tstep : cB;
        for (int t = 0; t < nt; t += 2) {
            const bool last = (t == nt - 2);
            const char* a1 = cA + (size_t)(t + 1) * kstep;
            const char* a2 = last ? nA : cA + (size_t)(t + 2) * kstep; const char* b2 = last ? nB : cB + (size_t)(t + 2) * kstep;
            const char* a3 = a2 + kstep; const char* b3 = b2 + kstep;
            if (last && has_next) S.a_ready(nxt);
            if constexpr (SP2) {
            PG8_LDB(B0, 0, 0); PG8_LDB(B1, 0, 1); PG8_SCHED; PG8_LDA(At, 0, 0); PG8_STAGE(PG8_SA(1, 1), a1 + hstep, voffA);
            PG8_WAIT_V(8); PG8_WAIT_L(0); PG8_BAR; PG8_MMA(0, 0, At, B0); PG8_MMA(0, 1, At, B1); PG8_BAR; PG8_SCHED;
            PG8_LDA(At, 0, 1); PG8_STAGE(PG8_SB(0, 0), b2, voffB); PG8_STAGE(PG8_SB(0, 1), b2 + hstep, voffB); PG8_STAGE(PG8_SA(0, 0), a2, voffA);
            PG8_WAIT_V(8); PG8_WAIT_L(0); PG8_BAR; PG8_MMA(1, 0, At, B0); PG8_MMA(1, 1, At, B1); PG8_BAR; PG8_SCHED;
            PG8_LDB(B0, 1, 0); PG8_LDB(B1, 1, 1); PG8_SCHED; PG8_LDA(At, 1, 0); PG8_STAGE(PG8_SA(0, 1), a2 + hstep, voffA);
            PG8_WAIT_V(8); PG8_WAIT_L(0); PG8_BAR; PG8_MMA(0, 0, At, B0); PG8_MMA(0, 1, At, B1); PG8_BAR; PG8_SCHED;
            PG8_LDA(At, 1, 1); PG8_STAGE(PG8_SB(1, 0), b3, voffB); PG8_STAGE(PG8_SB(1, 1), b3 + hstep, voffB); PG8_STAGE(PG8_SA(1, 0), a3, voffA);
            PG8_WAIT_V(8); PG8_WAIT_L(0); PG8_BAR; PG8_MMA(1, 0, At, B0); PG8_MMA(1, 1, At, B1); PG8_BAR; PG8_SCHED;
            } else {
            PG8_LDB(B0, 0, 0); PG8_SCHED; PG8_LDA(At, 0, 0); PG8_STAGE(PG8_SA(1, 1), a1 + hstep, voffA);
            PG8_WAIT_L(8); PG8_BAR; PG8_WAIT_L(0); PG8_MMA(0, 0, At, B0); PG8_BAR; PG8_SCHED;
            PG8_LDB(B1, 0, 1); PG8_STAGE(PG8_SB(0, 0), b2, voffB);
            PG8_BAR; PG8_WAIT_L(0); PG8_MMA(0, 1, At, B1); PG8_BAR;
            PG8_LDA(At, 0, 1); PG8_STAGE(PG8_SA(0, 0), a2, voffA);
            PG8_BAR; PG8_WAIT_L(0); PG8_MMA(1, 0, At, B0); PG8_BAR; PG8_SCHED;
            PG8_STAGE(PG8_SB(0, 1), b2 + hstep, voffB);
            PG8_WAIT_V(6); PG8_BAR; PG8_MMA(1, 1, At, B1); PG8_BAR;
            PG8_LDB(B0, 1, 0); PG8_SCHED; PG8_LDA(At, 1, 0); PG8_STAGE(PG8_SA(0, 1), a2 + hstep, voffA);
            PG8_WAIT_L(8); PG8_BAR; PG8_WAIT_L(0); PG8_MMA(0, 0, At, B0); PG8_BAR; PG8_SCHED;
            PG8_LDB(B1, 1, 1); PG8_STAGE(PG8_SB(1, 0), b3, voffB);
            PG8_BAR; PG8_WAIT_L(0); PG8_MMA(0, 1, At, B1); PG8_BAR;
            PG8_LDA(At, 1, 1); PG8_STAGE(PG8_SA(1, 0), a3, voffA);
            PG8_BAR; PG8_WAIT_L(0); PG8_MMA(1, 0, At, B0); PG8_BAR; PG8_SCHED;
            PG8_STAGE(PG8_SB(1, 1), b3 + hstep, voffB);
            PG8_WAIT_V(6); PG8_BAR; PG8_MMA(1, 1, At, B1); PG8_BAR;
            }
        }
        if constexpr (ALIGN_EPI) { if (wr == 0) PG8_BAR; }
        if constexpr (!Epi::AFTER_DRAIN) { E(acc, cur, wr, wc, fr, fq); S.done(cur); }
        if (!has_next) break;
#pragma unroll
        for (int a = 0; a < 2; ++a)
#pragma unroll
            for (int b = 0; b < 2; ++b)
#pragma unroll
                for (int m = 0; m < 4; ++m)
#pragma unroll
                    for (int n = 0; n < 2; ++n) acc[a][b][m][n] = (f32x4){0.f, 0.f, 0.f, 0.f};
        cur = nxt; cA = nA; cB = nB; ++ui;
        if constexpr (ALIGN_EPI) { if (wr == 1) PG8_BAR; }
    }
    PG8_WAIT_V(0);
    if constexpr (!ALIGN_EPI) { if (wr == 0) PG8_BAR; }
    PG8_BAR;
    if constexpr (Epi::AFTER_DRAIN) { E.fused(acc, cur, wr, wc, fr, fq, lds, wid, lane); S.done(cur); }
#undef PG8_SA
#undef PG8_SB
#undef PG8_STAGE
#undef PG8_LDA
#undef PG8_LDB
#undef PG8_MMA
#undef PG8_WAIT_V
#undef PG8_WAIT_L
#undef PG8_BAR
#undef PG8_SCHED
}
}

#define LAS __attribute__((address_space(3)))
typedef unsigned short bf16_t;
typedef short bf16x8 __attribute__((ext_vector_type(8)));
typedef float f32x4 __attribute__((ext_vector_type(4)));
typedef float f32x16 __attribute__((ext_vector_type(16)));
typedef unsigned u32x4 __attribute__((ext_vector_type(4)));
typedef unsigned u32x2 __attribute__((ext_vector_type(2)));
using pg8::cvtpk; using pg8::pack8; using pg8::unpack8;
constexpr int NTHREADS = 512, NWAVES = 8;
constexpr int MH = 16384, DM = 1024, SEQ = 4096, NB_H = 4, NLAYER = 4, NP1 = 7168, NV2 = 2048, PLE = 256, NHEAD = 8;
constexpr size_t MiB = 1u << 20;
constexpr size_t LW_IN = 0, LW_A = (size_t)9216 * 1024, LW_B = LW_A + 1048576, LW_O = LW_B + 1048576, LW_G = LW_O + 1048576, LW_P = LW_G + 1048576, LW_TOTAL = LW_P + 262144;
constexpr size_t WS_W = 1 * MiB, WS_PROJ = 108 * MiB, WS_VT2 = 332 * MiB, WS_X0 = 396 * MiB, WS_X1 = 428 * MiB, WS_BRA = 460 * MiB, WS_BRB = 492 * MiB, WS_PB = 524 * MiB, WS_S0 = 532 * MiB, WS_S1 = 533 * MiB, WS_END = 534 * MiB;
static_assert(WS_W + LW_TOTAL * 2 * NLAYER <= WS_PROJ, "weights fit");
constexpr int TMP_LD = NP1 / 2;
constexpr int LDS_BYTES = 147456;
constexpr float EPS = 1e-6f;

struct Args {
    const float *x, *p, *norm_g, *w_in, *a_ln_g, *a_ln_b, *a_ws, *a_bs, *lam_q, *lam_k, *subln_g, *w_a_out, *w_b_out, *w_o, *ple_norm_g, *w_ple, *w_ple_gate, *final_g;
    float* out; unsigned char* ws;
};

__device__ __forceinline__ float wave_sum(float v) {
#pragma unroll
    for (int o = 1; o < 64; o <<= 1) v += __shfl_xor(v, o);
    return v;
}
#define LDS_WAIT() asm volatile("s_waitcnt lgkmcnt(0)" ::: "memory")

__device__ __forceinline__ void tr_item(const float* W, int K, int N, const float* scale, bf16_t* WT, int dst_row0, LAS float* scr, int k0, int n0, int lane) {
    f32x4 v[8];
#pragma unroll
    for (int i = 0; i < 8; ++i) v[i] = *(const f32x4*)(W + (size_t)(k0 + 4 * i + (lane >> 4)) * N + n0 + (lane & 15) * 4);
#pragma unroll
    for (int i = 0; i < 8; ++i) { const int kk = 4 * i + (lane >> 4); f32x4 x = v[i]; if (scale) x = x * scale[k0 + kk]; *(LAS f32x4*)(scr + kk * 68 + (lane & 15) * 4) = x; }
    LDS_WAIT(); asm volatile("" ::: "memory");
    bf16_t* o = WT + (size_t)(dst_row0 + lane) * K + k0;
#pragma unroll
    for (int j = 0; j < 4; ++j) { const LAS float* s = scr + (8 * j) * 68 + lane;
        u32x4 w; w.x = cvtpk(s[0 * 68], s[1 * 68]); w.y = cvtpk(s[2 * 68], s[3 * 68]); w.z = cvtpk(s[4 * 68], s[5 * 68]); w.w = cvtpk(s[6 * 68], s[7 * 68]);
        *(u32x4*)(o + 8 * j) = w; }
    LDS_WAIT(); asm volatile("" ::: "memory");
}
typedef const __attribute__((address_space(4))) Args* cargs_t;
__device__ __forceinline__ void weights_prologue(cargs_t ap, LAS unsigned char* lds, int gw, int ngw, int wave, int lane) {
    LAS float* scr = (LAS float*)(lds + wave * 16384);
    bf16_t* WT = (bf16_t*)(ap->ws + WS_W);
    constexpr int I_IN = 32 * 144, I_SQ = 32 * 16, I_P = 8 * 16, I_L = I_IN + 4 * I_SQ + I_P;
    for (int it = gw; it < I_L * NLAYER; it += ngw) {
        const int l = it / I_L; int r = it % I_L; bf16_t* wl = WT + (size_t)l * LW_TOTAL;
        if (r < I_IN) { const int kb = r / 144, nb = r % 144, n0 = nb * 64; const int osec = n0 >> 10;
            const int nsec = (int)((0x654832170ull >> (4 * osec)) & 0xFull);
            tr_item(ap->w_in + (size_t)l * 1024 * 9216, 1024, 9216, ap->norm_g + l * 1024, wl + LW_IN, nsec * 1024 + (n0 & 1023), scr, kb * 32, n0, lane);
            continue; }
        r -= I_IN;
        if (r < 4 * I_SQ) { const int which = r / I_SQ; const int rr = r % I_SQ; const int kb = rr / 16, nb = rr % 16;
            const float* src = which == 0 ? ap->w_a_out : which == 1 ? ap->w_b_out : which == 2 ? ap->w_o : ap->w_ple_gate;
            const size_t off = which == 0 ? LW_A : which == 1 ? LW_B : which == 2 ? LW_O : LW_G;
            tr_item(src + (size_t)l * 1048576, 1024, 1024, which == 3 ? ap->ple_norm_g + l * 1024 : nullptr, wl + off, nb * 64, scr, kb * 32, nb * 64, lane);
            continue; }
        r -= 4 * I_SQ;
        { const int kb = r / 16, nb = r % 16; tr_item(ap->w_ple + (size_t)l * 262144, 256, 1024, nullptr, wl + LW_P, nb * 64, scr, kb * 32, nb * 64, lane); }
    }
}

__device__ __forceinline__ void init_rows(const float* x, bf16_t* XB, float* S, int gw, int ngw, int lane) {
    asm volatile("" : "+v"(lane)); asm volatile("" : "+s"(gw));
    for (int m = gw; m < MH; m += ngw) {
        const f32x4* xr = (const f32x4*)(x + (size_t)m * DM) + lane; float s = 0.f; f32x4 v[4];
#pragma unroll
        for (int j = 0; j < 4; ++j) { v[j] = xr[64 * j]; s += (v[j][0] * v[j][0] + v[j][1] * v[j][1]) + (v[j][2] * v[j][2] + v[j][3] * v[j][3]); }
        s = wave_sum(s);
        u32x2* o = (u32x2*)(XB + (size_t)m * DM) + lane;
#pragma unroll
        for (int j = 0; j < 4; ++j) { u32x2 w; w.x = cvtpk(v[j][0], v[j][1]); w.y = cvtpk(v[j][2], v[j][3]); o[64 * j] = w; }
        if (lane < 16) S[(size_t)m * 16 + lane] = lane == 0 ? s : 0.f;
    }
}
__device__ __forceinline__ void final_rows(float* out, const float* g, int gw, int ngw, int lane) {
    asm volatile("" : "+v"(lane)); asm volatile("" : "+s"(gw));
    for (int m = gw; m < MH; m += ngw) {
        f32x4* xr = (f32x4*)(out + (size_t)m * DM) + lane; float s = 0.f; f32x4 v[4];
#pragma unroll
        for (int j = 0; j < 4; ++j) { v[j] = xr[64 * j]; s += (v[j][0] * v[j][0] + v[j][1] * v[j][1]) + (v[j][2] * v[j][2] + v[j][3] * v[j][3]); }
        const float rs = rsqrtf(wave_sum(s) * (1.0f / DM) + EPS);
#pragma unroll
        for (int j = 0; j < 4; ++j) { const f32x4 gg = ((const f32x4*)g)[64 * j + lane]; xr[64 * j] = v[j] * rs * gg; }
    }
}
__device__ __forceinline__ void convert_p(const float* p, bf16_t* PB, int gtid, int nthr) {
    asm volatile("" : "+v"(gtid));
    for (int i = gtid; i < MH * PLE / 8; i += nthr) { const f32x4 a = ((const f32x4*)p)[2 * i], b = ((const f32x4*)p)[2 * i + 1]; ((u32x4*)PB)[i] = pack8(a, b); }
}

__device__ __forceinline__ void gmlp_unit(LAS unsigned char* lds, const bf16_t* PROJ, const bf16_t* VT2, bf16_t* BRA, const float* lng, const float* lnb, const float* ws, const float* bs, int c, int gh) {
    int tid_ = threadIdx.x; asm volatile("" : "+v"(tid_)); const int tid = tid_, lane = tid & 63, l32 = lane & 31, hi = lane >> 5; const int w = __builtin_amdgcn_readfirstlane(tid >> 6);
    const int tok0 = c * 128;
    LAS float* red = (LAS float*)lds;
    LAS float* stat = (LAS float*)(lds + 32768);
    LAS unsigned char* T = lds + 34816;
    LAS float* LG = (LAS float*)(lds + 139264); LAS float* LB = LG + 512;
    LG[tid] = lng[gh * 512 + tid]; LB[tid] = lnb[gh * 512 + tid];
    { const int sc = tid & 15, rg = tid >> 4; float s[8], q[8];
#pragma unroll
      for (int j = 0; j < 8; ++j) { s[j] = 0.f; q[j] = 0.f; }
      for (int i = 0; i < 32; ++i) { const u32x4 wv = *(const u32x4*)(VT2 + (size_t)(rg + 32 * i) * MH + tok0 + sc * 8); f32x4 a, b; unpack8(wv, a, b);
#pragma unroll
          for (int j = 0; j < 4; ++j) { s[j] += a[j]; q[j] += a[j] * a[j]; s[4 + j] += b[j]; q[4 + j] += b[j] * b[j]; } }
#pragma unroll
      for (int j = 0; j < 8; ++j) { red[rg * 256 + sc * 8 + j] = s[j]; red[rg * 256 + 128 + sc * 8 + j] = q[j]; } }
    __syncthreads();
    if (tid < 128) { float s = 0.f, q = 0.f;
        for (int i = 0; i < 32; ++i) { s += red[i * 256 + tid]; q += red[i * 256 + 128 + tid]; }
        const float mean = s * (1.0f / 1024.0f); const float var = q * (1.0f / 1024.0f) - mean * mean;
        stat[2 * tid] = mean; stat[2 * tid + 1] = rsqrtf(var + EPS); }
    __syncthreads();
    const int tb = w & 3, dh = w >> 2;
    u32x4 pre[4];
#pragma unroll
    for (int i = 0; i < 4; ++i) { const int p = tid + 512 * i; pre[i] = *(const u32x4*)(VT2 + (size_t)(gh * 512 + (p >> 4)) * MH + tok0 + (p & 15) * 8); }
    for (int gi = 0; gi < 4; ++gi) { const int g = gh * 4 + gi;
#pragma unroll
        for (int i = 0; i < 4; ++i) { const int p = tid + 512 * i, d = p >> 4, sc = p & 15;
            f32x4 a, b; unpack8(pre[i], a, b);
            const float gg = LG[gi * 128 + d], bb = LB[gi * 128 + d];
#pragma unroll
            for (int j = 0; j < 4; ++j) { a[j] = (a[j] - stat[2 * (sc * 8 + j)]) * stat[2 * (sc * 8 + j) + 1] * gg + bb; b[j] = (b[j] - stat[2 * (sc * 8 + 4 + j)]) * stat[2 * (sc * 8 + 4 + j) + 1] * gg + bb; }
            *(LAS u32x4*)(T + d * 272 + sc * 16) = pack8(a, b); }
        if (gi < 3) {
#pragma unroll
            for (int i = 0; i < 4; ++i) { const int p = tid + 512 * i; pre[i] = *(const u32x4*)(VT2 + (size_t)((g + 1) * 128 + (p >> 4)) * MH + tok0 + (p & 15) * 8); } }
        const float* wrow = ws + (size_t)g * 16384 + (size_t)(32 * tb + l32) * 128 + 8 * hi;
        const int trow = 32 * tb + l32;
        f32x4 wa[8], wb[8];
#pragma unroll
        for (int ks = 0; ks < 8; ++ks) if (ks < 2 * tb + 2) { wa[ks] = *(const f32x4*)(wrow + 16 * ks); wb[ks] = *(const f32x4*)(wrow + 16 * ks + 4); }
        float bv[16];
#pragma unroll
        for (int r = 0; r < 16; ++r) bv[r] = bs[g * 128 + 32 * tb + (r & 3) + 8 * (r >> 2) + 4 * hi];
        u32x4 uq[4], zq[4];
#pragma unroll
        for (int i = 0; i < 4; ++i) { const int p = tid + 512 * i; const bf16_t* up = PROJ + (size_t)(tok0 + (p >> 4)) * NP1 + g * 128 + (p & 15) * 8; uq[i] = *(const u32x4*)up; zq[i] = *(const u32x4*)(up + 1024); }
        __syncthreads();
        f32x16 acc0 = {}, acc1 = {};
#pragma unroll
        for (int ks = 0; ks < 8; ++ks) if (ks < 2 * tb + 2) { const int s0 = 16 * ks + 8 * hi; f32x4 a_ = wa[ks], b_ = wb[ks];
#pragma unroll
            for (int j = 0; j < 4; ++j) { if (s0 + j > trow) a_[j] = 0.f; if (s0 + 4 + j > trow) b_[j] = 0.f; }
            const bf16x8 A = __builtin_bit_cast(bf16x8, pack8(a_, b_));
            const bf16x8 B0 = *(const LAS bf16x8*)(T + (64 * dh + l32) * 272 + (16 * ks + 8 * hi) * 2);
            const bf16x8 B1 = *(const LAS bf16x8*)(T + (64 * dh + 32 + l32) * 272 + (16 * ks + 8 * hi) * 2);
            acc0 = __builtin_amdgcn_mfma_f32_32x32x16_bf16(A, B0, acc0, 0, 0, 0);
            acc1 = __builtin_amdgcn_mfma_f32_32x32x16_bf16(A, B1, acc1, 0, 0, 0);
        }
        LAS float* Yb = (LAS float*)(lds + 71680);
#pragma unroll
        for (int r = 0; r < 16; ++r) { const int t = 32 * tb + (r & 3) + 8 * (r >> 2) + 4 * hi;
            Yb[t * 132 + 64 * dh + l32] = acc0[r] + bv[r]; Yb[t * 132 + 64 * dh + 32 + l32] = acc1[r] + bv[r]; }
        __syncthreads();
#pragma unroll
        for (int i = 0; i < 4; ++i) { const int p = tid + 512 * i, t = p >> 4, c8 = p & 15; const size_t tok = (size_t)(tok0 + t); const int col = g * 128 + c8 * 8;
            f32x4 u0, u1, z0, z1; unpack8(uq[i], u0, u1); unpack8(zq[i], z0, z1);
            const f32x4 y0 = *(const LAS f32x4*)(Yb + t * 132 + c8 * 8), y1 = *(const LAS f32x4*)(Yb + t * 132 + c8 * 8 + 4);
            *(u32x4*)(BRA + tok * DM + col) = pack8(u0 * y0 * z0, u1 * y1 * z1); }
        __syncthreads();
    }
}

constexpr int AT_KS = 17408, AT_VS = 18432, AT_VOFF = 2 * AT_KS;
__device__ __forceinline__ void attn_unit(LAS unsigned char* lds, const bf16_t* PROJ, const bf16_t* VT2, bf16_t* BRB, const float* subg, float lam, float lam_init, int b, int h, int qb) {
    int tid_ = threadIdx.x; asm volatile("" : "+v"(tid_)); const int tid = tid_, lane = tid & 63, l32 = lane & 31, hi = lane >> 5; const int w = __builtin_amdgcn_readfirstlane(tid >> 6); const int map = w >> 2, wq = w & 3;
    const int rowbase = b * SEQ, q0 = qb * 128, myq = q0 + wq * 32 + l32, NT = 2 * qb + 2;
    bf16x8 qf[4];
    { const bf16_t* qp = PROJ + (size_t)(rowbase + myq) * NP1 + 2048 + h * 128 + map * 64 + hi * 8;
#pragma unroll
      for (int ks = 0; ks < 4; ++ks) qf[ks] = *(const bf16x8*)(qp + ks * 16); }
    const bf16_t* ksrc[2]; const bf16_t* vsrc[2]; int kdst[2], vdst[2];
#pragma unroll
    for (int i = 0; i < 2; ++i) { const int p = tid + 512 * i;
        ksrc[i] = PROJ + (size_t)(rowbase + (p >> 4)) * NP1 + 3072 + h * 128 + (p & 15) * 8; kdst[i] = (p >> 4) * 272 + (p & 15) * 16;
        vsrc[i] = VT2 + (size_t)(1024 + h * 128 + (p >> 3)) * MH + rowbase + (p & 7) * 8; vdst[i] = AT_VOFF + (p >> 3) * 144 + (((p & 7) >> 1) * 16 + (p & 1) * 4) * 2; }
    u32x4 kr[2], vr[2];
#pragma unroll
    for (int i = 0; i < 2; ++i) { kr[i] = *(const u32x4*)(ksrc[i]); vr[i] = *(const u32x4*)(vsrc[i]); }
#pragma unroll
    for (int i = 0; i < 2; ++i) { *(LAS u32x4*)(lds + kdst[i]) = kr[i]; *(LAS u32x2*)(lds + vdst[i]) = (u32x2){vr[i].x, vr[i].y}; *(LAS u32x2*)(lds + vdst[i] + 16) = (u32x2){vr[i].z, vr[i].w}; }
    __syncthreads();
    f32x16 O[4]; O[0] = f32x16{}; O[1] = f32x16{}; O[2] = f32x16{}; O[3] = f32x16{};
    float m_run = -1e30f, l_run = 0.f;
    for (int t = 0; t < NT; ++t) {
        const int buf = t & 1, kv0 = 64 * t;
        if (t + 1 < NT) {
#pragma unroll
            for (int i = 0; i < 2; ++i) { kr[i] = *(const u32x4*)(ksrc[i] + (size_t)(kv0 + 64) * NP1); vr[i] = *(const u32x4*)(vsrc[i] + kv0 + 64); } }
        if (kv0 <= q0 + wq * 32 + 31) {
            LAS unsigned char* Kb = lds + buf * AT_KS + l32 * 272 + map * 128 + hi * 16;
            LAS unsigned char* Vb = lds + AT_VOFF + buf * AT_VS + l32 * 144 + hi * 16;
            f32x16 S0 = {}, S1 = {};
            { bf16x8 kf[8];
#pragma unroll
              for (int ks = 0; ks < 4; ++ks) { kf[2 * ks] = *(const LAS bf16x8*)(Kb + ks * 32); kf[2 * ks + 1] = *(const LAS bf16x8*)(Kb + 32 * 272 + ks * 32); }
              __builtin_amdgcn_sched_barrier(0);
#pragma unroll
              for (int ks = 0; ks < 4; ++ks) { S0 = __builtin_amdgcn_mfma_f32_32x32x16_bf16(kf[2 * ks], qf[ks], S0, 0, 0, 0); S1 = __builtin_amdgcn_mfma_f32_32x32x16_bf16(kf[2 * ks + 1], qf[ks], S1, 0, 0, 0); } }
            u32x4 va[8], vb[8];
#pragma unroll
            for (int j = 0; j < 2; ++j)
#pragma unroll
                for (int db = 0; db < 4; ++db) va[j * 4 + db] = *(const LAS u32x4*)(Vb + db * 32 * 144 + j * 32);
            __builtin_amdgcn_sched_barrier(0);
            if (t >= NT - 2) {
#pragma unroll
                for (int r = 0; r < 16; ++r) { const int kv = kv0 + (r & 3) + 8 * (r >> 2) + 4 * hi; if (kv > myq) S0[r] = -1e30f; if (kv + 32 > myq) S1[r] = -1e30f; } }
            float mx = __builtin_fmaxf(__builtin_fmaxf(S0[0], S1[0]), __builtin_fmaxf(S0[1], S1[1]));
#pragma unroll
            for (int r = 2; r < 16; r += 2) { mx = __builtin_fmaxf(__builtin_fmaxf(mx, S0[r]), S1[r]); mx = __builtin_fmaxf(__builtin_fmaxf(mx, S0[r + 1]), S1[r + 1]); }
            if (__any(mx > m_run + 8.0f)) { mx = fmaxf(mx, __shfl_xor(mx, 32)); const float mnew = fmaxf(m_run, mx), alpha = __builtin_amdgcn_exp2f(m_run - mnew); m_run = mnew; l_run *= alpha;
#pragma unroll
                for (int db = 0; db < 4; ++db)
#pragma unroll
                    for (int r = 0; r < 16; ++r) O[db][r] *= alpha; }
            pg8::f32x2 ps2 = {0.f, 0.f};
#pragma unroll
            for (int r = 0; r < 16; r += 2) { S0[r] = __builtin_amdgcn_exp2f(S0[r] - m_run); S0[r + 1] = __builtin_amdgcn_exp2f(S0[r + 1] - m_run); ps2 += (pg8::f32x2){S0[r], S0[r + 1]}; }
            bf16x8 pf[4];
#pragma unroll
            for (int j = 0; j < 2; ++j) { u32x4 pw;
#pragma unroll
                for (int i = 0; i < 4; ++i) pw[i] = cvtpk(S0[8 * j + 2 * i], S0[8 * j + 2 * i + 1]);
                pf[j] = __builtin_bit_cast(bf16x8, pw); }
#pragma unroll
            for (int j = 2; j < 4; ++j)
#pragma unroll
                for (int db = 0; db < 4; ++db) vb[(j - 2) * 4 + db] = *(const LAS u32x4*)(Vb + db * 32 * 144 + j * 32);
            __builtin_amdgcn_sched_barrier(0);
#pragma unroll
            for (int j = 0; j < 2; ++j)
#pragma unroll
                for (int db = 0; db < 4; ++db) O[db] = __builtin_amdgcn_mfma_f32_32x32x16_bf16(__builtin_bit_cast(bf16x8, va[j * 4 + db]), pf[j], O[db], 0, 0, 0);
#pragma unroll
            for (int r = 0; r < 16; r += 2) { S1[r] = __builtin_amdgcn_exp2f(S1[r] - m_run); S1[r + 1] = __builtin_amdgcn_exp2f(S1[r + 1] - m_run); ps2 += (pg8::f32x2){S1[r], S1[r + 1]}; }
#pragma unroll
            for (int j = 2; j < 4; ++j) { u32x4 pw;
#pragma unroll
                for (int i = 0; i < 4; ++i) pw[i] = cvtpk(S1[8 * (j & 1) + 2 * i], S1[8 * (j & 1) + 2 * i + 1]);
                pf[j] = __builtin_bit_cast(bf16x8, pw); }
#pragma unroll
            for (int k = 0; k < 8; ++k) { __builtin_amdgcn_sched_group_barrier(0x008, 1, 0); __builtin_amdgcn_sched_group_barrier(0x002, 6, 0); }
            __builtin_amdgcn_sched_barrier(0);
            l_run += ps2.x + ps2.y;
#pragma unroll
            for (int j = 2; j < 4; ++j)
#pragma unroll
                for (int db = 0; db < 4; ++db) O[db] = __builtin_amdgcn_mfma_f32_32x32x16_bf16(__builtin_bit_cast(bf16x8, vb[(j - 2) * 4 + db]), pf[j], O[db], 0, 0, 0);
        }
        if (t + 1 < NT) {
#pragma unroll
            for (int i = 0; i < 2; ++i) { *(LAS u32x4*)(lds + (buf ^ 1) * AT_KS + kdst[i]) = kr[i]; *(LAS u32x2*)(lds + (buf ^ 1) * AT_VS + vdst[i]) = (u32x2){vr[i].x, vr[i].y}; *(LAS u32x2*)(lds + (buf ^ 1) * AT_VS + vdst[i] + 16) = (u32x2){vr[i].z, vr[i].w}; } }
        __syncthreads();
    }
    const float inv = 1.0f / (l_run + __shfl_xor(l_run, 32));
    LAS float* X = (LAS float*)lds + wq * 4096 + lane;
    if (map == 1) { const float sc = -lam * inv;
#pragma unroll
        for (int db = 0; db < 4; ++db)
#pragma unroll
            for (int r = 0; r < 16; ++r) X[(db * 16 + r) * 64] = O[db][r] * sc; }
    __syncthreads();
    if (map == 0) { float ss = 0.f;
#pragma unroll
        for (int db = 0; db < 4; ++db)
#pragma unroll
            for (int r = 0; r < 16; ++r) { const float o = O[db][r] * inv + X[(db * 16 + r) * 64]; O[db][r] = o; ss += o * o; }
        ss += __shfl_xor(ss, 32);
        const float rs = rsqrtf(ss * (1.0f / 128.0f) + EPS) * (1.0f - lam_init);
        LAS float* Zr = (LAS float*)(lds + 65536) + (wq * 32 + l32) * 132;
#pragma unroll
        for (int db = 0; db < 4; ++db)
#pragma unroll
            for (int rg = 0; rg < 4; ++rg) { const int d = 32 * db + 8 * rg + 4 * hi; const f32x4 gg = *(const f32x4*)(subg + d);
                *(LAS f32x4*)(Zr + d) = (f32x4){O[db][4 * rg] * rs * gg[0], O[db][4 * rg + 1] * rs * gg[1], O[db][4 * rg + 2] * rs * gg[2], O[db][4 * rg + 3] * rs * gg[3]}; } }
    __syncthreads();
#pragma unroll
    for (int i = 0; i < 4; ++i) { const int p = tid + 512 * i, q = p >> 4, c8 = p & 15; const size_t row = (size_t)(rowbase + q0 + q);
        f32x4 z0, z1; unpack8(*(const u32x4*)(PROJ + row * NP1 + 4096 + h * 128 + c8 * 8), z0, z1);
        const LAS float* zp = (const LAS float*)(lds + 65536) + q * 132 + c8 * 8;
        const f32x4 v0 = *(const LAS f32x4*)zp, v1 = *(const LAS f32x4*)(zp + 4);
        *(u32x4*)(BRB + row * DM + h * 128 + c8 * 8) = pack8(v0 * z0, v1 * z1); }
    __syncthreads();
}

#define RLX_AGENT __ATOMIC_RELAXED, __HIP_MEMORY_SCOPE_AGENT
#define XB_TMO      128
#define XB_XCNT(j)  (256  + 64 * (j))
#define XB_XSUB(j)  (1280 + 64 * (j))
#define XB_XGEN(j)  (2304 + 64 * (j))
#define XB_TOP      3328
#define XB_TOPGEN   3392
#define XCD_BAR_WORDS 3456
#define XB_SPIN_CAP (1u << 18)

__device__ __forceinline__ unsigned xb_ld(unsigned* p)              { return __hip_atomic_load(p, __ATOMIC_RELAXED, __HIP_MEMORY_SCOPE_AGENT); }
__device__ __forceinline__ unsigned xb_add(unsigned* p, unsigned v) { return __hip_atomic_fetch_add(p, v, __ATOMIC_RELAXED, __HIP_MEMORY_SCOPE_AGENT); }
__device__ __forceinline__ unsigned xb_xcc_id() { return (unsigned)__builtin_amdgcn_s_getreg((3 << 11) | 20) & 0xFu; }
#define XB_SPIN(cond, bar) do { unsigned _sp = 0; while (cond) { __builtin_amdgcn_s_sleep(1); \
    if ((++_sp & 255u) == 0u) { if (xb_ld(&(bar)[XB_TMO])) break; if (_sp > XB_SPIN_CAP) { atomicAdd(&(bar)[XB_TMO], 1u); break; } } } } while (0)

struct XcdBarrier {
    unsigned* bar; unsigned x;
    volatile LAS unsigned* st;
};

__device__ __forceinline__ XcdBarrier xcd_barrier_post(unsigned* bar, volatile LAS unsigned* st) {
    XcdBarrier b; b.bar = bar; b.x = xb_xcc_id(); b.st = st;
    if (threadIdx.x == 0) (void)xb_add(&bar[XB_XCNT(b.x)], 1u);
    return b;
}
__device__ __forceinline__ void xcd_barrier_complete(unsigned* bar, unsigned x, unsigned& nloc, unsigned& nx) {
    const unsigned G = gridDim.x * gridDim.y * gridDim.z;
    unsigned sum, cnt, mine, sp = 0u;
    for (;;) {
        sum = 0u; cnt = 0u; mine = 0u;
#pragma unroll
        for (unsigned j = 0; j < 16; ++j) { const unsigned c = xb_ld(&bar[XB_XCNT(j)]); sum += c; cnt += (c > 0u) ? 1u : 0u; mine = (j == x) ? c : mine; }
        if (sum == G) break;
        __builtin_amdgcn_s_sleep(1);
        if ((++sp & 255u) == 0u) { if (xb_ld(&bar[XB_TMO])) break; if (sp > XB_SPIN_CAP) { atomicAdd(&bar[XB_TMO], 1u); break; } }
    }
    nloc = mine > 0u ? mine : 1u; nx = cnt > 0u ? cnt : 1u;
}

__device__ __forceinline__ void xcd_barrier(const XcdBarrier& b) {
    asm volatile("s_waitcnt vmcnt(0)" ::: "memory");
    __syncthreads();
    if (threadIdx.x == 0) {
        unsigned* bar = b.bar;
        __builtin_amdgcn_s_waitcnt(0);
        unsigned nloc = b.st[0], nx = b.st[1];
        if (nloc == 0u) { xcd_barrier_complete(bar, b.x, nloc, nx); b.st[0] = nloc; b.st[1] = nx; }
        const unsigned old = xb_add(&bar[XB_XSUB(b.x)], 1u);
        const unsigned gen = old / nloc;
        if (old + 1u == (gen + 1u) * nloc) {
            __builtin_amdgcn_fence(__ATOMIC_RELEASE, "agent");
            asm volatile("s_waitcnt vmcnt(0)" ::: "memory");
            const unsigned og = xb_add(&bar[XB_TOP], 1u);
            const unsigned tg = og / nx;
            if (og + 1u == (tg + 1u) * nx) xb_add(&bar[XB_TOPGEN], 1u);
            else XB_SPIN(xb_ld(&bar[XB_TOPGEN]) == tg, bar);
            __builtin_amdgcn_fence(__ATOMIC_ACQUIRE, "agent");
            xb_add(&bar[XB_XGEN(b.x)], 1u);
            asm volatile("s_waitcnt vmcnt(0)" ::: "memory");
        } else {
            XB_SPIN(xb_ld(&bar[XB_XGEN(b.x)]) == gen, bar);
            __builtin_amdgcn_fence(__ATOMIC_ACQUIRE, "agent");
            asm volatile("s_waitcnt vmcnt(0)" ::: "memory");
        }
    }
    __syncthreads();
}


__global__ void __launch_bounds__(NTHREADS, 2) mega_fwd(Args a_unused) {
    extern __shared__ __attribute__((aligned(16))) unsigned char lds_raw[];
    LAS unsigned char* lds = (LAS unsigned char*)lds_raw;
    cg::grid_group grid = cg::this_grid();
    const int tid = threadIdx.x, lane = tid & 63, wave = __builtin_amdgcn_readfirstlane(tid >> 6);
    const int G = gridDim.x, bx = blockIdx.x;
    const int vcu = (G % 8 == 0) ? (bx % 8) * (G / 8) + bx / 8 : bx;
    const int gw = vcu * NWAVES + wave, ngw = G * NWAVES;
#define ARGS() cargs_t ap = (cargs_t)__builtin_amdgcn_kernarg_segment_ptr(); asm volatile("" : "+s"(ap)); unsigned char* const ws = ap->ws
#define GSYNC() xcd_barrier(xbar)
#define WSP(T, off) ((T*)(ws + (off)))
#define XBP(ci) ((bf16_t*)(ws + ((ci) ? WS_X1 : WS_X0)))
#define SXP(ci) ((float*)(ws + ((ci) ? WS_S1 : WS_S0)))
#define TMPP ((float*)(ws + WS_PROJ + 4096))
    if (tid < 64) ((LAS unsigned*)(lds + 147200))[tid] = 0u;
    __syncthreads();
    grid.sync();
    XcdBarrier xbar;
    { ARGS(); xbar = xcd_barrier_post((unsigned*)ws, (volatile LAS unsigned*)(lds + 147200)); }
    { ARGS(); weights_prologue(ap, lds, gw, ngw, wave, lane); }

#define DUMP_BF16(buf_off, nelem) do { ARGS(); const bf16_t* B_ = WSP(bf16_t, buf_off); float* o_ = ap->out; \
    for (size_t i_ = (size_t)bx * NTHREADS + tid; i_ < (size_t)2 * MH * DM; i_ += (size_t)G * NTHREADS) o_[i_] = __uint_as_float((unsigned)B_[i_ % (size_t)(nelem)] << 16); } while (0)
    for (int hf = 0; hf < 2; ++hf) {
        { ARGS(); init_rows(ap->x + (size_t)hf * MH * DM, XBP(0), SXP(0), gw, ngw, lane); }
        GSYNC();
        int c = 0;
        for (int l = 0; l < NLAYER; ++l) {
            { ARGS(); convert_p(ap->p + ((size_t)l * 2 * MH + (size_t)hf * MH) * PLE, WSP(bf16_t, WS_PB), bx * NTHREADS + tid, G * NTHREADS); }
            int rbase;
            { ARGS(); rbase = 2048 * (bx & 7);
              LAS float* rt = (LAS float*)(lds + 131072); const float* Sx = SXP(c);
              int t_ = threadIdx.x; asm volatile("" : "+v"(t_));
#pragma unroll
              for (int i = 0; i < 4; ++i) { const int r = t_ + 512 * i; const f32x4* p = (const f32x4*)(Sx + (size_t)(rbase + r) * 16); const f32x4 q = (p[0] + p[1]) + (p[2] + p[3]);
                  rt[r] = rsqrtf(((q[0] + q[1]) + (q[2] + q[3])) * (1.0f / 1024.0f) + EPS); }
              __syncthreads(); }
#if !defined(ONLY) || ONLY == 0
            { ARGS(); const bf16_t* wl = WSP(bf16_t, WS_W) + (size_t)l * LW_TOTAL;
              pg8::Gemm g{XBP(c), wl + LW_IN, MH, NP1, DM}; pg8::StaticOrder S; S.init(MH, NP1, G, bx);
              pg8::Epi E{0, WSP(bf16_t, WS_PROJ), NP1, nullptr, 0, nullptr, 0, nullptr, SXP(c), nullptr, nullptr, nullptr, (const LAS float*)(lds + 131072), rbase};
              pg8::gemm_phase<pg8::Epi, pg8::StaticOrder, true, true>(lds, g, S, E); }
#endif
#if !defined(ONLY) || ONLY == 1
            { ARGS(); const bf16_t* wl = WSP(bf16_t, WS_W) + (size_t)l * LW_TOTAL;
              pg8::Gemm g{wl + LW_IN + (size_t)NP1 * DM, XBP(c), NV2, MH, DM}; pg8::StaticOrder S; S.init(NV2, MH, G, bx);
              pg8::Epi E{1, WSP(bf16_t, WS_VT2), MH, nullptr, 0, nullptr, 0, nullptr, SXP(c), nullptr, nullptr, nullptr, (const LAS float*)(lds + 131072), rbase};
              pg8::gemm_phase<pg8::Epi, pg8::StaticOrder, true, true>(lds, g, S, E); }
#endif
            GSYNC();
#if defined(STOP_AFTER) && STOP_AFTER == 1
            DUMP_BF16(WS_PROJ, (size_t)MH * NP1); return;
#endif
#if defined(STOP_AFTER) && STOP_AFTER == 11
            DUMP_BF16(WS_VT2, (size_t)MH * NV2); return;
#endif
#ifndef NO_GMLP
            { ARGS();
              for (int u = vcu; u < 256; u += G)
                gmlp_unit(lds, WSP(bf16_t, WS_PROJ), WSP(bf16_t, WS_VT2), WSP(bf16_t, WS_BRA), ap->a_ln_g + l * 1024, ap->a_ln_b + l * 1024, ap->a_ws + (size_t)l * 131072, ap->a_bs + l * 1024, u >> 1, u & 1); }
#endif
#ifdef NO_ATTN
            { ARGS(); const bf16_t* PR = WSP(bf16_t, WS_PROJ); bf16_t* B = WSP(bf16_t, WS_BRB);
              for (int i = bx * NTHREADS + tid; i < MH * DM / 8; i += G * NTHREADS) { const int row = i >> 7, c8 = i & 127; *(u32x4*)(B + (size_t)row * DM + c8 * 8) = *(const u32x4*)(PR + (size_t)row * NP1 + 4096 + c8 * 8); } }
#endif
#ifdef NO_GMLP
            { ARGS(); const bf16_t* PR = WSP(bf16_t, WS_PROJ); bf16_t* B = WSP(bf16_t, WS_BRA);
              for (int i = bx * NTHREADS + tid; i < MH * DM / 8; i += G * NTHREADS) { const int row = i >> 7, c8 = i & 127; *(u32x4*)(B + (size_t)row * DM + c8 * 8) = *(const u32x4*)(PR + (size_t)row * NP1 + c8 * 8); } }
#endif
#ifndef NO_ATTN
            { ARGS();
              const float lam_init = 0.8f - 0.6f * expf(-0.3f * (float)l);
              const float d0 = wave_sum(ap->lam_q[l * 128 + lane] * ap->lam_k[l * 128 + lane]), d1 = wave_sum(ap->lam_q[l * 128 + 64 + lane] * ap->lam_k[l * 128 + 64 + lane]);
              const float lam = expf(d0) - expf(d1) + lam_init;
              for (int pu = vcu; pu < 512; pu += G) { const int bh = pu >> 4, s = pu & 15;
                  attn_unit(lds, WSP(bf16_t, WS_PROJ), WSP(bf16_t, WS_VT2), WSP(bf16_t, WS_BRB), ap->subln_g + l * 128, lam, lam_init, bh >> 3, bh & 7, 31 - s);
                  attn_unit(lds, WSP(bf16_t, WS_PROJ), WSP(bf16_t, WS_VT2), WSP(bf16_t, WS_BRB), ap->subln_g + l * 128, lam, lam_init, bh >> 3, bh & 7, s); } }
#endif
            GSYNC();
#if !defined(ONLY) || ONLY == 2
            { ARGS(); const bf16_t* wl = WSP(bf16_t, WS_W) + (size_t)l * LW_TOTAL;
              pg8::Gemm g{WSP(bf16_t, WS_BRA), wl + LW_A, MH, DM, DM}; pg8::StaticOrder S; S.init(MH, DM, G, bx);
              pg8::Epi E{2, WSP(bf16_t, WS_PROJ) + 2048, NP1, nullptr, 0, nullptr, 0, WSP(bf16_t, WS_PROJ) + 5120, nullptr, nullptr, nullptr, nullptr, nullptr, 0};
              pg8::gemm_phase<pg8::Epi, pg8::StaticOrder, true, true>(lds, g, S, E); }
#endif
#if !defined(ONLY) || ONLY == 3
            { ARGS(); const bf16_t* wl = WSP(bf16_t, WS_W) + (size_t)l * LW_TOTAL;
              pg8::Gemm g{WSP(bf16_t, WS_BRB), wl + LW_B, MH, DM, DM}; pg8::StaticOrder S; S.init(MH, DM, G, bx);
              pg8::Epi E{3, XBP(1 - c), DM, nullptr, 0, nullptr, 0, WSP(bf16_t, WS_PROJ) + 6144, nullptr, nullptr, WSP(bf16_t, WS_PROJ) + 2048, nullptr, nullptr, 0};
              pg8::gemm_phase<pg8::Epi, pg8::StaticOrder, true, true>(lds, g, S, E); }
#endif
            GSYNC();
#if defined(STOP_AFTER) && STOP_AFTER == 3
            if (c == 0) DUMP_BF16(WS_X1, (size_t)MH * DM); else DUMP_BF16(WS_X0, (size_t)MH * DM); return;
#endif
#if !defined(ONLY) || ONLY == 4
            { ARGS(); const bf16_t* wl = WSP(bf16_t, WS_W) + (size_t)l * LW_TOTAL; float* out = ap->out + (size_t)hf * MH * DM;
              pg8::Gemm g{XBP(1 - c), wl + LW_O, MH, DM, DM}; pg8::StaticOrder S; S.init(MH, DM, G, bx);
              pg8::Epi E{4, XBP(c), DM, nullptr, 0, l == 0 ? ap->x + (size_t)hf * MH * DM : (const float*)nullptr, DM, nullptr, nullptr, SXP(c), nullptr, XBP(c), nullptr, 0};
              pg8::gemm_phase<pg8::Epi, pg8::StaticOrder, true, true>(lds, g, S, E); }
#endif
            GSYNC();
#if defined(STOP_AFTER) && STOP_AFTER == 4
            if (c == 0) DUMP_BF16(WS_X0, (size_t)MH * DM); else DUMP_BF16(WS_X1, (size_t)MH * DM); return;
#endif
#if !defined(ONLY) || ONLY == 5
            { ARGS(); const bf16_t* wl = WSP(bf16_t, WS_W) + (size_t)l * LW_TOTAL;
              pg8::Gemm g{XBP(c), wl + LW_G, MH, DM, DM}; pg8::StaticOrder S; S.init(MH, DM, G, bx);
              pg8::Epi E{5, WSP(bf16_t, WS_PROJ) + 2048, NP1, nullptr, 0, nullptr, 0, nullptr, SXP(c), nullptr, nullptr, nullptr, nullptr, 0};
              pg8::gemm_phase<pg8::Epi, pg8::StaticOrder, true, true>(lds, g, S, E); }
#endif
#if !defined(ONLY) || ONLY == 6
            { ARGS(); const bf16_t* wl = WSP(bf16_t, WS_W) + (size_t)l * LW_TOTAL; float* out = ap->out + (size_t)hf * MH * DM;
              pg8::Gemm g{WSP(bf16_t, WS_PB), wl + LW_P, MH, DM, PLE}; pg8::StaticOrder S; S.init(MH, DM, G, bx);
              pg8::Epi E{6, XBP(1 - c), DM, l == NLAYER - 1 ? out : (float*)nullptr, DM, nullptr, 0, nullptr, nullptr, SXP(1 - c), WSP(bf16_t, WS_PROJ) + 2048, XBP(c), nullptr, 0};
              pg8::gemm_phase<pg8::Epi, pg8::StaticOrder, true, true>(lds, g, S, E); }
#endif
            GSYNC();
#if defined(STOP_AFTER) && STOP_AFTER == 5
            if (c == 0) DUMP_BF16(WS_X1, (size_t)MH * DM); else DUMP_BF16(WS_X0, (size_t)MH * DM); return;
#endif
            c ^= 1;
        }
        { ARGS(); final_rows(ap->out + (size_t)hf * MH * DM, ap->final_g, gw, ngw, lane); }
    }
}

extern "C" void kernel_launch(void* const* d_in, const int* in_sizes, int n_in, void* d_out, int out_size, void* d_ws, size_t ws_size, hipStream_t stream) {
    static int grid = 0;
    if (grid == 0) {
        if (n_in != 18 || ws_size < WS_END) { fprintf(stderr, "kernel_launch: unexpected n_in %d / ws_size %zu (need %zu)\n", n_in, ws_size, (size_t)WS_END); grid = -1; return; }
        int dev = 0, cus = 0, per_cu = 0;
        hipGetDevice(&dev); hipDeviceGetAttribute(&cus, hipDeviceAttributeMultiprocessorCount, dev);
        if (hipFuncSetAttribute((const void*)mega_fwd, hipFuncAttributeMaxDynamicSharedMemorySize, LDS_BYTES) != hipSuccess) { fprintf(stderr, "kernel_launch: hipFuncSetAttribute failed\n"); grid = -1; return; }
        if (hipOccupancyMaxActiveBlocksPerMultiprocessor(&per_cu, (const void*)mega_fwd, NTHREADS, LDS_BYTES) != hipSuccess || per_cu < 1) { fprintf(stderr, "kernel_launch: occupancy query gives %d\n", per_cu); per_cu = 1; }
        (void)hipGetLastError();
        if (cus % 8 != 0) { fprintf(stderr, "kernel_launch: CU count %d is not a multiple of 8\n", cus); grid = -1; return; }
        grid = cus;
    }
    if (grid < 0) return;
    if (hipMemsetAsync(d_ws, 0, 16384, stream) != hipSuccess) { fprintf(stderr, "kernel_launch: memset failed\n"); return; }
    Args a{};
    const float** f = (const float**)&a;
    for (int i = 0; i < 18; ++i) f[i] = (const float*)d_in[i];
    a.out = (float*)d_out; a.ws = (unsigned char*)d_ws;
    void* args[] = {&a};
    hipError_t e = hipLaunchCooperativeKernel((const void*)mega_fwd, dim3(grid), dim3(NTHREADS), args, LDS_BYTES, stream);
    if (e != hipSuccess) fprintf(stderr, "cooperative launch failed: %s (grid %d)\n", hipGetErrorString(e), grid);
}
```

```cpp
#include <hip/hip_runtime.h>
#include <hip/hip_cooperative_groups.h>
#include <cstdio>
#include <cstdint>
namespace cg = cooperative_groups;
template <int M> __device__ __forceinline__ float xor_lt32(float v) { return __builtin_bit_cast(float, __builtin_amdgcn_ds_swizzle(__builtin_bit_cast(int, v), (M << 10) | 0x1F)); }
__device__ __forceinline__ float xor32_add(float v) { const unsigned b = __builtin_bit_cast(unsigned, v); auto rr = __builtin_amdgcn_permlane32_swap(b, b, false, false); return __builtin_bit_cast(float, (unsigned)rr[0]) + __builtin_bit_cast(float, (unsigned)rr[1]); }
__device__ __forceinline__ float xor32_max(float v) { const unsigned b = __builtin_bit_cast(unsigned, v); auto rr = __builtin_amdgcn_permlane32_swap(b, b, false, false); return fmaxf(__builtin_bit_cast(float, (unsigned)rr[0]), __builtin_bit_cast(float, (unsigned)rr[1])); }
__device__ __forceinline__ int lane_id_() { int l_; asm volatile("v_mbcnt_lo_u32_b32 %0, -1, 0\n\tv_mbcnt_hi_u32_b32 %0, -1, %0" : "=&v"(l_)); return l_; }
namespace pg8 {
#define PG8_LAS __attribute__((address_space(3)))
typedef unsigned short bf16_t;
typedef short bf16x8 __attribute__((ext_vector_type(8)));
typedef float f32x4 __attribute__((ext_vector_type(4)));
typedef unsigned u32x4 __attribute__((ext_vector_type(4)));
constexpr int BM = 256, BK = 64, HALF = 128, HTB = HALF * BK * 2  , STAGE_BYTES = 8 * HTB, NXCD = 8, WGM = 8;

__host__ __device__ __forceinline__ int lds_byte(int r, int c) { const int st = (r >> 4) * 2 + (c >> 5), rr = r & 15, cc = c & 31, ob = rr * 64 + cc * 2; return st * 1024 + (ob ^ (((ob >> 9) & 1) << 5)); }
__host__ __device__ __forceinline__ void stage_rc(int b, int& R, int& C) { const int st = b / 1024, sb = b % 1024, swz = sb ^ (((sb >> 9) & 1) << 5); R = (st >> 1) * 16 + swz / 64; C = (st & 1) * 32 + (swz % 64) / 2; }
__host__ __device__ __forceinline__ int perm32(int rho) { const int n = rho >> 4, i = rho & 15; return 8 * (i >> 2) + 4 * n + (i & 3); }

struct Unit { int pm, pn; };
struct Gemm { const bf16_t* A; const bf16_t* Bt; int M, N, K; };

struct StaticOrder {
    int nM, nN, nwg, G, c;
    __host__ __device__ void init(int M, int N, int G_, int c_) { nM = M / BM; nN = N / BM; nwg = nM * nN; G = G_; c = c_; }
    __host__ __device__ bool next(int i, Unit& u) const {
        const long L = (long)i * G + c; if (L >= nwg) return false;
        int wgid = (int)L; { const int q = nwg / NXCD, r = nwg % NXCD, xcd = wgid % NXCD, off = wgid / NXCD; wgid = (xcd < r ? xcd * (q + 1) : r * (q + 1) + (xcd - r) * q) + off; }
        const int nig = WGM * nN, gid = wgid / nig, fm = gid * WGM, gsz = (nM - fm) < WGM ? (nM - fm) : WGM;
        u.pm = fm + ((wgid % nig) % gsz); u.pn = (wgid % nig) / gsz; return true;
    }
    __device__ __forceinline__ void a_ready(const Unit&) const {}
    __device__ __forceinline__ void done(const Unit&) const {}
};

__device__ __forceinline__ unsigned cvt_pk_bf16(float lo, float hi) { unsigned r; asm volatile("v_cvt_pk_bf16_f32 %0, %1, %2" : "=v"(r) : "v"(lo), "v"(hi)); return r; }
typedef float f32x2 __attribute__((ext_vector_type(2)));
__device__ __forceinline__ f32x2 gelu_pk(f32x2 v) {
    const f32x2 av = __builtin_elementwise_abs(v), d = av * 0.2316418882f + 1.0f;
    f32x2 t; t.x = __builtin_amdgcn_rcpf(d.x); t.y = __builtin_amdgcn_rcpf(d.y);
    f32x2 q = t * 0.5307027145f + (-0.7265760135f); q = q * t + 0.7107068705f; q = q * t + (-0.142248368f); q = q * t + 0.127414796f; q = q * t;
    const f32x2 s = (v * v) * (-0.72134752044f);
    f32x2 e; e.x = __builtin_amdgcn_exp2f(s.x); e.y = __builtin_amdgcn_exp2f(s.y);
    const f32x2 m = v * (q * e), r = v - m;
    f32x2 o; o.x = v.x < 0.f ? m.x : r.x; o.y = v.y < 0.f ? m.y : r.y; return o;
}

typedef float f32x2_t __attribute__((ext_vector_type(2))); typedef __bf16 bf16x2_t __attribute__((ext_vector_type(2)));
__device__ __forceinline__ unsigned cvtpk(float lo, float hi) { f32x2_t v = {lo, hi}; bf16x2_t b = __builtin_convertvector(v, bf16x2_t); return __builtin_bit_cast(unsigned, b); }
__device__ __forceinline__ u32x4 pack8(f32x4 a, f32x4 b) { u32x4 w; w.x = cvtpk(a[0], a[1]); w.y = cvtpk(a[2], a[3]); w.z = cvtpk(b[0], b[1]); w.w = cvtpk(b[2], b[3]); return w; }
__device__ __forceinline__ void unpack8(u32x4 w, f32x4& a, f32x4& b) {
    a[0] = __uint_as_float(w.x << 16); a[1] = __uint_as_float(w.x & 0xffff0000u); a[2] = __uint_as_float(w.y << 16); a[3] = __uint_as_float(w.y & 0xffff0000u);
    b[0] = __uint_as_float(w.z << 16); b[1] = __uint_as_float(w.z & 0xffff0000u); b[2] = __uint_as_float(w.w << 16); b[3] = __uint_as_float(w.w & 0xffff0000u); }
__device__ __forceinline__ float sigm(float x) { return __builtin_amdgcn_rcpf(1.0f + __builtin_amdgcn_exp2f(-1.4426950408889634f * x)); }
__device__ __forceinline__ f32x4 sigm4(f32x4 v) { f32x4 o; o[0] = sigm(v[0]); o[1] = sigm(v[1]); o[2] = sigm(v[2]); o[3] = sigm(v[3]); return o; }
__device__ __forceinline__ f32x4 gelu4(f32x4 v) { f32x2 a = gelu_pk((f32x2){v[0], v[1]}), b = gelu_pk((f32x2){v[2], v[3]}); return (f32x4){a.x, a.y, b.x, b.y}; }
__device__ __forceinline__ float row_rstd(const float* S, int row) {
    const f32x4* p = (const f32x4*)(S + (size_t)row * 16); const f32x4 s = (p[0] + p[1]) + (p[2] + p[3]);
    return rsqrtf(((s[0] + s[1]) + (s[2] + s[3])) * (1.0f / 1024.0f) + 1e-6f); }
constexpr float QSCALE = 0.125f * 1.4426950408889634f;
struct Epi {
    static constexpr bool PERM = true, AFTER_DRAIN = false;
    int mode; bf16_t* Ob; int ldo; float* Of; int ldf; const float* Fin; int ldi; const bf16_t* G; const float* S; float* Sn; const bf16_t* T16; const bf16_t* Xin; const PG8_LAS float* rtab; int rbase;
    __device__ __forceinline__ void operator()(const f32x4 (&acc)[2][2][4][2], const Unit& u, int wr, int wc, int fr, int fq) const {
        const int row0 = u.pm * BM + wr * 64 + fr, col0 = u.pn * BM + wc * 32 + 8 * fq;
        if (mode == 1) {
            const int sec = u.pm >> 2; f32x4 rc[2][2];
#pragma unroll
            for (int bj = 0; bj < 2; ++bj)
#pragma unroll
                for (int n = 0; n < 2; ++n) rc[bj][n] = *(const PG8_LAS f32x4*)(rtab + (col0 + bj * HALF + 4 * n - rbase));
#pragma unroll
            for (int ai = 0; ai < 2; ++ai)
#pragma unroll
                for (int m = 0; m < 4; ++m) { const int row = row0 + ai * HALF + m * 16;
#pragma unroll
                    for (int bj = 0; bj < 2; ++bj) { f32x4 v0 = acc[ai][bj][m][0] * rc[bj][0], v1 = acc[ai][bj][m][1] * rc[bj][1];
                        if (sec == 0) { v0 = gelu4(v0); v1 = gelu4(v1); }
                        *(u32x4*)(Ob + (size_t)row * ldo + col0 + bj * HALF) = pack8(v0, v1); }
                    if (m & 1) asm volatile("" ::: "memory"); }
            return;
        }
        const int sec = u.pn >> 2;
        if (mode == 0 || mode == 5) {
#pragma unroll
            for (int ai = 0; ai < 2; ++ai) {
                float rsr[4];
#pragma unroll
                for (int m = 0; m < 4; ++m) {
                    if (mode == 0) { rsr[m] = rtab[row0 + ai * HALF + m * 16 - rbase]; }
                    else { const f32x4 p = ((const f32x4*)(S + (size_t)(row0 + ai * HALF + m * 16) * 16))[fq]; float s_ = (p[0] + p[1]) + (p[2] + p[3]);
                        s_ += __shfl_xor(s_, 16); s_ += __shfl_xor(s_, 32); rsr[m] = rsqrtf(s_ * (1.0f / 1024.0f) + 1e-6f); } }
#pragma unroll
                for (int m = 0; m < 4; ++m) { const int row = row0 + ai * HALF + m * 16; const float rs = rsr[m];
#pragma unroll
                    for (int bj = 0; bj < 2; ++bj) { const int col = col0 + bj * HALF; f32x4 v0 = acc[ai][bj][m][0] * rs, v1 = acc[ai][bj][m][1] * rs;
                        if (mode == 0) {
                            if (sec == 0) { v0 = gelu4(v0); v1 = gelu4(v1); }
                            else if (sec == 1 || sec == 4) { v0 = v0 * sigm4(v0); v1 = v1 * sigm4(v1); }
                            else if (sec == 2) { v0 = v0 * QSCALE; v1 = v1 * QSCALE; }
                            else if (sec >= 5) { v0 = sigm4(v0); v1 = sigm4(v1); }
                            *(u32x4*)(Ob + (size_t)row * ldo + col) = pack8(v0, v1);
                        } else { *(u32x4*)(Ob + (size_t)row * ldo + col) = pack8(sigm4(v0), sigm4(v1)); } }
                    asm volatile("" ::: "memory"); }
            }
            return;
        }
#pragma unroll
        for (int ai = 0; ai < 2; ++ai)
#pragma unroll
            for (int mh = 0; mh < 2; ++mh) {
                u32x4 gq[2][2], tq[2][2], xq[2][2]; f32x4 ta[2][2][2];
#pragma unroll
                for (int mm = 0; mm < 2; ++mm)
#pragma unroll
                    for (int bj = 0; bj < 2; ++bj) { const int row = row0 + ai * HALF + (2 * mh + mm) * 16, col = col0 + bj * HALF;
                        if (mode == 2 || mode == 3) gq[mm][bj] = *(const u32x4*)(G + (size_t)row * 7168 + col);
                        if (mode == 4 && Fin) { const float* t = Fin + (size_t)row * ldi + col; ta[mm][bj][0] = *(const f32x4*)t; ta[mm][bj][1] = *(const f32x4*)(t + 4); }
                        if ((mode == 4 && !Fin) || mode == 6) xq[mm][bj] = *(const u32x4*)(Xin + (size_t)row * 1024 + col);
                        if (mode == 3 || mode == 6) tq[mm][bj] = *(const u32x4*)(T16 + (size_t)row * 7168 + col);
                    }
#pragma unroll
                for (int mm = 0; mm < 2; ++mm) { const int m = 2 * mh + mm; const int row = row0 + ai * HALF + m * 16; float ss = 0.f;
#pragma unroll
                    for (int bj = 0; bj < 2; ++bj) { const int col = col0 + bj * HALF; f32x4 v0 = acc[ai][bj][m][0], v1 = acc[ai][bj][m][1];
                        if (mode == 2) { f32x4 g0, g1; unpack8(gq[mm][bj], g0, g1); *(u32x4*)(Ob + (size_t)row * ldo + col) = pack8(v0 * g0, v1 * g1); }
                        else if (mode == 3) { f32x4 g0, g1, t0, t1; unpack8(gq[mm][bj], g0, g1); unpack8(tq[mm][bj], t0, t1); v0 = t0 + v0 * g0; v1 = t1 + v1 * g1; *(u32x4*)(Ob + (size_t)row * ldo + col) = pack8(v0, v1); }
                        else { if (mode == 4) { if (Fin) { v0 = ta[mm][bj][0] + v0; v1 = ta[mm][bj][1] + v1; } else { f32x4 x0, x1; unpack8(xq[mm][bj], x0, x1); v0 = x0 + v0; v1 = x1 + v1; } }
                            else { f32x4 t0, t1, x0, x1; unpack8(tq[mm][bj], t0, t1); unpack8(xq[mm][bj], x0, x1); v0 = x0 + v0 * t0; v1 = x1 + v1 * t1; }
                            if (Of) { float* o = Of + (size_t)row * ldf + col; *(f32x4*)o = v0; *(f32x4*)(o + 4) = v1; }
                            *(u32x4*)(Ob + (size_t)row * ldo + col) = pack8(v0, v1);
                            ss += (v0[0] * v0[0] + v0[1] * v0[1]) + (v0[2] * v0[2] + v0[3] * v0[3]) + (v1[0] * v1[0] + v1[1] * v1[1]) + (v1[2] * v1[2] + v1[3] * v1[3]); } }
                    if (mode == 4 || mode == 6) { ss += __shfl_xor(ss, 16); ss += __shfl_xor(ss, 32); if (fq == 0) Sn[(size_t)row * 16 + u.pn * 4 + wc] = ss; } }
                asm volatile("" ::: "memory");
            }
    }
};
template <class Epi, class Sched, bool ALIGN_EPI = false, bool SP2 = false>
__device__ __forceinline__ void gemm_phase(PG8_LAS unsigned char* lds, const Gemm g, const Sched& S, const Epi& E) {
    int tid_ = threadIdx.x; asm volatile("" : "+v"(tid_)); const int tid = tid_, wid = __builtin_amdgcn_readfirstlane(tid >> 6), lane = tid & 63, wr = wid >> 2, wc = wid & 3, fr = lane & 15, fq = lane >> 4;
    int K_ = g.K; asm volatile("" : "+s"(K_)); const int K = K_, nt = K / BK;
    unsigned voffA[2], voffB[2];
#pragma unroll
    for (int i = 0; i < 2; ++i) { int R, C; stage_rc(tid * 16 + i * 8192, R, C); const int Rb = Epi::PERM ? ((R & ~31) + perm32(R & 31)) : R;
        voffA[i] = (unsigned)(R * K + C) * 2u; voffB[i] = (unsigned)(Rb * K + C) * 2u; }
    const size_t kstep = (size_t)(BK * 2);
    const size_t hstep = (size_t)HALF * K * 2;
    const size_t tstep = 2 * hstep;
    const unsigned ldsw = (unsigned)wid * 1024u;
    const int aoff = lds_byte(wr * 64 + fr, fq * 8), boff = lds_byte(wc * 32 + fr, fq * 8);
#define PG8_SA(b, h) (((b) * 2 + (h)) * HTB)
#define PG8_SB(b, h) ((4 + (b) * 2 + (h)) * HTB)
#define PG8_STAGE(bufoff, gbase, voff) do { _Pragma("unroll") for (int _i = 0; _i < 2; ++_i) \
        __builtin_amdgcn_global_load_lds((const unsigned*)((const char*)(gbase) + (voff)[_i]), (PG8_LAS unsigned*)(lds + (bufoff) + ldsw + _i * 8192), 16, 0, 0); } while (0)
#define PG8_LDA(dst, b, h) do { _Pragma("unroll") for (int m = 0; m < 4; ++m) _Pragma("unroll") for (int k = 0; k < 2; ++k) dst[m][k] = *(const PG8_LAS bf16x8*)(lds + PG8_SA(b, h) + aoff + m * 2048 + k * 1024); } while (0)
#define PG8_LDB(dst, b, h) do { _Pragma("unroll") for (int n = 0; n < 2; ++n) _Pragma("unroll") for (int k = 0; k < 2; ++k) dst[n][k] = *(const PG8_LAS bf16x8*)(lds + PG8_SB(b, h) + boff + n * 2048 + k * 1024); } while (0)
#define PG8_MMA(ai, bj, At, Bt) do { __builtin_amdgcn_s_setprio(1); _Pragma("unroll") for (int m = 0; m < 4; ++m) _Pragma("unroll") for (int n = 0; n < 2; ++n) _Pragma("unroll") for (int k = 0; k < 2; ++k) \
        acc[ai][bj][m][n] = __builtin_amdgcn_mfma_f32_16x16x32_bf16(Bt[n][k], At[m][k], acc[ai][bj][m][n], 0, 0, 0); __builtin_amdgcn_s_setprio(0); } while (0)
#define PG8_WAIT_V(n) asm volatile("s_waitcnt vmcnt(" #n ")" ::: "memory")
#define PG8_WAIT_L(n) asm volatile("s_waitcnt lgkmcnt(" #n ")" ::: "memory")
#define PG8_BAR __builtin_amdgcn_s_barrier()
#define PG8_SCHED __builtin_amdgcn_sched_barrier(0)
    Unit cur, nxt; int ui = 0;
    if (!S.next(0, cur)) return;
    f32x4 acc[2][2][4][2];
#pragma unroll
    for (int a = 0; a < 2; ++a)
#pragma unroll
        for (int b = 0; b < 2; ++b)
#pragma unroll
            for (int m = 0; m < 4; ++m)
#pragma unroll
                for (int n = 0; n < 2; ++n) acc[a][b][m][n] = (f32x4){0.f, 0.f, 0.f, 0.f};
    bf16x8 At[4][2], B0[2][2], B1[2][2];
    const char* cA = (const char*)g.A + (size_t)cur.pm * tstep; const char* cB = (const char*)g.Bt + (size_t)cur.pn * tstep;
    S.a_ready(cur);
    if constexpr (SP2) {
        PG8_STAGE(PG8_SB(0, 0), cB, voffB); PG8_STAGE(PG8_SB(0, 1), cB + hstep, voffB); PG8_STAGE(PG8_SA(0, 0), cA, voffA); PG8_STAGE(PG8_SA(0, 1), cA + hstep, voffA);
        if (wr == 1) PG8_BAR;
        PG8_WAIT_V(2); PG8_BAR;
        PG8_STAGE(PG8_SB(1, 0), cB + kstep, voffB); PG8_STAGE(PG8_SA(1, 0), cA + kstep, voffA); PG8_STAGE(PG8_SB(1, 1), cB + hstep + kstep, voffB);
        PG8_WAIT_V(6); PG8_BAR;
    } else {
        PG8_STAGE(PG8_SB(0, 0), cB, voffB); PG8_STAGE(PG8_SA(0, 0), cA, voffA); PG8_STAGE(PG8_SB(0, 1), cB + hstep, voffB); PG8_STAGE(PG8_SA(0, 1), cA + hstep, voffA);
        if (wr == 1) PG8_BAR;
        PG8_WAIT_V(4); PG8_BAR;
        PG8_STAGE(PG8_SB(1, 0), cB + kstep, voffB); PG8_STAGE(PG8_SA(1, 0), cA + kstep, voffA); PG8_STAGE(PG8_SB(1, 1), cB + hstep + kstep, voffB);
        PG8_WAIT_V(6); PG8_BAR;
    }
    for (;;) {
        const bool has_next = S.next(ui + 1, nxt);
        const char* nA = has_next ? (const char*)g.A + (size_t)nxt.pm * tstep : cA; const char* nB = has_next ? (const char*)g.Bt + (size_t)nxt.pn * tstep : cB;
        for (int t = 0; t < nt; t += 2) {
            const bool last = (t == nt - 2);
            const char* a1 = cA + (size_t)(t + 1) * kstep;
            const char* a2 = last ? nA : cA + (size_t)(t + 2) * kstep; const char* b2 = last ? nB : cB + (size_t)(t + 2) * kstep;
            const char* a3 = a2 + kstep; const char* b3 = b2 + kstep;
            if (last && has_next) S.a_ready(nxt);
            if constexpr (SP2) {
            PG8_LDB(B0, 0, 0); PG8_LDB(B1, 0, 1); PG8_SCHED; PG8_LDA(At, 0, 0); PG8_STAGE(PG8_SA(1, 1), a1 + hstep, voffA);
            PG8_WAIT_V(8); PG8_WAIT_L(0); PG8_BAR; PG8_MMA(0, 0, At, B0); PG8_MMA(0, 1, At, B1); PG8_BAR; PG8_SCHED;
            PG8_LDA(At, 0, 1); PG8_STAGE(PG8_SB(0, 0), b2, voffB); PG8_STAGE(PG8_SB(0, 1), b2 + hstep, voffB); PG8_STAGE(PG8_SA(0, 0), a2, voffA);
            PG8_WAIT_V(8); PG8_WAIT_L(0); PG8_BAR; PG8_MMA(1, 0, At, B0); PG8_MMA(1, 1, At, B1); PG8_BAR; PG8_SCHED;
            PG8_LDB(B0, 1, 0); PG8_LDB(B1, 1, 1); PG8_SCHED; PG8_LDA(At, 1, 0); PG8_STAGE(PG8_SA(0, 1), a2 + hstep, voffA);
            PG8_WAIT_V(8); PG8_WAIT_L(0); PG8_BAR; PG8_MMA(0, 0, At, B0); PG8_MMA(0, 1, At, B1); PG8_BAR; PG8_SCHED;
            PG8_LDA(At, 1, 1); PG8_STAGE(PG8_SB(1, 0), b3, voffB); PG8_STAGE(PG8_SB(1, 1), b3 + hstep, voffB); PG8_STAGE(PG8_SA(1, 0), a3, voffA);
            PG8_WAIT_V(8); PG8_WAIT_L(0); PG8_BAR; PG8_MMA(1, 0, At, B0); PG8_MMA(1, 1, At, B1); PG8_BAR; PG8_SCHED;
            } else {
            PG8_LDB(B0, 0, 0); PG8_SCHED; PG8_LDA(At, 0, 0); PG8_STAGE(PG8_SA(1, 1), a1 + hstep, voffA);
            PG8_WAIT_L(8); PG8_BAR; PG8_WAIT_L(0); PG8_MMA(0, 0, At, B0); PG8_BAR; PG8_SCHED;
            PG8_LDB(B1, 0, 1); PG8_STAGE(PG8_SB(0, 0), b2, voffB);
            PG8_BAR; PG8_WAIT_L(0); PG8_MMA(0, 1, At, B1); PG8_BAR;
            PG8_LDA(At, 0, 1); PG8_STAGE(PG8_SA(0, 0), a2, voffA);
            PG8_BAR; PG8_WAIT_L(0); PG8_MMA(1, 0, At, B0); PG8_BAR; PG8_SCHED;
            PG8_STAGE(PG8_SB(0, 1), b2 + hstep, voffB);
            PG8_WAIT_V(6); PG8_BAR; PG8_MMA(1, 1, At, B1); PG8_BAR;
            PG8_LDB(B0, 1, 0); PG8_SCHED; PG8_LDA(At, 1, 0); PG8_STAGE(PG8_SA(0, 1), a2 + hstep, voffA);
            PG8_WAIT_L(8); PG8_BAR; PG8_WAIT_L(0); PG8_MMA(0, 0, At, B0); PG8_BAR; PG8_SCHED;
            PG8_LDB(B1, 1, 1); PG8_STAGE(PG8_SB(1, 0), b3, voffB);
            PG8_BAR; PG8_WAIT_L(0); PG8_MMA(0, 1, At, B1); PG8_BAR;
            PG8_LDA(At, 1, 1); PG8_STAGE(PG8_SA(1, 0), a3, voffA);
            PG8_BAR; PG8_WAIT_L(0); PG8_MMA(1, 0, At, B0); PG8_BAR; PG8_SCHED;
            PG8_STAGE(PG8_SB(1, 1), b3 + hstep, voffB);
            PG8_WAIT_V(6); PG8_BAR; PG8_MMA(1, 1, At, B1); PG8_BAR;
            }
        }
        if constexpr (ALIGN_EPI) { if (wr == 0) PG8_BAR; }
        if constexpr (!Epi::AFTER_DRAIN) { E(acc, cur, wr, wc, fr, fq); S.done(cur); }
        if (!has_next) break;
#pragma unroll
        for (int a = 0; a < 2; ++a)
#pragma unroll
            for (int b = 0; b < 2; ++b)
#pragma unroll
                for (int m = 0; m < 4; ++m)
#pragma unroll
                    for (int n = 0; n < 2; ++n) acc[a][b][m][n] = (f32x4){0.f, 0.f, 0.f, 0.f};
        cur = nxt; cA = nA; cB = nB; ++ui;
        if constexpr (ALIGN_EPI) { if (wr == 1) PG8_BAR; }
    }
    PG8_WAIT_V(0);
    if constexpr (!ALIGN_EPI) { if (wr == 0) PG8_BAR; }
    PG8_BAR;
    if constexpr (Epi::AFTER_DRAIN) { E.fused(acc, cur, wr, wc, fr, fq, lds, wid, lane); S.done(cur); }
#undef PG8_SA
#undef PG8_SB
#undef PG8_STAGE
#undef PG8_LDA
#undef PG8_LDB
#undef PG8_MMA
#undef PG8_WAIT_V
#undef PG8_WAIT_L
#undef PG8_BAR
#undef PG8_SCHED
}
}

#define LAS __attribute__((address_space(3)))
typedef unsigned short bf16_t;
typedef short bf16x8 __attribute__((ext_vector_type(8)));
typedef float f32x4 __attribute__((ext_vector_type(4)));
typedef float f32x16 __attribute__((ext_vector_type(16)));
typedef unsigned u32x4 __attribute__((ext_vector_type(4)));
typedef unsigned u32x2 __attribute__((ext_vector_type(2)));
using pg8::cvtpk; using pg8::pack8; using pg8::unpack8;
constexpr int NTHREADS = 512, NWAVES = 8;
constexpr int MH = 16384, DM = 1024, SEQ = 4096, NB_H = 4, NLAYER = 4, NP1 = 7168, NV2 = 2048, PLE = 256, NHEAD = 8;
constexpr size_t MiB = 1u << 20;
constexpr size_t LW_IN = 0, LW_A = (size_t)9216 * 1024, LW_B = LW_A + 1048576, LW_O = LW_B + 1048576, LW_G = LW_O + 1048576, LW_P = LW_G + 1048576, LW_TOTAL = LW_P + 262144;
constexpr size_t WS_W = 1 * MiB, WS_PROJ = 108 * MiB, WS_VT2 = 332 * MiB, WS_X0 = 396 * MiB, WS_X1 = 428 * MiB, WS_BRA = 460 * MiB, WS_BRB = 492 * MiB, WS_PB = 524 * MiB, WS_S0 = 532 * MiB, WS_S1 = 533 * MiB, WS_END = 534 * MiB;
static_assert(WS_W + LW_TOTAL * 2 * NLAYER <= WS_PROJ, "weights fit");
constexpr int TMP_LD = NP1 / 2;
constexpr int LDS_BYTES = 147456;
constexpr float EPS = 1e-6f;

struct Args {
    const float *x, *p, *norm_g, *w_in, *a_ln_g, *a_ln_b, *a_ws, *a_bs, *lam_q, *lam_k, *subln_g, *w_a_out, *w_b_out, *w_o, *ple_norm_g, *w_ple, *w_ple_gate, *final_g;
    float* out; unsigned char* ws;
};

__device__ __forceinline__ float wave_sum(float v) {
#pragma unroll
    for (int o = 1; o < 64; o <<= 1) v += __shfl_xor(v, o);
    return v;
}
#define LDS_WAIT() asm volatile("s_waitcnt lgkmcnt(0)" ::: "memory")

__device__ __forceinline__ void tr_item(const float* W, int K, int N, const float* scale, bf16_t* WT, int dst_row0, LAS float* scr, int k0, int n0, int lane) {
    f32x4 v[8];
#pragma unroll
    for (int i = 0; i < 8; ++i) v[i] = *(const f32x4*)(W + (size_t)(k0 + 4 * i + (lane >> 4)) * N + n0 + (lane & 15) * 4);
#pragma unroll
    for (int i = 0; i < 8; ++i) { const int kk = 4 * i + (lane >> 4); f32x4 x = v[i]; if (scale) x = x * scale[k0 + kk]; *(LAS f32x4*)(scr + kk * 68 + (lane & 15) * 4) = x; }
    LDS_WAIT(); asm volatile("" ::: "memory");
    bf16_t* o = WT + (size_t)(dst_row0 + lane) * K + k0;
#pragma unroll
    for (int j = 0; j < 4; ++j) { const LAS float* s = scr + (8 * j) * 68 + lane;
        u32x4 w; w.x = cvtpk(s[0 * 68], s[1 * 68]); w.y = cvtpk(s[2 * 68], s[3 * 68]); w.z = cvtpk(s[4 * 68], s[5 * 68]); w.w = cvtpk(s[6 * 68], s[7 * 68]);
        *(u32x4*)(o + 8 * j) = w; }
    LDS_WAIT(); asm volatile("" ::: "memory");
}
typedef const __attribute__((address_space(4))) Args* cargs_t;
__device__ __forceinline__ void weights_prologue(cargs_t ap, LAS unsigned char* lds, int gw, int ngw, int wave, int lane) {
    LAS float* scr = (LAS float*)(lds + wave * 16384);
    bf16_t* WT = (bf16_t*)(ap->ws + WS_W);
    constexpr int I_IN = 32 * 144, I_SQ = 32 * 16, I_P = 8 * 16, I_L = I_IN + 4 * I_SQ + I_P;
    for (int it = gw; it < I_L * NLAYER; it += ngw) {
        const int l = it / I_L; int r = it % I_L; bf16_t* wl = WT + (size_t)l * LW_TOTAL;
        if (r < I_IN) { const int kb = r / 144, nb = r % 144, n0 = nb * 64; const int osec = n0 >> 10;
            const int nsec = (int)((0x654832170ull >> (4 * osec)) & 0xFull);
            tr_item(ap->w_in + (size_t)l * 1024 * 9216, 1024, 9216, ap->norm_g + l * 1024, wl + LW_IN, nsec * 1024 + (n0 & 1023), scr, kb * 32, n0, lane);
            continue; }
        r -= I_IN;
        if (r < 4 * I_SQ) { const int which = r / I_SQ; const int rr = r % I_SQ; const int kb = rr / 16, nb = rr % 16;
            const float* src = which == 0 ? ap->w_a_out : which == 1 ? ap->w_b_out : which == 2 ? ap->w_o : ap->w_ple_gate;
            const size_t off = which == 0 ? LW_A : which == 1 ? LW_B : which == 2 ? LW_O : LW_G;
            tr_item(src + (size_t)l * 1048576, 1024, 1024, which == 3 ? ap->ple_norm_g + l * 1024 : nullptr, wl + off, nb * 64, scr, kb * 32, nb * 64, lane);
            continue; }
        r -= 4 * I_SQ;
        { const int kb = r / 16, nb = r % 16; tr_item(ap->w_ple + (size_t)l * 262144, 256, 1024, nullptr, wl + LW_P, nb * 64, scr, kb * 32, nb * 64, lane); }
    }
}

__device__ __forceinline__ void init_rows(const float* x, bf16_t* XB, float* S, int gw, int ngw, int lane) {
    asm volatile("" : "+v"(lane)); asm volatile("" : "+s"(gw));
    for (int m = gw; m < MH; m += ngw) {
        const f32x4* xr = (const f32x4*)(x + (size_t)m * DM) + lane; float s = 0.f; f32x4 v[4];
#pragma unroll
        for (int j = 0; j < 4; ++j) { v[j] = xr[64 * j]; s += (v[j][0] * v[j][0] + v[j][1] * v[j][1]) + (v[j][2] * v[j][2] + v[j][3] * v[j][3]); }
        s = wave_sum(s);
        u32x2* o = (u32x2*)(XB + (size_t)m * DM) + lane;
#pragma unroll
        for (int j = 0; j < 4; ++j) { u32x2 w; w.x = cvtpk(v[j][0], v[j][1]); w.y = cvtpk(v[j][2], v[j][3]); o[64 * j] = w; }
        if (lane < 16) S[(size_t)m * 16 + lane] = lane == 0 ? s : 0.f;
    }
}
__device__ __forceinline__ void final_rows(float* out, const float* g, int gw, int ngw, int lane) {
    asm volatile("" : "+v"(lane)); asm volatile("" : "+s"(gw));
    for (int m = gw; m < MH; m += ngw) {
        f32x4* xr = (f32x4*)(out + (size_t)m * DM) + lane; float s = 0.f; f32x4 v[4];
#pragma unroll
        for (int j = 0; j < 4; ++j) { v[j] = xr[64 * j]; s += (v[j][0] * v[j][0] + v[j][1] * v[j][1]) + (v[j][2] * v[j][2] + v[j][3] * v[j][3]); }
        const float rs = rsqrtf(wave_sum(s) * (1.0f / DM) + EPS);
#pragma unroll
        for (int j = 0; j < 4; ++j) { const f32x4 gg = ((const f32x4*)g)[64 * j + lane]; xr[64 * j] = v[j] * rs * gg; }
    }
}
__device__ __forceinline__ void convert_p(const float* p, bf16_t* PB, int gtid, int nthr) {
    asm volatile("" : "+v"(gtid));
    for (int i = gtid; i < MH * PLE / 8; i += nthr) { const f32x4 a = ((const f32x4*)p)[2 * i], b = ((const f32x4*)p)[2 * i + 1]; ((u32x4*)PB)[i] = pack8(a, b); }
}

__device__ __forceinline__ void gmlp_unit(LAS unsigned char* lds, const bf16_t* PROJ, const bf16_t* VT2, bf16_t* BRA, const float* lng, const float* lnb, const float* ws, const float* bs, int c, int gh) {
    int tid_ = threadIdx.x; asm volatile("" : "+v"(tid_)); const int tid = tid_, lane = tid & 63, l32 = lane & 31, hi = lane >> 5; const int w = __builtin_amdgcn_readfirstlane(tid >> 6);
    const int tok0 = c * 128;
    LAS float* red = (LAS float*)lds;
    LAS float* stat = (LAS float*)(lds + 32768);
    LAS unsigned char* T = lds + 34816;
    LAS float* LG = (LAS float*)(lds + 139264); LAS float* LB = LG + 512;
    LG[tid] = lng[gh * 512 + tid]; LB[tid] = lnb[gh * 512 + tid];
    { const int sc = tid & 15, rg = tid >> 4; float s[8], q[8];
#pragma unroll
      for (int j = 0; j < 8; ++j) { s[j] = 0.f; q[j] = 0.f; }
#pragma unroll 8
      for (int i = 0; i < 32; ++i) { const u32x4 wv = *(const u32x4*)(VT2 + (size_t)(rg + 32 * i) * MH + tok0 + sc * 8); f32x4 a, b; unpack8(wv, a, b);
#pragma unroll
          for (int j = 0; j < 4; ++j) { s[j] += a[j]; q[j] += a[j] * a[j]; s[4 + j] += b[j]; q[4 + j] += b[j] * b[j]; } }
#pragma unroll
      for (int j = 0; j < 8; ++j) { red[rg * 256 + sc * 8 + j] = s[j]; red[rg * 256 + 128 + sc * 8 + j] = q[j]; } }
    __syncthreads();
    if (tid < 128) { float s = 0.f, q = 0.f;
        for (int i = 0; i < 32; ++i) { s += red[i * 256 + tid]; q += red[i * 256 + 128 + tid]; }
        const float mean = s * (1.0f / 1024.0f); const float var = q * (1.0f / 1024.0f) - mean * mean;
        stat[2 * tid] = mean; stat[2 * tid + 1] = rsqrtf(var + EPS); }
    __syncthreads();
    const int tb = w & 3, dh = w >> 2;
    u32x4 pre[4];
#pragma unroll
    for (int i = 0; i < 4; ++i) { const int p = tid + 512 * i; pre[i] = *(const u32x4*)(VT2 + (size_t)(gh * 512 + (p >> 4)) * MH + tok0 + (p & 15) * 8); }
    for (int gi = 0; gi < 4; ++gi) { const int g = gh * 4 + gi;
#pragma unroll
        for (int i = 0; i < 4; ++i) { const int p = tid + 512 * i, d = p >> 4, sc = p & 15;
            f32x4 a, b; unpack8(pre[i], a, b);
            const float gg = LG[gi * 128 + d], bb = LB[gi * 128 + d];
#pragma unroll
            for (int j = 0; j < 4; ++j) { a[j] = (a[j] - stat[2 * (sc * 8 + j)]) * stat[2 * (sc * 8 + j) + 1] * gg + bb; b[j] = (b[j] - stat[2 * (sc * 8 + 4 + j)]) * stat[2 * (sc * 8 + 4 + j) + 1] * gg + bb; }
            *(LAS u32x4*)(T + d * 272 + sc * 16) = pack8(a, b); }
        if (gi < 3) {
#pragma unroll
            for (int i = 0; i < 4; ++i) { const int p = tid + 512 * i; pre[i] = *(const u32x4*)(VT2 + (size_t)((g + 1) * 128 + (p >> 4)) * MH + tok0 + (p & 15) * 8); } }
        const float* wrow = ws + (size_t)g * 16384 + (size_t)(32 * tb + l32) * 128 + 8 * hi;
        const int trow = 32 * tb + l32;
        f32x4 wa[8], wb[8];
#pragma unroll
        for (int ks = 0; ks < 8; ++ks) if (ks < 2 * tb + 2) { wa[ks] = *(const f32x4*)(wrow + 16 * ks); wb[ks] = *(const f32x4*)(wrow + 16 * ks + 4); }
        float bv[16];
#pragma unroll
        for (int r = 0; r < 16; ++r) bv[r] = bs[g * 128 + 32 * tb + (r & 3) + 8 * (r >> 2) + 4 * hi];
        u32x4 uq[4], zq[4];
#pragma unroll
        for (int i = 0; i < 4; ++i) { const int p = tid + 512 * i; const bf16_t* up = PROJ + (size_t)(tok0 + (p >> 4)) * NP1 + g * 128 + (p & 15) * 8; uq[i] = *(const u32x4*)up; zq[i] = *(const u32x4*)(up + 1024); }
        __syncthreads();
        f32x16 acc0 = {}, acc1 = {};
#pragma unroll
        for (int ks = 0; ks < 8; ++ks) if (ks < 2 * tb + 2) { const int s0 = 16 * ks + 8 * hi; f32x4 a_ = wa[ks], b_ = wb[ks];
#pragma unroll
            for (int j = 0; j < 4; ++j) { if (s0 + j > trow) a_[j] = 0.f; if (s0 + 4 + j > trow) b_[j] = 0.f; }
            const bf16x8 A = __builtin_bit_cast(bf16x8, pack8(a_, b_));
            const bf16x8 B0 = *(const LAS bf16x8*)(T + (64 * dh + l32) * 272 + (16 * ks + 8 * hi) * 2);
            const bf16x8 B1 = *(const LAS bf16x8*)(T + (64 * dh + 32 + l32) * 272 + (16 * ks + 8 * hi) * 2);
            acc0 = __builtin_amdgcn_mfma_f32_32x32x16_bf16(A, B0, acc0, 0, 0, 0);
            acc1 = __builtin_amdgcn_mfma_f32_32x32x16_bf16(A, B1, acc1, 0, 0, 0);
        }
        LAS float* Yb = (LAS float*)(lds + 71680);
#pragma unroll
        for (int r = 0; r < 16; ++r) { const int t = 32 * tb + (r & 3) + 8 * (r >> 2) + 4 * hi;
            Yb[t * 132 + 64 * dh + l32] = acc0[r] + bv[r]; Yb[t * 132 + 64 * dh + 32 + l32] = acc1[r] + bv[r]; }
        __syncthreads();
#pragma unroll
        for (int i = 0; i < 4; ++i) { const int p = tid + 512 * i, t = p >> 4, c8 = p & 15; const size_t tok = (size_t)(tok0 + t); const int col = g * 128 + c8 * 8;
            f32x4 u0, u1, z0, z1; unpack8(uq[i], u0, u1); unpack8(zq[i], z0, z1);
            const f32x4 y0 = *(const LAS f32x4*)(Yb + t * 132 + c8 * 8), y1 = *(const LAS f32x4*)(Yb + t * 132 + c8 * 8 + 4);
            *(u32x4*)(BRA + tok * DM + col) = pack8(u0 * y0 * z0, u1 * y1 * z1); }
        __syncthreads();
    }
}

constexpr int AT_KS = 17408, AT_VS = 18432, AT_VOFF = 2 * AT_KS;
__device__ __forceinline__ void attn_unit(LAS unsigned char* lds, const bf16_t* PROJ, const bf16_t* VT2, bf16_t* BRB, const float* subg, float lam, float lam_init, int b, int h, int qb) {
    int tid_ = threadIdx.x; asm volatile("" : "+v"(tid_)); const int tid = tid_, lane = tid & 63, l32 = lane & 31, hi = lane >> 5; const int w = __builtin_amdgcn_readfirstlane(tid >> 6); const int map = w >> 2, wq = w & 3;
    const int rowbase = b * SEQ, q0 = qb * 128, myq = q0 + wq * 32 + l32, NT = 2 * qb + 2;
    LAS float* SG = (LAS float*)(lds + 143360); if (tid < 128) SG[tid] = subg[tid];
    bf16x8 qf[4];
    { const bf16_t* qp = PROJ + (size_t)(rowbase + myq) * NP1 + 2048 + h * 128 + map * 64 + hi * 8;
#pragma unroll
      for (int ks = 0; ks < 4; ++ks) qf[ks] = *(const bf16x8*)(qp + ks * 16); }
    const bf16_t* ksrc[2]; const bf16_t* vsrc[2]; int kdst[2], vdst[2];
#pragma unroll
    for (int i = 0; i < 2; ++i) { const int p = tid + 512 * i;
        ksrc[i] = PROJ + (size_t)(rowbase + (p >> 4)) * NP1 + 3072 + h * 128 + (p & 15) * 8; kdst[i] = (p >> 4) * 272 + (p & 15) * 16;
        vsrc[i] = VT2 + (size_t)(1024 + h * 128 + (p >> 3)) * MH + rowbase + (p & 7) * 8; vdst[i] = AT_VOFF + (p >> 3) * 144 + (((p & 7) >> 1) * 16 + (p & 1) * 4) * 2; }
    u32x4 kr[2], vr[2];
#pragma unroll
    for (int i = 0; i < 2; ++i) { kr[i] = *(const u32x4*)(ksrc[i]); vr[i] = *(const u32x4*)(vsrc[i]); }
#pragma unroll
    for (int i = 0; i < 2; ++i) { *(LAS u32x4*)(lds + kdst[i]) = kr[i]; *(LAS u32x2*)(lds + vdst[i]) = (u32x2){vr[i].x, vr[i].y}; *(LAS u32x2*)(lds + vdst[i] + 16) = (u32x2){vr[i].z, vr[i].w}; }
    __syncthreads();
    f32x16 O[4]; O[0] = f32x16{}; O[1] = f32x16{}; O[2] = f32x16{}; O[3] = f32x16{};
    float m_run = -1e30f, l_run = 0.f;
    for (int t = 0; t < NT; ++t) {
        const int buf = t & 1, kv0 = 64 * t;
        if (t + 1 < NT) {
#pragma unroll
            for (int i = 0; i < 2; ++i) { kr[i] = *(const u32x4*)(ksrc[i] + (size_t)(kv0 + 64) * NP1); vr[i] = *(const u32x4*)(vsrc[i] + kv0 + 64); } }
        if (kv0 <= q0 + wq * 32 + 31) {
            LAS unsigned char* Kb = lds + buf * AT_KS + l32 * 272 + map * 128 + hi * 16;
            LAS unsigned char* Vb = lds + AT_VOFF + buf * AT_VS + l32 * 144 + hi * 16;
            f32x16 S0 = {}, S1 = {};
            { bf16x8 kf[8];
#pragma unroll
              for (int ks = 0; ks < 4; ++ks) { kf[2 * ks] = *(const LAS bf16x8*)(Kb + ks * 32); kf[2 * ks + 1] = *(const LAS bf16x8*)(Kb + 32 * 272 + ks * 32); }
              __builtin_amdgcn_sched_barrier(0);
#pragma unroll
              for (int ks = 0; ks < 4; ++ks) { S0 = __builtin_amdgcn_mfma_f32_32x32x16_bf16(kf[2 * ks], qf[ks], S0, 0, 0, 0); S1 = __builtin_amdgcn_mfma_f32_32x32x16_bf16(kf[2 * ks + 1], qf[ks], S1, 0, 0, 0); } }
            u32x4 va[8], vb[8];
#pragma unroll
            for (int j = 0; j < 2; ++j)
#pragma unroll
                for (int db = 0; db < 4; ++db) va[j * 4 + db] = *(const LAS u32x4*)(Vb + db * 32 * 144 + j * 32);
            __builtin_amdgcn_sched_barrier(0);
            if (t >= NT - 2) {
#pragma unroll
                for (int r = 0; r < 16; ++r) { const int kv = kv0 + (r & 3) + 8 * (r >> 2) + 4 * hi; if (kv > myq) S0[r] = -1e30f; if (kv + 32 > myq) S1[r] = -1e30f; } }
            float mx = __builtin_fmaxf(__builtin_fmaxf(S0[0], S1[0]), __builtin_fmaxf(S0[1], S1[1]));
#pragma unroll
            for (int r = 2; r < 16; r += 2) { mx = __builtin_fmaxf(__builtin_fmaxf(mx, S0[r]), S1[r]); mx = __builtin_fmaxf(__builtin_fmaxf(mx, S0[r + 1]), S1[r + 1]); }
            if (__any(mx > m_run + 8.0f)) { mx = fmaxf(mx, __shfl_xor(mx, 32)); const float mnew = fmaxf(m_run, mx), alpha = __builtin_amdgcn_exp2f(m_run - mnew); m_run = mnew; l_run *= alpha;
#pragma unroll
                for (int db = 0; db < 4; ++db)
#pragma unroll
                    for (int r = 0; r < 16; ++r) O[db][r] *= alpha; }
            pg8::f32x2 ps2 = {0.f, 0.f};
#pragma unroll
            for (int r = 0; r < 16; r += 2) { S0[r] = __builtin_amdgcn_exp2f(S0[r] - m_run); S0[r + 1] = __builtin_amdgcn_exp2f(S0[r + 1] - m_run); ps2 += (pg8::f32x2){S0[r], S0[r + 1]}; }
            bf16x8 pf[4];
#pragma unroll
            for (int j = 0; j < 2; ++j) { u32x4 pw;
#pragma unroll
                for (int i = 0; i < 4; ++i) pw[i] = cvtpk(S0[8 * j + 2 * i], S0[8 * j + 2 * i + 1]);
                pf[j] = __builtin_bit_cast(bf16x8, pw); }
#pragma unroll
            for (int j = 2; j < 4; ++j)
#pragma unroll
                for (int db = 0; db < 4; ++db) vb[(j - 2) * 4 + db] = *(const LAS u32x4*)(Vb + db * 32 * 144 + j * 32);
            __builtin_amdgcn_sched_barrier(0);
#pragma unroll
            for (int j = 0; j < 2; ++j)
#pragma unroll
                for (int db = 0; db < 4; ++db) O[db] = __builtin_amdgcn_mfma_f32_32x32x16_bf16(__builtin_bit_cast(bf16x8, va[j * 4 + db]), pf[j], O[db], 0, 0, 0);
#pragma unroll
            for (int r = 0; r < 16; r += 2) { S1[r] = __builtin_amdgcn_exp2f(S1[r] - m_run); S1[r + 1] = __builtin_amdgcn_exp2f(S1[r + 1] - m_run); ps2 += (pg8::f32x2){S1[r], S1[r + 1]}; }
#pragma unroll
            for (int j = 2; j < 4; ++j) { u32x4 pw;
#pragma unroll
                for (int i = 0; i < 4; ++i) pw[i] = cvtpk(S1[8 * (j & 1) + 2 * i], S1[8 * (j & 1) + 2 * i + 1]);
                pf[j] = __builtin_bit_cast(bf16x8, pw); }
#pragma unroll
            for (int k = 0; k < 8; ++k) { __builtin_amdgcn_sched_group_barrier(0x008, 1, 0); __builtin_amdgcn_sched_group_barrier(0x002, 6, 0); }
            __builtin_amdgcn_sched_barrier(0);
            l_run += ps2.x + ps2.y;
#pragma unroll
            for (int j = 2; j < 4; ++j)
#pragma unroll
                for (int db = 0; db < 4; ++db) O[db] = __builtin_amdgcn_mfma_f32_32x32x16_bf16(__builtin_bit_cast(bf16x8, vb[(j - 2) * 4 + db]), pf[j], O[db], 0, 0, 0);
        }
        if (t + 1 < NT) {
#pragma unroll
            for (int i = 0; i < 2; ++i) { *(LAS u32x4*)(lds + (buf ^ 1) * AT_KS + kdst[i]) = kr[i]; *(LAS u32x2*)(lds + (buf ^ 1) * AT_VS + vdst[i]) = (u32x2){vr[i].x, vr[i].y}; *(LAS u32x2*)(lds + (buf ^ 1) * AT_VS + vdst[i] + 16) = (u32x2){vr[i].z, vr[i].w}; } }
        __syncthreads();
    }
    u32x4 zq[4];
#pragma unroll
    for (int i = 0; i < 4; ++i) { const int p = tid + 512 * i; zq[i] = *(const u32x4*)(PROJ + (size_t)(rowbase + q0 + (p >> 4)) * NP1 + 4096 + h * 128 + (p & 15) * 8); }
    const float inv = 1.0f / (l_run + __shfl_xor(l_run, 32));
    LAS float* X = (LAS float*)lds + wq * 4096 + lane;
    if (map == 1) { const float sc = -lam * inv;
#pragma unroll
        for (int db = 0; db < 4; ++db)
#pragma unroll
            for (int r = 0; r < 16; ++r) X[(db * 16 + r) * 64] = O[db][r] * sc; }
    __syncthreads();
    if (map == 0) { float ss = 0.f;
#pragma unroll
        for (int db = 0; db < 4; ++db)
#pragma unroll
            for (int r = 0; r < 16; ++r) { const float o = O[db][r] * inv + X[(db * 16 + r) * 64]; O[db][r] = o; ss += o * o; }
        ss += __shfl_xor(ss, 32);
        const float rs = rsqrtf(ss * (1.0f / 128.0f) + EPS) * (1.0f - lam_init);
        LAS float* Zr = (LAS float*)(lds + 65536) + (wq * 32 + l32) * 132;
#pragma unroll
        for (int db = 0; db < 4; ++db)
#pragma unroll
            for (int rg = 0; rg < 4; ++rg) { const int d = 32 * db + 8 * rg + 4 * hi; const f32x4 gg = *(const LAS f32x4*)(SG + d);
                *(LAS f32x4*)(Zr + d) = (f32x4){O[db][4 * rg] * rs * gg[0], O[db][4 * rg + 1] * rs * gg[1], O[db][4 * rg + 2] * rs * gg[2], O[db][4 * rg + 3] * rs * gg[3]}; } }
    __syncthreads();
#pragma unroll
    for (int i = 0; i < 4; ++i) { const int p = tid + 512 * i, q = p >> 4, c8 = p & 15; const size_t row = (size_t)(rowbase + q0 + q);
        f32x4 z0, z1; unpack8(zq[i], z0, z1);
        const LAS float* zp = (const LAS float*)(lds + 65536) + q * 132 + c8 * 8;
        const f32x4 v0 = *(const LAS f32x4*)zp, v1 = *(const LAS f32x4*)(zp + 4);
        *(u32x4*)(BRB + row * DM + h * 128 + c8 * 8) = pack8(v0 * z0, v1 * z1); }
    __syncthreads();
}

#define RLX_AGENT __ATOMIC_RELAXED, __HIP_MEMORY_SCOPE_AGENT
#define XB_TMO      128
#define XB_XCNT(j)  (256  + 64 * (j))
#define XB_XSUB(j)  (1280 + 64 * (j))
#define XB_XGEN(j)  (2304 + 64 * (j))
#define XB_TOP      3328
#define XB_TOPGEN   3392
#define XCD_BAR_WORDS 3456
#define XB_SPIN_CAP (1u << 18)

__device__ __forceinline__ unsigned xb_ld(unsigned* p)              { return __hip_atomic_load(p, __ATOMIC_RELAXED, __HIP_MEMORY_SCOPE_AGENT); }
__device__ __forceinline__ unsigned xb_add(unsigned* p, unsigned v) { return __hip_atomic_fetch_add(p, v, __ATOMIC_RELAXED, __HIP_MEMORY_SCOPE_AGENT); }
__device__ __forceinline__ unsigned xb_xcc_id() { return (unsigned)__builtin_amdgcn_s_getreg((3 << 11) | 20) & 0xFu; }
#define XB_SPIN(cond, bar) do { unsigned _sp = 0; while (cond) { __builtin_amdgcn_s_sleep(1); \
    if ((++_sp & 255u) == 0u) { if (xb_ld(&(bar)[XB_TMO])) break; if (_sp > XB_SPIN_CAP) { atomicAdd(&(bar)[XB_TMO], 1u); break; } } } } while (0)

struct XcdBarrier {
    unsigned* bar; unsigned x;
    volatile LAS unsigned* st;
};

__device__ __forceinline__ XcdBarrier xcd_barrier_post(unsigned* bar, volatile LAS unsigned* st) {
    XcdBarrier b; b.bar = bar; b.x = xb_xcc_id(); b.st = st;
    if (threadIdx.x == 0) (void)xb_add(&bar[XB_XCNT(b.x)], 1u);
    return b;
}
__device__ __forceinline__ void xcd_barrier_complete(unsigned* bar, unsigned x, unsigned& nloc, unsigned& nx) {
    const unsigned G = gridDim.x * gridDim.y * gridDim.z;
    unsigned sum, cnt, mine, sp = 0u;
    for (;;) {
        sum = 0u; cnt = 0u; mine = 0u;
#pragma unroll
        for (unsigned j = 0; j < 16; ++j) { const unsigned c = xb_ld(&bar[XB_XCNT(j)]); sum += c; cnt += (c > 0u) ? 1u : 0u; mine = (j == x) ? c : mine; }
        if (sum == G) break;
        __builtin_amdgcn_s_sleep(1);
        if ((++sp & 255u) == 0u) { if (xb_ld(&bar[XB_TMO])) break; if (sp > XB_SPIN_CAP) { atomicAdd(&bar[XB_TMO], 1u); break; } }
    }
    nloc = mine > 0u ? mine : 1u; nx = cnt > 0u ? cnt : 1u;
}

__device__ __forceinline__ void xcd_barrier(const XcdBarrier& b) {
    asm volatile("s_waitcnt vmcnt(0)" ::: "memory");
    __syncthreads();
    if (threadIdx.x == 0) {
        unsigned* bar = b.bar;
        __builtin_amdgcn_s_waitcnt(0);
        unsigned nloc = b.st[0], nx = b.st[1];
        if (nloc == 0u) { xcd_barrier_complete(bar, b.x, nloc, nx); b.st[0] = nloc; b.st[1] = nx; }
        const unsigned old = xb_add(&bar[XB_XSUB(b.x)], 1u);
        const unsigned gen = old / nloc;
        if (old + 1u == (gen + 1u) * nloc) {
            __builtin_amdgcn_fence(__ATOMIC_RELEASE, "agent");
            asm volatile("s_waitcnt vmcnt(0)" ::: "memory");
            const unsigned og = xb_add(&bar[XB_TOP], 1u);
            const unsigned tg = og / nx;
            if (og + 1u == (tg + 1u) * nx) xb_add(&bar[XB_TOPGEN], 1u);
            else XB_SPIN(xb_ld(&bar[XB_TOPGEN]) == tg, bar);
            __builtin_amdgcn_fence(__ATOMIC_ACQUIRE, "agent");
            xb_add(&bar[XB_XGEN(b.x)], 1u);
            asm volatile("s_waitcnt vmcnt(0)" ::: "memory");
        } else {
            XB_SPIN(xb_ld(&bar[XB_XGEN(b.x)]) == gen, bar);
            __builtin_amdgcn_fence(__ATOMIC_ACQUIRE, "agent");
            asm volatile("s_waitcnt vmcnt(0)" ::: "memory");
        }
    }
    __syncthreads();
}


__global__ void __launch_bounds__(NTHREADS, 2) mega_fwd(Args a_unused) {
    extern __shared__ __attribute__((aligned(16))) unsigned char lds_raw[];
    LAS unsigned char* lds = (LAS unsigned char*)lds_raw;
    cg::grid_group grid = cg::this_grid();
    const int tid = threadIdx.x, lane = tid & 63, wave = __builtin_amdgcn_readfirstlane(tid >> 6);
    const int G = gridDim.x, bx = blockIdx.x;
    const int vcu = (G % 8 == 0) ? (bx % 8) * (G / 8) + bx / 8 : bx;
    const int gw = vcu * NWAVES + wave, ngw = G * NWAVES;
#define ARGS() cargs_t ap = (cargs_t)__builtin_amdgcn_kernarg_segment_ptr(); asm volatile("" : "+s"(ap)); unsigned char* const ws = ap->ws
#define GSYNC() xcd_barrier(xbar)
#define WSP(T, off) ((T*)(ws + (off)))
#define XBP(ci) ((bf16_t*)(ws + ((ci) ? WS_X1 : WS_X0)))
#define SXP(ci) ((float*)(ws + ((ci) ? WS_S1 : WS_S0)))
#define TMPP ((float*)(ws + WS_PROJ + 4096))
    if (tid < 64) ((LAS unsigned*)(lds + 147200))[tid] = 0u;
    __syncthreads();
    grid.sync();
    XcdBarrier xbar;
    { ARGS(); xbar = xcd_barrier_post((unsigned*)ws, (volatile LAS unsigned*)(lds + 147200)); }
    { ARGS(); weights_prologue(ap, lds, gw, ngw, wave, lane); }

#define DUMP_BF16(buf_off, nelem) do { ARGS(); const bf16_t* B_ = WSP(bf16_t, buf_off); float* o_ = ap->out; \
    for (size_t i_ = (size_t)bx * NTHREADS + tid; i_ < (size_t)2 * MH * DM; i_ += (size_t)G * NTHREADS) o_[i_] = __uint_as_float((unsigned)B_[i_ % (size_t)(nelem)] << 16); } while (0)
    for (int hf = 0; hf < 2; ++hf) {
        { ARGS(); init_rows(ap->x + (size_t)hf * MH * DM, XBP(0), SXP(0), gw, ngw, lane); }
        GSYNC();
        int c = 0;
        for (int l = 0; l < NLAYER; ++l) {
            { ARGS(); convert_p(ap->p + ((size_t)l * 2 * MH + (size_t)hf * MH) * PLE, WSP(bf16_t, WS_PB), bx * NTHREADS + tid, G * NTHREADS); }
            int rbase;
            { ARGS(); rbase = 2048 * (bx & 7);
              LAS float* rt = (LAS float*)(lds + 131072); const float* Sx = SXP(c);
              int t_ = threadIdx.x; asm volatile("" : "+v"(t_));
#pragma unroll
              for (int i = 0; i < 4; ++i) { const int r = t_ + 512 * i; const f32x4* p = (const f32x4*)(Sx + (size_t)(rbase + r) * 16); const f32x4 q = (p[0] + p[1]) + (p[2] + p[3]);
                  rt[r] = rsqrtf(((q[0] + q[1]) + (q[2] + q[3])) * (1.0f / 1024.0f) + EPS); }
              __syncthreads(); }
#if !defined(ONLY) || ONLY == 0
            { ARGS(); const bf16_t* wl = WSP(bf16_t, WS_W) + (size_t)l * LW_TOTAL;
              pg8::Gemm g{XBP(c), wl + LW_IN, MH, NP1, DM}; pg8::StaticOrder S; S.init(MH, NP1, G, bx);
              pg8::Epi E{0, WSP(bf16_t, WS_PROJ), NP1, nullptr, 0, nullptr, 0, nullptr, SXP(c), nullptr, nullptr, nullptr, (const LAS float*)(lds + 131072), rbase};
              pg8::gemm_phase<pg8::Epi, pg8::StaticOrder, true, true>(lds, g, S, E); }
#endif
#if !defined(ONLY) || ONLY == 1
            { ARGS(); const bf16_t* wl = WSP(bf16_t, WS_W) + (size_t)l * LW_TOTAL;
              pg8::Gemm g{wl + LW_IN + (size_t)NP1 * DM, XBP(c), NV2, MH, DM}; pg8::StaticOrder S; S.init(NV2, MH, G, bx);
              pg8::Epi E{1, WSP(bf16_t, WS_VT2), MH, nullptr, 0, nullptr, 0, nullptr, SXP(c), nullptr, nullptr, nullptr, (const LAS float*)(lds + 131072), rbase};
              pg8::gemm_phase<pg8::Epi, pg8::StaticOrder, true, true>(lds, g, S, E); }
#endif
            GSYNC();
#if defined(STOP_AFTER) && STOP_AFTER == 1
            DUMP_BF16(WS_PROJ, (size_t)MH * NP1); return;
#endif
#if defined(STOP_AFTER) && STOP_AFTER == 11
            DUMP_BF16(WS_VT2, (size_t)MH * NV2); return;
#endif
#ifndef NO_GMLP
            { ARGS();
              for (int u = vcu; u < 256; u += G)
                gmlp_unit(lds, WSP(bf16_t, WS_PROJ), WSP(bf16_t, WS_VT2), WSP(bf16_t, WS_BRA), ap->a_ln_g + l * 1024, ap->a_ln_b + l * 1024, ap->a_ws + (size_t)l * 131072, ap->a_bs + l * 1024, u >> 1, u & 1); }
#endif
#ifdef NO_ATTN
            { ARGS(); const bf16_t* PR = WSP(bf16_t, WS_PROJ); bf16_t* B = WSP(bf16_t, WS_BRB);
              for (int i = bx * NTHREADS + tid; i < MH * DM / 8; i += G * NTHREADS) { const int row = i >> 7, c8 = i & 127; *(u32x4*)(B + (size_t)row * DM + c8 * 8) = *(const u32x4*)(PR + (size_t)row * NP1 + 4096 + c8 * 8); } }
#endif
#ifdef NO_GMLP
            { ARGS(); const bf16_t* PR = WSP(bf16_t, WS_PROJ); bf16_t* B = WSP(bf16_t, WS_BRA);
              for (int i = bx * NTHREADS + tid; i < MH * DM / 8; i += G * NTHREADS) { const int row = i >> 7, c8 = i & 127; *(u32x4*)(B + (size_t)row * DM + c8 * 8) = *(const u32x4*)(PR + (size_t)row * NP1 + c8 * 8); } }
#endif
#ifndef NO_ATTN
            { ARGS();
              const float lam_init = 0.8f - 0.6f * expf(-0.3f * (float)l);
              const float d0 = wave_sum(ap->lam_q[l * 128 + lane] * ap->lam_k[l * 128 + lane]), d1 = wave_sum(ap->lam_q[l * 128 + 64 + lane] * ap->lam_k[l * 128 + 64 + lane]);
              const float lam = expf(d0) - expf(d1) + lam_init;
              for (int pu = vcu; pu < 512; pu += G) { const int bh = pu >> 4, s = pu & 15;
                  attn_unit(lds, WSP(bf16_t, WS_PROJ), WSP(bf16_t, WS_VT2), WSP(bf16_t, WS_BRB), ap->subln_g + l * 128, lam, lam_init, bh >> 3, bh & 7, 31 - s);
                  attn_unit(lds, WSP(bf16_t, WS_PROJ), WSP(bf16_t, WS_VT2), WSP(bf16_t, WS_BRB), ap->subln_g + l * 128, lam, lam_init, bh >> 3, bh & 7, s); } }
#endif
            GSYNC();
#if !defined(ONLY) || ONLY == 2
            { ARGS(); const bf16_t* wl = WSP(bf16_t, WS_W) + (size_t)l * LW_TOTAL;
              pg8::Gemm g{WSP(bf16_t, WS_BRA), wl + LW_A, MH, DM, DM}; pg8::StaticOrder S; S.init(MH, DM, G, bx);
              pg8::Epi E{2, WSP(bf16_t, WS_PROJ) + 2048, NP1, nullptr, 0, nullptr, 0, WSP(bf16_t, WS_PROJ) + 5120, nullptr, nullptr, nullptr, nullptr, nullptr, 0};
              pg8::gemm_phase<pg8::Epi, pg8::StaticOrder, true, true>(lds, g, S, E); }
#endif
#if !defined(ONLY) || ONLY == 3
            { ARGS(); const bf16_t* wl = WSP(bf16_t, WS_W) + (size_t)l * LW_TOTAL;
              pg8::Gemm g{WSP(bf16_t, WS_BRB), wl + LW_B, MH, DM, DM}; pg8::StaticOrder S; S.init(MH, DM, G, bx);
              pg8::Epi E{3, XBP(1 - c), DM, nullptr, 0, nullptr, 0, WSP(bf16_t, WS_PROJ) + 6144, nullptr, nullptr, WSP(bf16_t, WS_PROJ) + 2048, nullptr, nullptr, 0};
              pg8::gemm_phase<pg8::Epi, pg8::StaticOrder, true, true>(lds, g, S, E); }
#endif
            GSYNC();
#if defined(STOP_AFTER) && STOP_AFTER == 3
            if (c == 0) DUMP_BF16(WS_X1, (size_t)MH * DM); else DUMP_BF16(WS_X0, (size_t)MH * DM); return;
#endif
#if !defined(ONLY) || ONLY == 4
            { ARGS(); const bf16_t* wl = WSP(bf16_t, WS_W) + (size_t)l * LW_TOTAL; float* out = ap->out + (size_t)hf * MH * DM;
              pg8::Gemm g{XBP(1 - c), wl + LW_O, MH, DM, DM}; pg8::StaticOrder S; S.init(MH, DM, G, bx);
              pg8::Epi E{4, XBP(c), DM, nullptr, 0, l == 0 ? ap->x + (size_t)hf * MH * DM : (const float*)nullptr, DM, nullptr, nullptr, SXP(c), nullptr, XBP(c), nullptr, 0};
              pg8::gemm_phase<pg8::Epi, pg8::StaticOrder, true, true>(lds, g, S, E); }
#endif
            GSYNC();
#if defined(STOP_AFTER) && STOP_AFTER == 4
            if (c == 0) DUMP_BF16(WS_X0, (size_t)MH * DM); else DUMP_BF16(WS_X1, (size_t)MH * DM); return;
#endif
#if !defined(ONLY) || ONLY == 5
            { ARGS(); const bf16_t* wl = WSP(bf16_t, WS_W) + (size_t)l * LW_TOTAL;
              pg8::Gemm g{XBP(c), wl + LW_G, MH, DM, DM}; pg8::StaticOrder S; S.init(MH, DM, G, bx);
              pg8::Epi E{5, WSP(bf16_t, WS_PROJ) + 2048, NP1, nullptr, 0, nullptr, 0, nullptr, SXP(c), nullptr, nullptr, nullptr, nullptr, 0};
              pg8::gemm_phase<pg8::Epi, pg8::StaticOrder, true, true>(lds, g, S, E); }
#endif
#if !defined(ONLY) || ONLY == 6
            { ARGS(); const bf16_t* wl = WSP(bf16_t, WS_W) + (size_t)l * LW_TOTAL; float* out = ap->out + (size_t)hf * MH * DM;
              pg8::Gemm g{WSP(bf16_t, WS_PB), wl + LW_P, MH, DM, PLE}; pg8::StaticOrder S; S.init(MH, DM, G, bx);
              pg8::Epi E{6, XBP(1 - c), DM, l == NLAYER - 1 ? out : (float*)nullptr, DM, nullptr, 0, nullptr, nullptr, SXP(1 - c), WSP(bf16_t, WS_PROJ) + 2048, XBP(c), nullptr, 0};
              pg8::gemm_phase<pg8::Epi, pg8::StaticOrder, true, true>(lds, g, S, E); }
#endif
            GSYNC();
#if defined(STOP_AFTER) && STOP_AFTER == 5
            if (c == 0) DUMP_BF16(WS_X1, (size_t)MH * DM); else DUMP_BF16(WS_X0, (size_t)MH * DM); return;
#endif
            c ^= 1;
        }
        { ARGS(); final_rows(ap->out + (size_t)hf * MH * DM, ap->final_g, gw, ngw, lane); }
    }
}

extern "C" void kernel_launch(void* const* d_in, const int* in_sizes, int n_in, void* d_out, int out_size, void* d_ws, size_t ws_size, hipStream_t stream) {
    static int grid = 0;
    if (grid == 0) {
        if (n_in != 18 || ws_size < WS_END) { fprintf(stderr, "kernel_launch: unexpected n_in %d / ws_size %zu (need %zu)\n", n_in, ws_size, (size_t)WS_END); grid = -1; return; }
        int dev = 0, cus = 0, per_cu = 0;
        hipGetDevice(&dev); hipDeviceGetAttribute(&cus, hipDeviceAttributeMultiprocessorCount, dev);
        if (hipFuncSetAttribute((const void*)mega_fwd, hipFuncAttributeMaxDynamicSharedMemorySize, LDS_BYTES) != hipSuccess) { fprintf(stderr, "kernel_launch: hipFuncSetAttribute failed\n"); grid = -1; return; }
        if (hipOccupancyMaxActiveBlocksPerMultiprocessor(&per_cu, (const void*)mega_fwd, NTHREADS, LDS_BYTES) != hipSuccess || per_cu < 1) { fprintf(stderr, "kernel_launch: occupancy query gives %d\n", per_cu); per_cu = 1; }
        (void)hipGetLastError();
        if (cus % 8 != 0) { fprintf(stderr, "kernel_launch: CU count %d is not a multiple of 8\n", cus); grid = -1; return; }
        grid = cus;
    }
    if (grid < 0) return;
    if (hipMemsetAsync(d_ws, 0, 16384, stream) != hipSuccess) { fprintf(stderr, "kernel_launch: memset failed\n"); return; }
    Args a{};
    const float** f = (const float**)&a;
    for (int i = 0; i < 18; ++i) f[i] = (const float*)d_in[i];
    a.out = (float*)d_out; a.ws = (unsigned char*)d_ws;
    void* args[] = {&a};
    hipError_t e = hipLaunchCooperativeKernel((const void*)mega_fwd, dim3(grid), dim3(NTHREADS), args, LDS_BYTES, stream);
    if (e != hipSuccess) fprintf(stderr, "cooperative launch failed: %s (grid %d)\n", hipGetErrorString(e), grid);
}
```

```cpp
#include <hip/hip_runtime.h>
#include <hip/hip_cooperative_groups.h>
#include <cstdio>
#include <cstdint>
namespace cg = cooperative_groups;
template <int M> __device__ __forceinline__ float xor_lt32(float v) { return __builtin_bit_cast(float, __builtin_amdgcn_ds_swizzle(__builtin_bit_cast(int, v), (M << 10) | 0x1F)); }
__device__ __forceinline__ float xor32_add(float v) { const unsigned b = __builtin_bit_cast(unsigned, v); auto rr = __builtin_amdgcn_permlane32_swap(b, b, false, false); return __builtin_bit_cast(float, (unsigned)rr[0]) + __builtin_bit_cast(float, (unsigned)rr[1]); }
__device__ __forceinline__ float xor32_max(float v) { const unsigned b = __builtin_bit_cast(unsigned, v); auto rr = __builtin_amdgcn_permlane32_swap(b, b, false, false); return fmaxf(__builtin_bit_cast(float, (unsigned)rr[0]), __builtin_bit_cast(float, (unsigned)rr[1])); }
__device__ __forceinline__ int lane_id_() { int l_; asm volatile("v_mbcnt_lo_u32_b32 %0, -1, 0\n\tv_mbcnt_hi_u32_b32 %0, -1, %0" : "=&v"(l_)); return l_; }
namespace pg8 {
#define PG8_LAS __attribute__((address_space(3)))
typedef unsigned short bf16_t;
typedef short bf16x8 __attribute__((ext_vector_type(8)));
typedef float f32x4 __attribute__((ext_vector_type(4)));
typedef unsigned u32x4 __attribute__((ext_vector_type(4)));
constexpr int BM = 256, BK = 64, HALF = 128, HTB = HALF * BK * 2  , STAGE_BYTES = 8 * HTB, NXCD = 8, WGM = 8;

__host__ __device__ __forceinline__ int lds_byte(int r, int c) { const int st = (r >> 4) * 2 + (c >> 5), rr = r & 15, cc = c & 31, ob = rr * 64 + cc * 2; return st * 1024 + (ob ^ (((ob >> 9) & 1) << 5)); }
__host__ __device__ __forceinline__ void stage_rc(int b, int& R, int& C) { const int st = b / 1024, sb = b % 1024, swz = sb ^ (((sb >> 9) & 1) << 5); R = (st >> 1) * 16 + swz / 64; C = (st & 1) * 32 + (swz % 64) / 2; }
__host__ __device__ __forceinline__ int perm32(int rho) { const int n = rho >> 4, i = rho & 15; return 8 * (i >> 2) + 4 * n + (i & 3); }

struct Unit { int pm, pn; };
struct Gemm { const bf16_t* A; const bf16_t* Bt; int M, N, K; };

struct StaticOrder {
    int nM, nN, nwg, G, c;
    __host__ __device__ void init(int M, int N, int G_, int c_) { nM = M / BM; nN = N / BM; nwg = nM * nN; G = G_; c = c_; }
    __host__ __device__ bool next(int i, Unit& u) const {
        const long L = (long)i * G + c; if (L >= nwg) return false;
        int wgid = (int)L; { const int q = nwg / NXCD, r = nwg % NXCD, xcd = wgid % NXCD, off = wgid / NXCD; wgid = (xcd < r ? xcd * (q + 1) : r * (q + 1) + (xcd - r) * q) + off; }
        const int nig = WGM * nN, gid = wgid / nig, fm = gid * WGM, gsz = (nM - fm) < WGM ? (nM - fm) : WGM;
        u.pm = fm + ((wgid % nig) % gsz); u.pn = (wgid % nig) / gsz; return true;
    }
    __device__ __forceinline__ void a_ready(const Unit&) const {}
    __device__ __forceinline__ void done(const Unit&) const {}
};

__device__ __forceinline__ unsigned cvt_pk_bf16(float lo, float hi) { unsigned r; asm volatile("v_cvt_pk_bf16_f32 %0, %1, %2" : "=v"(r) : "v"(lo), "v"(hi)); return r; }
typedef float f32x2 __attribute__((ext_vector_type(2)));
__device__ __forceinline__ f32x2 gelu_pk(f32x2 v) {
    const f32x2 av = __builtin_elementwise_abs(v), d = av * 0.2316418882f + 1.0f;
    f32x2 t; t.x = __builtin_amdgcn_rcpf(d.x); t.y = __builtin_amdgcn_rcpf(d.y);
    f32x2 q = t * 0.5307027145f + (-0.7265760135f); q = q * t + 0.7107068705f; q = q * t + (-0.142248368f); q = q * t + 0.127414796f; q = q * t;
    const f32x2 s = (v * v) * (-0.72134752044f);
    f32x2 e; e.x = __builtin_amdgcn_exp2f(s.x); e.y = __builtin_amdgcn_exp2f(s.y);
    const f32x2 m = v * (q * e), r = v - m;
    f32x2 o; o.x = v.x < 0.f ? m.x : r.x; o.y = v.y < 0.f ? m.y : r.y; return o;
}

typedef float f32x2_t __attribute__((ext_vector_type(2))); typedef __bf16 bf16x2_t __attribute__((ext_vector_type(2)));
__device__ __forceinline__ unsigned cvtpk(float lo, float hi) { f32x2_t v = {lo, hi}; bf16x2_t b = __builtin_convertvector(v, bf16x2_t); return __builtin_bit_cast(unsigned, b); }
__device__ __forceinline__ u32x4 pack8(f32x4 a, f32x4 b) { u32x4 w; w.x = cvtpk(a[0], a[1]); w.y = cvtpk(a[2], a[3]); w.z = cvtpk(b[0], b[1]); w.w = cvtpk(b[2], b[3]); return w; }
__device__ __forceinline__ void unpack8(u32x4 w, f32x4& a, f32x4& b) {
    a[0] = __uint_as_float(w.x << 16); a[1] = __uint_as_float(w.x & 0xffff0000u); a[2] = __uint_as_float(w.y << 16); a[3] = __uint_as_float(w.y & 0xffff0000u);
    b[0] = __uint_as_float(w.z << 16); b[1] = __uint_as_float(w.z & 0xffff0000u); b[2] = __uint_as_float(w.w << 16); b[3] = __uint_as_float(w.w & 0xffff0000u); }
__device__ __forceinline__ float sigm(float x) { return __builtin_amdgcn_rcpf(1.0f + __builtin_amdgcn_exp2f(-1.4426950408889634f * x)); }
__device__ __forceinline__ f32x4 sigm4(f32x4 v) { f32x4 o; o[0] = sigm(v[0]); o[1] = sigm(v[1]); o[2] = sigm(v[2]); o[3] = sigm(v[3]); return o; }
__device__ __forceinline__ f32x4 gelu4(f32x4 v) { f32x2 a = gelu_pk((f32x2){v[0], v[1]}), b = gelu_pk((f32x2){v[2], v[3]}); return (f32x4){a.x, a.y, b.x, b.y}; }
__device__ __forceinline__ float row_rstd(const float* S, int row) {
    const f32x4* p = (const f32x4*)(S + (size_t)row * 16); const f32x4 s = (p[0] + p[1]) + (p[2] + p[3]);
    return rsqrtf(((s[0] + s[1]) + (s[2] + s[3])) * (1.0f / 1024.0f) + 1e-6f); }
constexpr float QSCALE = 0.125f * 1.4426950408889634f;
struct Epi {
    static constexpr bool PERM = true, AFTER_DRAIN = false;
    int mode; bf16_t* Ob; int ldo; float* Of; int ldf; const float* Fin; int ldi; const bf16_t* G; const float* S; float* Sn; const bf16_t* T16; const bf16_t* Xin; const PG8_LAS float* rtab; int rbase;
    __device__ __forceinline__ void operator()(const f32x4 (&acc)[2][2][4][2], const Unit& u, int wr, int wc, int fr, int fq) const {
        const int row0 = u.pm * BM + wr * 64 + fr, col0 = u.pn * BM + wc * 32 + 8 * fq;
        if (mode == 1) {
            const int sec = u.pm >> 2; f32x4 rc[2][2];
#pragma unroll
            for (int bj = 0; bj < 2; ++bj)
#pragma unroll
                for (int n = 0; n < 2; ++n) rc[bj][n] = *(const PG8_LAS f32x4*)(rtab + (col0 + bj * HALF + 4 * n - rbase));
#pragma unroll
            for (int ai = 0; ai < 2; ++ai)
#pragma unroll
                for (int m = 0; m < 4; ++m) { const int row = row0 + ai * HALF + m * 16;
#pragma unroll
                    for (int bj = 0; bj < 2; ++bj) { f32x4 v0 = acc[ai][bj][m][0] * rc[bj][0], v1 = acc[ai][bj][m][1] * rc[bj][1];
                        if (sec == 0) { v0 = gelu4(v0); v1 = gelu4(v1); }
                        *(u32x4*)(Ob + (size_t)row * ldo + col0 + bj * HALF) = pack8(v0, v1); }
                    if (m & 1) asm volatile("" ::: "memory"); }
            return;
        }
        const int sec = u.pn >> 2;
        if (mode == 0 || mode == 5) {
            float rs8[2][4];
            if (mode == 5) {
                f32x4 p8[2][4];
#pragma unroll
                for (int ai = 0; ai < 2; ++ai)
#pragma unroll
                    for (int m = 0; m < 4; ++m) p8[ai][m] = ((const f32x4*)(S + (size_t)(row0 + ai * HALF + m * 16) * 16))[fq];
#pragma unroll
                for (int ai = 0; ai < 2; ++ai)
#pragma unroll
                    for (int m = 0; m < 4; ++m) { float s_ = (p8[ai][m][0] + p8[ai][m][1]) + (p8[ai][m][2] + p8[ai][m][3]);
                        s_ += __shfl_xor(s_, 16); s_ += __shfl_xor(s_, 32); rs8[ai][m] = rsqrtf(s_ * (1.0f / 1024.0f) + 1e-6f); }
            }
#pragma unroll
            for (int ai = 0; ai < 2; ++ai) {
                float rsr[4];
#pragma unroll
                for (int m = 0; m < 4; ++m) rsr[m] = (mode == 0) ? rtab[row0 + ai * HALF + m * 16 - rbase] : rs8[ai][m];
#pragma unroll
                for (int m = 0; m < 4; ++m) { const int row = row0 + ai * HALF + m * 16; const float rs = rsr[m];
#pragma unroll
                    for (int bj = 0; bj < 2; ++bj) { const int col = col0 + bj * HALF; f32x4 v0 = acc[ai][bj][m][0] * rs, v1 = acc[ai][bj][m][1] * rs;
                        if (mode == 0) {
                            if (sec == 0) { v0 = gelu4(v0); v1 = gelu4(v1); }
                            else if (sec == 1 || sec == 4) { v0 = v0 * sigm4(v0); v1 = v1 * sigm4(v1); }
                            else if (sec == 2) { v0 = v0 * QSCALE; v1 = v1 * QSCALE; }
                            else if (sec >= 5) { v0 = sigm4(v0); v1 = sigm4(v1); }
                            *(u32x4*)(Ob + (size_t)row * ldo + col) = pack8(v0, v1);
                        } else { *(u32x4*)(Ob + (size_t)row * ldo + col) = pack8(sigm4(v0), sigm4(v1)); } }
                    asm volatile("" ::: "memory"); }
            }
            return;
        }
#pragma unroll
        for (int ai = 0; ai < 2; ++ai)
#pragma unroll
            for (int mh = 0; mh < 2; ++mh) {
                u32x4 gq[2][2], tq[2][2], xq[2][2]; f32x4 ta[2][2][2];
#pragma unroll
                for (int mm = 0; mm < 2; ++mm)
#pragma unroll
                    for (int bj = 0; bj < 2; ++bj) { const int row = row0 + ai * HALF + (2 * mh + mm) * 16, col = col0 + bj * HALF;
                        if (mode == 2 || mode == 3) gq[mm][bj] = *(const u32x4*)(G + (size_t)row * 7168 + col);
                        if (mode == 4 && Fin) { const float* t = Fin + (size_t)row * ldi + col; ta[mm][bj][0] = *(const f32x4*)t; ta[mm][bj][1] = *(const f32x4*)(t + 4); }
                        if ((mode == 4 && !Fin) || mode == 6) xq[mm][bj] = *(const u32x4*)(Xin + (size_t)row * 1024 + col);
                        if (mode == 3 || mode == 6) tq[mm][bj] = *(const u32x4*)(T16 + (size_t)row * 7168 + col);
                    }
#pragma unroll
                for (int mm = 0; mm < 2; ++mm) { const int m = 2 * mh + mm; const int row = row0 + ai * HALF + m * 16; float ss = 0.f;
#pragma unroll
                    for (int bj = 0; bj < 2; ++bj) { const int col = col0 + bj * HALF; f32x4 v0 = acc[ai][bj][m][0], v1 = acc[ai][bj][m][1];
                        if (mode == 2) { f32x4 g0, g1; unpack8(gq[mm][bj], g0, g1); *(u32x4*)(Ob + (size_t)row * ldo + col) = pack8(v0 * g0, v1 * g1); }
                        else if (mode == 3) { f32x4 g0, g1, t0, t1; unpack8(gq[mm][bj], g0, g1); unpack8(tq[mm][bj], t0, t1); v0 = t0 + v0 * g0; v1 = t1 + v1 * g1; *(u32x4*)(Ob + (size_t)row * ldo + col) = pack8(v0, v1); }
                        else { if (mode == 4) { if (Fin) { v0 = ta[mm][bj][0] + v0; v1 = ta[mm][bj][1] + v1; } else { f32x4 x0, x1; unpack8(xq[mm][bj], x0, x1); v0 = x0 + v0; v1 = x1 + v1; } }
                            else { f32x4 t0, t1, x0, x1; unpack8(tq[mm][bj], t0, t1); unpack8(xq[mm][bj], x0, x1); v0 = x0 + v0 * t0; v1 = x1 + v1 * t1; }
                            if (Of) { float* o = Of + (size_t)row * ldf + col; *(f32x4*)o = v0; *(f32x4*)(o + 4) = v1; }
                            *(u32x4*)(Ob + (size_t)row * ldo + col) = pack8(v0, v1);
                            ss += (v0[0] * v0[0] + v0[1] * v0[1]) + (v0[2] * v0[2] + v0[3] * v0[3]) + (v1[0] * v1[0] + v1[1] * v1[1]) + (v1[2] * v1[2] + v1[3] * v1[3]); } }
                    if (mode == 4 || mode == 6) { ss += __shfl_xor(ss, 16); ss += __shfl_xor(ss, 32); if (fq == 0) Sn[(size_t)row * 16 + u.pn * 4 + wc] = ss; } }
                if (!(mode == 2 && mh == 0)) asm volatile("" ::: "memory");
            }
    }
};
template <class Epi, class Sched, bool ALIGN_EPI = false, bool SP2 = false>
__device__ __forceinline__ void gemm_phase(PG8_LAS unsigned char* lds, const Gemm g, const Sched& S, const Epi& E) {
    int tid_ = threadIdx.x; asm volatile("" : "+v"(tid_)); const int tid = tid_, wid = __builtin_amdgcn_readfirstlane(tid >> 6), lane = tid & 63, wr = wid >> 2, wc = wid & 3, fr = lane & 15, fq = lane >> 4;
    int K_ = g.K; asm volatile("" : "+s"(K_)); const int K = K_, nt = K / BK;
    unsigned voffA[2], voffB[2];
#pragma unroll
    for (int i = 0; i < 2; ++i) { int R, C; stage_rc(tid * 16 + i * 8192, R, C); const int Rb = Epi::PERM ? ((R & ~31) + perm32(R & 31)) : R;
        voffA[i] = (unsigned)(R * K + C) * 2u; voffB[i] = (unsigned)(Rb * K + C) * 2u; }
    const size_t kstep = (size_t)(BK * 2);
    const size_t hstep = (size_t)HALF * K * 2;
    const size_t tstep = 2 * hstep;
    const unsigned ldsw = (unsigned)wid * 1024u;
    const int aoff = lds_byte(wr * 64 + fr, fq * 8), boff = lds_byte(wc * 32 + fr, fq * 8);
#define PG8_SA(b, h) (((b) * 2 + (h)) * HTB)
#define PG8_SB(b, h) ((4 + (b) * 2 + (h)) * HTB)
#define PG8_STAGE(bufoff, gbase, voff) do { _Pragma("unroll") for (int _i = 0; _i < 2; ++_i) \
        __builtin_amdgcn_global_load_lds((const unsigned*)((const char*)(gbase) + (voff)[_i]), (PG8_LAS unsigned*)(lds + (bufoff) + ldsw + _i * 8192), 16, 0, 0); } while (0)
#define PG8_LDA(dst, b, h) do { _Pragma("unroll") for (int m = 0; m < 4; ++m) _Pragma("unroll") for (int k = 0; k < 2; ++k) dst[m][k] = *(const PG8_LAS bf16x8*)(lds + PG8_SA(b, h) + aoff + m * 2048 + k * 1024); } while (0)
#define PG8_LDB(dst, b, h) do { _Pragma("unroll") for (int n = 0; n < 2; ++n) _Pragma("unroll") for (int k = 0; k < 2; ++k) dst[n][k] = *(const PG8_LAS bf16x8*)(lds + PG8_SB(b, h) + boff + n * 2048 + k * 1024); } while (0)
#define PG8_MMA(ai, bj, At, Bt) do { __builtin_amdgcn_s_setprio(1); _Pragma("unroll") for (int m = 0; m < 4; ++m) _Pragma("unroll") for (int n = 0; n < 2; ++n) _Pragma("unroll") for (int k = 0; k < 2; ++k) \
        acc[ai][bj][m][n] = __builtin_amdgcn_mfma_f32_16x16x32_bf16(Bt[n][k], At[m][k], acc[ai][bj][m][n], 0, 0, 0); __builtin_amdgcn_s_setprio(0); } while (0)
#define PG8_WAIT_V(n) asm volatile("s_waitcnt vmcnt(" #n ")" ::: "memory")
#define PG8_WAIT_L(n) asm volatile("s_waitcnt lgkmcnt(" #n ")" ::: "memory")
#define PG8_BAR __builtin_amdgcn_s_barrier()
#define PG8_SCHED __builtin_amdgcn_sched_barrier(0)
    Unit cur, nxt; int ui = 0;
    if (!S.next(0, cur)) return;
    f32x4 acc[2][2][4][2];
#pragma unroll
    for (int a = 0; a < 2; ++a)
#pragma unroll
        for (int b = 0; b < 2; ++b)
#pragma unroll
            for (int m = 0; m < 4; ++m)
#pragma unroll
                for (int n = 0; n < 2; ++n) acc[a][b][m][n] = (f32x4){0.f, 0.f, 0.f, 0.f};
    bf16x8 At[4][2], B0[2][2], B1[2][2];
    const char* cA = (const char*)g.A + (size_t)cur.pm * tstep; const char* cB = (const char*)g.Bt + (size_t)cur.pn * tstep;
    S.a_ready(cur);
    if constexpr (SP2) {
        PG8_STAGE(PG8_SB(0, 0), cB, voffB); PG8_STAGE(PG8_SB(0, 1), cB + hstep, voffB); PG8_STAGE(PG8_SA(0, 0), cA, voffA); PG8_STAGE(PG8_SA(0, 1), cA + hstep, voffA);
        if (wr == 1) PG8_BAR;
        PG8_WAIT_V(2); PG8_BAR;
        PG8_STAGE(PG8_SB(1, 0), cB + kstep, voffB); PG8_STAGE(PG8_SA(1, 0), cA + kstep, voffA); PG8_STAGE(PG8_SB(1, 1), cB + hstep + kstep, voffB);
        PG8_WAIT_V(6); PG8_BAR;
    } else {
        PG8_STAGE(PG8_SB(0, 0), cB, voffB); PG8_STAGE(PG8_SA(0, 0), cA, voffA); PG8_STAGE(PG8_SB(0, 1), cB + hstep, voffB); PG8_STAGE(PG8_SA(0, 1), cA + hstep, voffA);
        if (wr == 1) PG8_BAR;
        PG8_WAIT_V(4); PG8_BAR;
        PG8_STAGE(PG8_SB(1, 0), cB + kstep, voffB); PG8_STAGE(PG8_SA(1, 0), cA + kstep, voffA); PG8_STAGE(PG8_SB(1, 1), cB + hstep + kstep, voffB);
        PG8_WAIT_V(6); PG8_BAR;
    }
    for (;;) {
        const bool has_next = S.next(ui + 1, nxt);
        const char* nA = has_next ? (const char*)g.A + (size_t)nxt.pm * tstep : cA; const char* nB = has_next ? (const char*)g.Bt + (size_t)nxt.pn * tstep : cB;
        for (int t = 0; t < nt; t += 2) {
            const bool last = (t == nt - 2);
            const char* a1 = cA + (size_t)(t + 1) * kstep;
            const char* a2 = last ? nA : cA + (size_t)(t + 2) * kstep; const char* b2 = last ? nB : cB + (size_t)(t + 2) * kstep;
            const char* a3 = a2 + kstep; const char* b3 = b2 + kstep;
            if (last && has_next) S.a_ready(nxt);
            if constexpr (SP2) {
            PG8_LDB(B0, 0, 0); PG8_LDB(B1, 0, 1); PG8_SCHED; PG8_LDA(At, 0, 0); PG8_STAGE(PG8_SA(1, 1), a1 + hstep, voffA);
            PG8_WAIT_V(8); PG8_WAIT_L(0); PG8_BAR; PG8_MMA(0, 0, At, B0); PG8_MMA(0, 1, At, B1); PG8_BAR; PG8_SCHED;
            PG8_LDA(At, 0, 1); PG8_STAGE(PG8_SB(0, 0), b2, voffB); PG8_STAGE(PG8_SB(0, 1), b2 + hstep, voffB); PG8_STAGE(PG8_SA(0, 0), a2, voffA);
            PG8_WAIT_V(8); PG8_WAIT_L(0); PG8_BAR; PG8_MMA(1, 0, At, B0); PG8_MMA(1, 1, At, B1); PG8_BAR; PG8_SCHED;
            PG8_LDB(B0, 1, 0); PG8_LDB(B1, 1, 1); PG8_SCHED; PG8_LDA(At, 1, 0); PG8_STAGE(PG8_SA(0, 1), a2 + hstep, voffA);
            PG8_WAIT_V(8); PG8_WAIT_L(0); PG8_BAR; PG8_MMA(0, 0, At, B0); PG8_MMA(0, 1, At, B1); PG8_BAR; PG8_SCHED;
            PG8_LDA(At, 1, 1); PG8_STAGE(PG8_SB(1, 0), b3, voffB); PG8_STAGE(PG8_SB(1, 1), b3 + hstep, voffB); PG8_STAGE(PG8_SA(1, 0), a3, voffA);
            PG8_WAIT_V(8); PG8_WAIT_L(0); PG8_BAR; PG8_MMA(1, 0, At, B0); PG8_MMA(1, 1, At, B1); PG8_BAR; PG8_SCHED;
            } else {
            PG8_LDB(B0, 0, 0); PG8_SCHED; PG8_LDA(At, 0, 0); PG8_STAGE(PG8_SA(1, 1), a1 + hstep, voffA);
            PG8_WAIT_L(8); PG8_BAR; PG8_WAIT_L(0); PG8_MMA(0, 0, At, B0); PG8_BAR; PG8_SCHED;
            PG8_LDB(B1, 0, 1); PG8_STAGE(PG8_SB(0, 0), b2, voffB);
            PG8_BAR; PG8_WAIT_L(0); PG8_MMA(0, 1, At, B1); PG8_BAR;
            PG8_LDA(At, 0, 1); PG8_STAGE(PG8_SA(0, 0), a2, voffA);
            PG8_BAR; PG8_WAIT_L(0); PG8_MMA(1, 0, At, B0); PG8_BAR; PG8_SCHED;
            PG8_STAGE(PG8_SB(0, 1), b2 + hstep, voffB);
            PG8_WAIT_V(6); PG8_BAR; PG8_MMA(1, 1, At, B1); PG8_BAR;
            PG8_LDB(B0, 1, 0); PG8_SCHED; PG8_LDA(At, 1, 0); PG8_STAGE(PG8_SA(0, 1), a2 + hstep, voffA);
            PG8_WAIT_L(8); PG8_BAR; PG8_WAIT_L(0); PG8_MMA(0, 0, At, B0); PG8_BAR; PG8_SCHED;
            PG8_LDB(B1, 1, 1); PG8_STAGE(PG8_SB(1, 0), b3, voffB);
            PG8_BAR; PG8_WAIT_L(0); PG8_MMA(0, 1, At, B1); PG8_BAR;
            PG8_LDA(At, 1, 1); PG8_STAGE(PG8_SA(1, 0), a3, voffA);
            PG8_BAR; PG8_WAIT_L(0); PG8_MMA(1, 0, At, B0); PG8_BAR; PG8_SCHED;
            PG8_STAGE(PG8_SB(1, 1), b3 + hstep, voffB);
            PG8_WAIT_V(6); PG8_BAR; PG8_MMA(1, 1, At, B1); PG8_BAR;
            }
        }
        if constexpr (ALIGN_EPI) { if (wr == 0) PG8_BAR; }
        if constexpr (!Epi::AFTER_DRAIN) { E(acc, cur, wr, wc, fr, fq); S.done(cur); }
        if (!has_next) break;
#pragma unroll
        for (int a = 0; a < 2; ++a)
#pragma unroll
            for (int b = 0; b < 2; ++b)
#pragma unroll
                for (int m = 0; m < 4; ++m)
#pragma unroll
                    for (int n = 0; n < 2; ++n) acc[a][b][m][n] = (f32x4){0.f, 0.f, 0.f, 0.f};
        cur = nxt; cA = nA; cB = nB; ++ui;
        if constexpr (ALIGN_EPI) { if (wr == 1) PG8_BAR; }
    }
    PG8_WAIT_V(0);
    if constexpr (!ALIGN_EPI) { if (wr == 0) PG8_BAR; }
    PG8_BAR;
    if constexpr (Epi::AFTER_DRAIN) { E.fused(acc, cur, wr, wc, fr, fq, lds, wid, lane); S.done(cur); }
#undef PG8_SA
#undef PG8_SB
#undef PG8_STAGE
#undef PG8_LDA
#undef PG8_LDB
#undef PG8_MMA
#undef PG8_WAIT_V
#undef PG8_WAIT_L
#undef PG8_BAR
#undef PG8_SCHED
}
}

#define LAS __attribute__((address_space(3)))
typedef unsigned short bf16_t;
typedef short bf16x8 __attribute__((ext_vector_type(8)));
typedef float f32x4 __attribute__((ext_vector_type(4)));
typedef float f32x16 __attribute__((ext_vector_type(16)));
typedef unsigned u32x4 __attribute__((ext_vector_type(4)));
typedef unsigned u32x2 __attribute__((ext_vector_type(2)));
using pg8::cvtpk; using pg8::pack8; using pg8::unpack8;
constexpr int NTHREADS = 512, NWAVES = 8;
constexpr int MH = 16384, DM = 1024, SEQ = 4096, NB_H = 4, NLAYER = 4, NP1 = 7168, NV2 = 2048, PLE = 256, NHEAD = 8;
constexpr size_t MiB = 1u << 20;
constexpr size_t LW_IN = 0, LW_A = (size_t)9216 * 1024, LW_B = LW_A + 1048576, LW_O = LW_B + 1048576, LW_G = LW_O + 1048576, LW_P = LW_G + 1048576, LW_TOTAL = LW_P + 262144;
constexpr size_t WS_W = 1 * MiB, WS_PROJ = 108 * MiB, WS_VT2 = 332 * MiB, WS_X0 = 396 * MiB, WS_X1 = 428 * MiB, WS_BRA = 460 * MiB, WS_BRB = 492 * MiB, WS_PB = 524 * MiB, WS_S0 = 532 * MiB, WS_S1 = 533 * MiB, WS_END = 534 * MiB;
static_assert(WS_W + LW_TOTAL * 2 * NLAYER <= WS_PROJ, "weights fit");
constexpr int TMP_LD = NP1 / 2;
constexpr int LDS_BYTES = 147456;
constexpr float EPS = 1e-6f;

struct Args {
    const float *x, *p, *norm_g, *w_in, *a_ln_g, *a_ln_b, *a_ws, *a_bs, *lam_q, *lam_k, *subln_g, *w_a_out, *w_b_out, *w_o, *ple_norm_g, *w_ple, *w_ple_gate, *final_g;
    float* out; unsigned char* ws;
};

__device__ __forceinline__ float wave_sum(float v) {
#pragma unroll
    for (int o = 1; o < 64; o <<= 1) v += __shfl_xor(v, o);
    return v;
}
#define LDS_WAIT() asm volatile("s_waitcnt lgkmcnt(0)" ::: "memory")

__device__ __forceinline__ void tr_item(const float* W, int K, int N, const float* scale, bf16_t* WT, int dst_row0, LAS float* scr, int k0, int n0, int lane) {
    f32x4 v[8];
#pragma unroll
    for (int i = 0; i < 8; ++i) v[i] = *(const f32x4*)(W + (size_t)(k0 + 4 * i + (lane >> 4)) * N + n0 + (lane & 15) * 4);
#pragma unroll
    for (int i = 0; i < 8; ++i) { const int kk = 4 * i + (lane >> 4); f32x4 x = v[i]; if (scale) x = x * scale[k0 + kk]; *(LAS f32x4*)(scr + kk * 68 + (lane & 15) * 4) = x; }
    LDS_WAIT(); asm volatile("" ::: "memory");
    bf16_t* o = WT + (size_t)(dst_row0 + lane) * K + k0;
#pragma unroll
    for (int j = 0; j < 4; ++j) { const LAS float* s = scr + (8 * j) * 68 + lane;
        u32x4 w; w.x = cvtpk(s[0 * 68], s[1 * 68]); w.y = cvtpk(s[2 * 68], s[3 * 68]); w.z = cvtpk(s[4 * 68], s[5 * 68]); w.w = cvtpk(s[6 * 68], s[7 * 68]);
        *(u32x4*)(o + 8 * j) = w; }
    LDS_WAIT(); asm volatile("" ::: "memory");
}
typedef const __attribute__((address_space(4))) Args* cargs_t;
__device__ __forceinline__ void weights_prologue(cargs_t ap, LAS unsigned char* lds, int gw, int ngw, int wave, int lane) {
    LAS float* scr = (LAS float*)(lds + wave * 16384);
    bf16_t* WT = (bf16_t*)(ap->ws + WS_W);
    constexpr int I_IN = 32 * 144, I_SQ = 32 * 16, I_P = 8 * 16, I_L = I_IN + 4 * I_SQ + I_P;
    for (int it = gw; it < I_L * NLAYER; it += ngw) {
        const int l = it / I_L; int r = it % I_L; bf16_t* wl = WT + (size_t)l * LW_TOTAL;
        if (r < I_IN) { const int kb = r / 144, nb = r % 144, n0 = nb * 64; const int osec = n0 >> 10;
            const int nsec = (int)((0x654832170ull >> (4 * osec)) & 0xFull);
            tr_item(ap->w_in + (size_t)l * 1024 * 9216, 1024, 9216, ap->norm_g + l * 1024, wl + LW_IN, nsec * 1024 + (n0 & 1023), scr, kb * 32, n0, lane);
            continue; }
        r -= I_IN;
        if (r < 4 * I_SQ) { const int which = r / I_SQ; const int rr = r % I_SQ; const int kb = rr / 16, nb = rr % 16;
            const float* src = which == 0 ? ap->w_a_out : which == 1 ? ap->w_b_out : which == 2 ? ap->w_o : ap->w_ple_gate;
            const size_t off = which == 0 ? LW_A : which == 1 ? LW_B : which == 2 ? LW_O : LW_G;
            tr_item(src + (size_t)l * 1048576, 1024, 1024, which == 3 ? ap->ple_norm_g + l * 1024 : nullptr, wl + off, nb * 64, scr, kb * 32, nb * 64, lane);
            continue; }
        r -= 4 * I_SQ;
        { const int kb = r / 16, nb = r % 16; tr_item(ap->w_ple + (size_t)l * 262144, 256, 1024, nullptr, wl + LW_P, nb * 64, scr, kb * 32, nb * 64, lane); }
    }
}

__device__ __forceinline__ void init_rows(const float* x, bf16_t* XB, float* S, int gw, int ngw, int lane) {
    asm volatile("" : "+v"(lane)); asm volatile("" : "+s"(gw));
    for (int m = gw; m < MH; m += ngw) {
        const f32x4* xr = (const f32x4*)(x + (size_t)m * DM) + lane; float s = 0.f; f32x4 v[4];
#pragma unroll
        for (int j = 0; j < 4; ++j) { v[j] = xr[64 * j]; s += (v[j][0] * v[j][0] + v[j][1] * v[j][1]) + (v[j][2] * v[j][2] + v[j][3] * v[j][3]); }
        s = wave_sum(s);
        u32x2* o = (u32x2*)(XB + (size_t)m * DM) + lane;
#pragma unroll
        for (int j = 0; j < 4; ++j) { u32x2 w; w.x = cvtpk(v[j][0], v[j][1]); w.y = cvtpk(v[j][2], v[j][3]); o[64 * j] = w; }
        if (lane < 16) S[(size_t)m * 16 + lane] = lane == 0 ? s : 0.f;
    }
}
__device__ __forceinline__ void final_rows(float* out, const float* g, int gw, int ngw, int lane) {
    asm volatile("" : "+v"(lane)); asm volatile("" : "+s"(gw));
    for (int m = gw; m < MH; m += ngw) {
        f32x4* xr = (f32x4*)(out + (size_t)m * DM) + lane; float s = 0.f; f32x4 v[4];
#pragma unroll
        for (int j = 0; j < 4; ++j) { v[j] = xr[64 * j]; s += (v[j][0] * v[j][0] + v[j][1] * v[j][1]) + (v[j][2] * v[j][2] + v[j][3] * v[j][3]); }
        const float rs = rsqrtf(wave_sum(s) * (1.0f / DM) + EPS);
#pragma unroll
        for (int j = 0; j < 4; ++j) { const f32x4 gg = ((const f32x4*)g)[64 * j + lane]; xr[64 * j] = v[j] * rs * gg; }
    }
}
__device__ __forceinline__ void convert_p(const float* p, bf16_t* PB, int gtid, int nthr) {
    asm volatile("" : "+v"(gtid));
    for (int i = gtid; i < MH * PLE / 8; i += nthr) { const f32x4 a = ((const f32x4*)p)[2 * i], b = ((const f32x4*)p)[2 * i + 1]; ((u32x4*)PB)[i] = pack8(a, b); }
}

__device__ __forceinline__ void gmlp_unit(LAS unsigned char* lds, const bf16_t* PROJ, const bf16_t* VT2, bf16_t* BRA, const float* lng, const float* lnb, const float* ws, const float* bs, int c, int gh) {
    int tid_ = threadIdx.x; asm volatile("" : "+v"(tid_)); const int tid = tid_, lane = tid & 63, l32 = lane & 31, hi = lane >> 5; const int w = __builtin_amdgcn_readfirstlane(tid >> 6);
    const int tok0 = c * 128;
    LAS float* red = (LAS float*)lds;
    LAS float* stat = (LAS float*)(lds + 32768);
    LAS unsigned char* T = lds + 34816;
    LAS float* LG = (LAS float*)(lds + 139264); LAS float* LB = LG + 512;
    LG[tid] = lng[gh * 512 + tid]; LB[tid] = lnb[gh * 512 + tid];
    { const int sc = tid & 15, rg = tid >> 4; float s[8], q[8];
#pragma unroll
      for (int j = 0; j < 8; ++j) { s[j] = 0.f; q[j] = 0.f; }
#pragma unroll 8
      for (int i = 0; i < 32; ++i) { const u32x4 wv = *(const u32x4*)(VT2 + (size_t)(rg + 32 * i) * MH + tok0 + sc * 8); f32x4 a, b; unpack8(wv, a, b);
#pragma unroll
          for (int j = 0; j < 4; ++j) { s[j] += a[j]; q[j] += a[j] * a[j]; s[4 + j] += b[j]; q[4 + j] += b[j] * b[j]; } }
#pragma unroll
      for (int j = 0; j < 8; ++j) { red[rg * 256 + sc * 8 + j] = s[j]; red[rg * 256 + 128 + sc * 8 + j] = q[j]; } }
    __syncthreads();
    if (tid < 128) { float s = 0.f, q = 0.f;
        for (int i = 0; i < 32; ++i) { s += red[i * 256 + tid]; q += red[i * 256 + 128 + tid]; }
        const float mean = s * (1.0f / 1024.0f); const float var = q * (1.0f / 1024.0f) - mean * mean;
        stat[2 * tid] = mean; stat[2 * tid + 1] = rsqrtf(var + EPS); }
    __syncthreads();
    const int tb = w & 3, dh = w >> 2;
    u32x4 pre[4];
#pragma unroll
    for (int i = 0; i < 4; ++i) { const int p = tid + 512 * i; pre[i] = *(const u32x4*)(VT2 + (size_t)(gh * 512 + (p >> 4)) * MH + tok0 + (p & 15) * 8); }
    for (int gi = 0; gi < 4; ++gi) { const int g = gh * 4 + gi;
#pragma unroll
        for (int i = 0; i < 4; ++i) { const int p = tid + 512 * i, d = p >> 4, sc = p & 15;
            f32x4 a, b; unpack8(pre[i], a, b);
            const float gg = LG[gi * 128 + d], bb = LB[gi * 128 + d];
#pragma unroll
            for (int j = 0; j < 4; ++j) { a[j] = (a[j] - stat[2 * (sc * 8 + j)]) * stat[2 * (sc * 8 + j) + 1] * gg + bb; b[j] = (b[j] - stat[2 * (sc * 8 + 4 + j)]) * stat[2 * (sc * 8 + 4 + j) + 1] * gg + bb; }
            *(LAS u32x4*)(T + d * 272 + sc * 16) = pack8(a, b); }
        if (gi < 3) {
#pragma unroll
            for (int i = 0; i < 4; ++i) { const int p = tid + 512 * i; pre[i] = *(const u32x4*)(VT2 + (size_t)((g + 1) * 128 + (p >> 4)) * MH + tok0 + (p & 15) * 8); } }
        const float* wrow = ws + (size_t)g * 16384 + (size_t)(32 * tb + l32) * 128 + 8 * hi;
        const int trow = 32 * tb + l32;
        f32x4 wa[8], wb[8];
#pragma unroll
        for (int ks = 0; ks < 8; ++ks) if (ks < 2 * tb + 2) { wa[ks] = *(const f32x4*)(wrow + 16 * ks); wb[ks] = *(const f32x4*)(wrow + 16 * ks + 4); }
        float bv[16];
#pragma unroll
        for (int r = 0; r < 16; ++r) bv[r] = bs[g * 128 + 32 * tb + (r & 3) + 8 * (r >> 2) + 4 * hi];
        u32x4 uq[4], zq[4];
#pragma unroll
        for (int i = 0; i < 4; ++i) { const int p = tid + 512 * i; const bf16_t* up = PROJ + (size_t)(tok0 + (p >> 4)) * NP1 + g * 128 + (p & 15) * 8; uq[i] = *(const u32x4*)up; zq[i] = *(const u32x4*)(up + 1024); }
        __syncthreads();
        f32x16 acc0 = {}, acc1 = {};
#pragma unroll
        for (int ks = 0; ks < 8; ++ks) if (ks < 2 * tb + 2) { const int s0 = 16 * ks + 8 * hi; f32x4 a_ = wa[ks], b_ = wb[ks];
#pragma unroll
            for (int j = 0; j < 4; ++j) { if (s0 + j > trow) a_[j] = 0.f; if (s0 + 4 + j > trow) b_[j] = 0.f; }
            const bf16x8 A = __builtin_bit_cast(bf16x8, pack8(a_, b_));
            const bf16x8 B0 = *(const LAS bf16x8*)(T + (64 * dh + l32) * 272 + (16 * ks + 8 * hi) * 2);
            const bf16x8 B1 = *(const LAS bf16x8*)(T + (64 * dh + 32 + l32) * 272 + (16 * ks + 8 * hi) * 2);
            acc0 = __builtin_amdgcn_mfma_f32_32x32x16_bf16(A, B0, acc0, 0, 0, 0);
            acc1 = __builtin_amdgcn_mfma_f32_32x32x16_bf16(A, B1, acc1, 0, 0, 0);
        }
        LAS float* Yb = (LAS float*)(lds + 71680);
#pragma unroll
        for (int r = 0; r < 16; ++r) { const int t = 32 * tb + (r & 3) + 8 * (r >> 2) + 4 * hi;
            Yb[t * 132 + 64 * dh + l32] = acc0[r] + bv[r]; Yb[t * 132 + 64 * dh + 32 + l32] = acc1[r] + bv[r]; }
        __syncthreads();
#pragma unroll
        for (int i = 0; i < 4; ++i) { const int p = tid + 512 * i, t = p >> 4, c8 = p & 15; const size_t tok = (size_t)(tok0 + t); const int col = g * 128 + c8 * 8;
            f32x4 u0, u1, z0, z1; unpack8(uq[i], u0, u1); unpack8(zq[i], z0, z1);
            const f32x4 y0 = *(const LAS f32x4*)(Yb + t * 132 + c8 * 8), y1 = *(const LAS f32x4*)(Yb + t * 132 + c8 * 8 + 4);
            *(u32x4*)(BRA + tok * DM + col) = pack8(u0 * y0 * z0, u1 * y1 * z1); }
        __syncthreads();
    }
}

constexpr int AT_KS = 17408, AT_VS = 18432, AT_VOFF = 2 * AT_KS;
__device__ __forceinline__ void attn_unit(LAS unsigned char* lds, const bf16_t* PROJ, const bf16_t* VT2, bf16_t* BRB, const float* subg, float lam, float lam_init, int b, int h, int qb) {
    int tid_ = threadIdx.x; asm volatile("" : "+v"(tid_)); const int tid = tid_, lane = tid & 63, l32 = lane & 31, hi = lane >> 5; const int w = __builtin_amdgcn_readfirstlane(tid >> 6); const int map = w >> 2, wq = w & 3;
    const int rowbase = b * SEQ, q0 = qb * 128, myq = q0 + wq * 32 + l32, NT = 2 * qb + 2;
    LAS float* SG = (LAS float*)(lds + 143360); if (tid < 128) SG[tid] = subg[tid];
    bf16x8 qf[4];
    { const bf16_t* qp = PROJ + (size_t)(rowbase + myq) * NP1 + 2048 + h * 128 + map * 64 + hi * 8;
#pragma unroll
      for (int ks = 0; ks < 4; ++ks) qf[ks] = *(const bf16x8*)(qp + ks * 16); }
    const bf16_t* ksrc[2]; const bf16_t* vsrc[2]; int kdst[2], vdst[2];
#pragma unroll
    for (int i = 0; i < 2; ++i) { const int p = tid + 512 * i;
        ksrc[i] = PROJ + (size_t)(rowbase + (p >> 4)) * NP1 + 3072 + h * 128 + (p & 15) * 8; kdst[i] = (p >> 4) * 272 + (p & 15) * 16;
        vsrc[i] = VT2 + (size_t)(1024 + h * 128 + (p >> 3)) * MH + rowbase + (p & 7) * 8; vdst[i] = AT_VOFF + (p >> 3) * 144 + (((p & 7) >> 1) * 16 + (p & 1) * 4) * 2; }
    u32x4 kr[2], vr[2];
#pragma unroll
    for (int i = 0; i < 2; ++i) { kr[i] = *(const u32x4*)(ksrc[i]); vr[i] = *(const u32x4*)(vsrc[i]); }
#pragma unroll
    for (int i = 0; i < 2; ++i) { *(LAS u32x4*)(lds + kdst[i]) = kr[i]; *(LAS u32x2*)(lds + vdst[i]) = (u32x2){vr[i].x, vr[i].y}; *(LAS u32x2*)(lds + vdst[i] + 16) = (u32x2){vr[i].z, vr[i].w}; }
    __syncthreads();
    f32x16 O[4]; O[0] = f32x16{}; O[1] = f32x16{}; O[2] = f32x16{}; O[3] = f32x16{};
    float m_run = -1e30f, l_run = 0.f;
    for (int t = 0; t < NT; ++t) {
        const int buf = t & 1, kv0 = 64 * t;
        if (t + 1 < NT) {
#pragma unroll
            for (int i = 0; i < 2; ++i) { kr[i] = *(const u32x4*)(ksrc[i] + (size_t)(kv0 + 64) * NP1); vr[i] = *(const u32x4*)(vsrc[i] + kv0 + 64); } }
        if (kv0 <= q0 + wq * 32 + 31) {
            LAS unsigned char* Kb = lds + buf * AT_KS + l32 * 272 + map * 128 + hi * 16;
            LAS unsigned char* Vb = lds + AT_VOFF + buf * AT_VS + l32 * 144 + hi * 16;
            f32x16 S0 = {}, S1 = {};
            { bf16x8 kf[8];
#pragma unroll
              for (int ks = 0; ks < 4; ++ks) { kf[2 * ks] = *(const LAS bf16x8*)(Kb + ks * 32); kf[2 * ks + 1] = *(const LAS bf16x8*)(Kb + 32 * 272 + ks * 32); }
              __builtin_amdgcn_sched_barrier(0);
#pragma unroll
              for (int ks = 0; ks < 4; ++ks) { S0 = __builtin_amdgcn_mfma_f32_32x32x16_bf16(kf[2 * ks], qf[ks], S0, 0, 0, 0); S1 = __builtin_amdgcn_mfma_f32_32x32x16_bf16(kf[2 * ks + 1], qf[ks], S1, 0, 0, 0); } }
            u32x4 va[8], vb[8];
#pragma unroll
            for (int j = 0; j < 2; ++j)
#pragma unroll
                for (int db = 0; db < 4; ++db) va[j * 4 + db] = *(const LAS u32x4*)(Vb + db * 32 * 144 + j * 32);
            __builtin_amdgcn_sched_barrier(0);
            if (t >= NT - 2) {
#pragma unroll
                for (int r = 0; r < 16; ++r) { const int kv = kv0 + (r & 3) + 8 * (r >> 2) + 4 * hi; if (kv > myq) S0[r] = -1e30f; if (kv + 32 > myq) S1[r] = -1e30f; } }
            float mx = __builtin_fmaxf(__builtin_fmaxf(S0[0], S1[0]), __builtin_fmaxf(S0[1], S1[1]));
#pragma unroll
            for (int r = 2; r < 16; r += 2) { mx = __builtin_fmaxf(__builtin_fmaxf(mx, S0[r]), S1[r]); mx = __builtin_fmaxf(__builtin_fmaxf(mx, S0[r + 1]), S1[r + 1]); }
            if (__any(mx > m_run + 8.0f)) { mx = fmaxf(mx, __shfl_xor(mx, 32)); const float mnew = fmaxf(m_run, mx), alpha = __builtin_amdgcn_exp2f(m_run - mnew); m_run = mnew; l_run *= alpha;
#pragma unroll
                for (int db = 0; db < 4; ++db)
#pragma unroll
                    for (int r = 0; r < 16; ++r) O[db][r] *= alpha; }
            pg8::f32x2 ps2 = {0.f, 0.f};
#pragma unroll
            for (int r = 0; r < 16; r += 2) { S0[r] = __builtin_amdgcn_exp2f(S0[r] - m_run); S0[r + 1] = __builtin_amdgcn_exp2f(S0[r + 1] - m_run); ps2 += (pg8::f32x2){S0[r], S0[r + 1]}; }
            bf16x8 pf[4];
#pragma unroll
            for (int j = 0; j < 2; ++j) { u32x4 pw;
#pragma unroll
                for (int i = 0; i < 4; ++i) pw[i] = cvtpk(S0[8 * j + 2 * i], S0[8 * j + 2 * i + 1]);
                pf[j] = __builtin_bit_cast(bf16x8, pw); }
#pragma unroll
            for (int j = 2; j < 4; ++j)
#pragma unroll
                for (int db = 0; db < 4; ++db) vb[(j - 2) * 4 + db] = *(const LAS u32x4*)(Vb + db * 32 * 144 + j * 32);
            __builtin_amdgcn_sched_barrier(0);
#pragma unroll
            for (int j = 0; j < 2; ++j)
#pragma unroll
                for (int db = 0; db < 4; ++db) O[db] = __builtin_amdgcn_mfma_f32_32x32x16_bf16(__builtin_bit_cast(bf16x8, va[j * 4 + db]), pf[j], O[db], 0, 0, 0);
#pragma unroll
            for (int r = 0; r < 16; r += 2) { S1[r] = __builtin_amdgcn_exp2f(S1[r] - m_run); S1[r + 1] = __builtin_amdgcn_exp2f(S1[r + 1] - m_run); ps2 += (pg8::f32x2){S1[r], S1[r + 1]}; }
#pragma unroll
            for (int j = 2; j < 4; ++j) { u32x4 pw;
#pragma unroll
                for (int i = 0; i < 4; ++i) pw[i] = cvtpk(S1[8 * (j & 1) + 2 * i], S1[8 * (j & 1) + 2 * i + 1]);
                pf[j] = __builtin_bit_cast(bf16x8, pw); }
#pragma unroll
            for (int k = 0; k < 8; ++k) { __builtin_amdgcn_sched_group_barrier(0x008, 1, 0); __builtin_amdgcn_sched_group_barrier(0x002, 6, 0); }
            __builtin_amdgcn_sched_barrier(0);
            l_run += ps2.x + ps2.y;
#pragma unroll
            for (int j = 2; j < 4; ++j)
#pragma unroll
                for (int db = 0; db < 4; ++db) O[db] = __builtin_amdgcn_mfma_f32_32x32x16_bf16(__builtin_bit_cast(bf16x8, vb[(j - 2) * 4 + db]), pf[j], O[db], 0, 0, 0);
        }
        if (t + 1 < NT) {
#pragma unroll
            for (int i = 0; i < 2; ++i) { *(LAS u32x4*)(lds + (buf ^ 1) * AT_KS + kdst[i]) = kr[i]; *(LAS u32x2*)(lds + (buf ^ 1) * AT_VS + vdst[i]) = (u32x2){vr[i].x, vr[i].y}; *(LAS u32x2*)(lds + (buf ^ 1) * AT_VS + vdst[i] + 16) = (u32x2){vr[i].z, vr[i].w}; } }
        __syncthreads();
    }
    u32x4 zq[4];
#pragma unroll
    for (int i = 0; i < 4; ++i) { const int p = tid + 512 * i; zq[i] = *(const u32x4*)(PROJ + (size_t)(rowbase + q0 + (p >> 4)) * NP1 + 4096 + h * 128 + (p & 15) * 8); }
    const float inv = 1.0f / (l_run + __shfl_xor(l_run, 32));
    LAS float* X = (LAS float*)lds + wq * 4096 + lane;
    if (map == 1) { const float sc = -lam * inv;
#pragma unroll
        for (int db = 0; db < 4; ++db)
#pragma unroll
            for (int r = 0; r < 16; ++r) X[(db * 16 + r) * 64] = O[db][r] * sc; }
    __syncthreads();
    if (map == 0) { float ss = 0.f;
#pragma unroll
        for (int db = 0; db < 4; ++db)
#pragma unroll
            for (int r = 0; r < 16; ++r) { const float o = O[db][r] * inv + X[(db * 16 + r) * 64]; O[db][r] = o; ss += o * o; }
        ss += __shfl_xor(ss, 32);
        const float rs = rsqrtf(ss * (1.0f / 128.0f) + EPS) * (1.0f - lam_init);
        LAS float* Zr = (LAS float*)(lds + 65536) + (wq * 32 + l32) * 132;
#pragma unroll
        for (int db = 0; db < 4; ++db)
#pragma unroll
            for (int rg = 0; rg < 4; ++rg) { const int d = 32 * db + 8 * rg + 4 * hi; const f32x4 gg = *(const LAS f32x4*)(SG + d);
                *(LAS f32x4*)(Zr + d) = (f32x4){O[db][4 * rg] * rs * gg[0], O[db][4 * rg + 1] * rs * gg[1], O[db][4 * rg + 2] * rs * gg[2], O[db][4 * rg + 3] * rs * gg[3]}; } }
    __syncthreads();
#pragma unroll
    for (int i = 0; i < 4; ++i) { const int p = tid + 512 * i, q = p >> 4, c8 = p & 15; const size_t row = (size_t)(rowbase + q0 + q);
        f32x4 z0, z1; unpack8(zq[i], z0, z1);
        const LAS float* zp = (const LAS float*)(lds + 65536) + q * 132 + c8 * 8;
        const f32x4 v0 = *(const LAS f32x4*)zp, v1 = *(const LAS f32x4*)(zp + 4);
        *(u32x4*)(BRB + row * DM + h * 128 + c8 * 8) = pack8(v0 * z0, v1 * z1); }
    __syncthreads();
}

#define RLX_AGENT __ATOMIC_RELAXED, __HIP_MEMORY_SCOPE_AGENT
#define XB_TMO      128
#define XB_XCNT(j)  (256  + 64 * (j))
#define XB_XSUB(j)  (1280 + 64 * (j))
#define XB_XGEN(j)  (2304 + 64 * (j))
#define XB_TOP      3328
#define XB_TOPGEN   3392
#define XCD_BAR_WORDS 3456
#define XB_SPIN_CAP (1u << 18)

__device__ __forceinline__ unsigned xb_ld(unsigned* p)              { return __hip_atomic_load(p, __ATOMIC_RELAXED, __HIP_MEMORY_SCOPE_AGENT); }
__device__ __forceinline__ unsigned xb_add(unsigned* p, unsigned v) { return __hip_atomic_fetch_add(p, v, __ATOMIC_RELAXED, __HIP_MEMORY_SCOPE_AGENT); }
__device__ __forceinline__ unsigned xb_xcc_id() { return (unsigned)__builtin_amdgcn_s_getreg((3 << 11) | 20) & 0xFu; }
#define XB_SPIN(cond, bar) do { unsigned _sp = 0; while (cond) { __builtin_amdgcn_s_sleep(1); \
    if ((++_sp & 255u) == 0u) { if (xb_ld(&(bar)[XB_TMO])) break; if (_sp > XB_SPIN_CAP) { atomicAdd(&(bar)[XB_TMO], 1u); break; } } } } while (0)

struct XcdBarrier {
    unsigned* bar; unsigned x;
    volatile LAS unsigned* st;
};

__device__ __forceinline__ XcdBarrier xcd_barrier_post(unsigned* bar, volatile LAS unsigned* st) {
    XcdBarrier b; b.bar = bar; b.x = xb_xcc_id(); b.st = st;
    if (threadIdx.x == 0) (void)xb_add(&bar[XB_XCNT(b.x)], 1u);
    return b;
}
__device__ __forceinline__ void xcd_barrier_complete(unsigned* bar, unsigned x, unsigned& nloc, unsigned& nx) {
    const unsigned G = gridDim.x * gridDim.y * gridDim.z;
    unsigned sum, cnt, mine, sp = 0u;
    for (;;) {
        sum = 0u; cnt = 0u; mine = 0u;
#pragma unroll
        for (unsigned j = 0; j < 16; ++j) { const unsigned c = xb_ld(&bar[XB_XCNT(j)]); sum += c; cnt += (c > 0u) ? 1u : 0u; mine = (j == x) ? c : mine; }
        if (sum == G) break;
        __builtin_amdgcn_s_sleep(1);
        if ((++sp & 255u) == 0u) { if (xb_ld(&bar[XB_TMO])) break; if (sp > XB_SPIN_CAP) { atomicAdd(&bar[XB_TMO], 1u); break; } }
    }
    nloc = mine > 0u ? mine : 1u; nx = cnt > 0u ? cnt : 1u;
}

__device__ __forceinline__ void xcd_barrier(const XcdBarrier& b) {
    asm volatile("s_waitcnt vmcnt(0)" ::: "memory");
    __syncthreads();
    if (threadIdx.x == 0) {
        unsigned* bar = b.bar;
        __builtin_amdgcn_s_waitcnt(0);
        unsigned nloc = b.st[0], nx = b.st[1];
        if (nloc == 0u) { xcd_barrier_complete(bar, b.x, nloc, nx); b.st[0] = nloc; b.st[1] = nx; }
        const unsigned old = xb_add(&bar[XB_XSUB(b.x)], 1u);
        const unsigned gen = old / nloc;
        if (old + 1u == (gen + 1u) * nloc) {
            __builtin_amdgcn_fence(__ATOMIC_RELEASE, "agent");
            asm volatile("s_waitcnt vmcnt(0)" ::: "memory");
            const unsigned og = xb_add(&bar[XB_TOP], 1u);
            const unsigned tg = og / nx;
            if (og + 1u == (tg + 1u) * nx) xb_add(&bar[XB_TOPGEN], 1u);
            else XB_SPIN(xb_ld(&bar[XB_TOPGEN]) == tg, bar);
            __builtin_amdgcn_fence(__ATOMIC_ACQUIRE, "agent");
            xb_add(&bar[XB_XGEN(b.x)], 1u);
            asm volatile("s_waitcnt vmcnt(0)" ::: "memory");
        } else {
            XB_SPIN(xb_ld(&bar[XB_XGEN(b.x)]) == gen, bar);
            __builtin_amdgcn_fence(__ATOMIC_ACQUIRE, "agent");
            asm volatile("s_waitcnt vmcnt(0)" ::: "memory");
        }
    }
    __syncthreads();
}


__global__ void __launch_bounds__(NTHREADS, 2) mega_fwd(Args a_unused) {
    extern __shared__ __attribute__((aligned(16))) unsigned char lds_raw[];
    LAS unsigned char* lds = (LAS unsigned char*)lds_raw;
    cg::grid_group grid = cg::this_grid();
    const int tid = threadIdx.x, lane = tid & 63, wave = __builtin_amdgcn_readfirstlane(tid >> 6);
    const int G = gridDim.x, bx = blockIdx.x;
    const int vcu = (G % 8 == 0) ? (bx % 8) * (G / 8) + bx / 8 : bx;
    const int gw = vcu * NWAVES + wave, ngw = G * NWAVES;
#define ARGS() cargs_t ap = (cargs_t)__builtin_amdgcn_kernarg_segment_ptr(); asm volatile("" : "+s"(ap)); unsigned char* const ws = ap->ws
#define GSYNC() xcd_barrier(xbar)
#define WSP(T, off) ((T*)(ws + (off)))
#define XBP(ci) ((bf16_t*)(ws + ((ci) ? WS_X1 : WS_X0)))
#define SXP(ci) ((float*)(ws + ((ci) ? WS_S1 : WS_S0)))
#define TMPP ((float*)(ws + WS_PROJ + 4096))
    if (tid < 64) ((LAS unsigned*)(lds + 147200))[tid] = 0u;
    __syncthreads();
    grid.sync();
    XcdBarrier xbar;
    { ARGS(); xbar = xcd_barrier_post((unsigned*)ws, (volatile LAS unsigned*)(lds + 147200)); }
    { ARGS(); weights_prologue(ap, lds, gw, ngw, wave, lane); }

#define DUMP_BF16(buf_off, nelem) do { ARGS(); const bf16_t* B_ = WSP(bf16_t, buf_off); float* o_ = ap->out; \
    for (size_t i_ = (size_t)bx * NTHREADS + tid; i_ < (size_t)2 * MH * DM; i_ += (size_t)G * NTHREADS) o_[i_] = __uint_as_float((unsigned)B_[i_ % (size_t)(nelem)] << 16); } while (0)
    for (int hf = 0; hf < 2; ++hf) {
        { ARGS(); init_rows(ap->x + (size_t)hf * MH * DM, XBP(0), SXP(0), gw, ngw, lane); }
        GSYNC();
        int c = 0;
        for (int l = 0; l < NLAYER; ++l) {
            { ARGS(); convert_p(ap->p + ((size_t)l * 2 * MH + (size_t)hf * MH) * PLE, WSP(bf16_t, WS_PB), bx * NTHREADS + tid, G * NTHREADS); }
            int rbase;
            { ARGS(); rbase = 2048 * (bx & 7);
              LAS float* rt = (LAS float*)(lds + 131072); const float* Sx = SXP(c);
              int t_ = threadIdx.x; asm volatile("" : "+v"(t_));
#pragma unroll
              for (int i = 0; i < 4; ++i) { const int r = t_ + 512 * i; const f32x4* p = (const f32x4*)(Sx + (size_t)(rbase + r) * 16); const f32x4 q = (p[0] + p[1]) + (p[2] + p[3]);
                  rt[r] = rsqrtf(((q[0] + q[1]) + (q[2] + q[3])) * (1.0f / 1024.0f) + EPS); }
              __syncthreads(); }
#if !defined(ONLY) || ONLY == 0
            { ARGS(); const bf16_t* wl = WSP(bf16_t, WS_W) + (size_t)l * LW_TOTAL;
              pg8::Gemm g{XBP(c), wl + LW_IN, MH, NP1, DM}; pg8::StaticOrder S; S.init(MH, NP1, G, bx);
              pg8::Epi E{0, WSP(bf16_t, WS_PROJ), NP1, nullptr, 0, nullptr, 0, nullptr, SXP(c), nullptr, nullptr, nullptr, (const LAS float*)(lds + 131072), rbase};
              pg8::gemm_phase<pg8::Epi, pg8::StaticOrder, true, true>(lds, g, S, E); }
#endif
#if !defined(ONLY) || ONLY == 1
            { ARGS(); const bf16_t* wl = WSP(bf16_t, WS_W) + (size_t)l * LW_TOTAL;
              pg8::Gemm g{wl + LW_IN + (size_t)NP1 * DM, XBP(c), NV2, MH, DM}; pg8::StaticOrder S; S.init(NV2, MH, G, bx);
              pg8::Epi E{1, WSP(bf16_t, WS_VT2), MH, nullptr, 0, nullptr, 0, nullptr, SXP(c), nullptr, nullptr, nullptr, (const LAS float*)(lds + 131072), rbase};
              pg8::gemm_phase<pg8::Epi, pg8::StaticOrder, true, true>(lds, g, S, E); }
#endif
            GSYNC();
#if defined(STOP_AFTER) && STOP_AFTER == 1
            DUMP_BF16(WS_PROJ, (size_t)MH * NP1); return;
#endif
#if defined(STOP_AFTER) && STOP_AFTER == 11
            DUMP_BF16(WS_VT2, (size_t)MH * NV2); return;
#endif
#ifndef NO_GMLP
            { ARGS();
              for (int u = vcu; u < 256; u += G)
                gmlp_unit(lds, WSP(bf16_t, WS_PROJ), WSP(bf16_t, WS_VT2), WSP(bf16_t, WS_BRA), ap->a_ln_g + l * 1024, ap->a_ln_b + l * 1024, ap->a_ws + (size_t)l * 131072, ap->a_bs + l * 1024, u >> 1, u & 1); }
#endif
#ifdef NO_ATTN
            { ARGS(); const bf16_t* PR = WSP(bf16_t, WS_PROJ); bf16_t* B = WSP(bf16_t, WS_BRB);
              for (int i = bx * NTHREADS + tid; i < MH * DM / 8; i += G * NTHREADS) { const int row = i >> 7, c8 = i & 127; *(u32x4*)(B + (size_t)row * DM + c8 * 8) = *(const u32x4*)(PR + (size_t)row * NP1 + 4096 + c8 * 8); } }
#endif
#ifdef NO_GMLP
            { ARGS(); const bf16_t* PR = WSP(bf16_t, WS_PROJ); bf16_t* B = WSP(bf16_t, WS_BRA);
              for (int i = bx * NTHREADS + tid; i < MH * DM / 8; i += G * NTHREADS) { const int row = i >> 7, c8 = i & 127; *(u32x4*)(B + (size_t)row * DM + c8 * 8) = *(const u32x4*)(PR + (size_t)row * NP1 + c8 * 8); } }
#endif
#ifndef NO_ATTN
            { ARGS();
              const float lam_init = 0.8f - 0.6f * expf(-0.3f * (float)l);
              const float d0 = wave_sum(ap->lam_q[l * 128 + lane] * ap->lam_k[l * 128 + lane]), d1 = wave_sum(ap->lam_q[l * 128 + 64 + lane] * ap->lam_k[l * 128 + 64 + lane]);
              const float lam = expf(d0) - expf(d1) + lam_init;
              for (int pu = vcu; pu < 512; pu += G) { const int bh = pu >> 4, s = pu & 15;
                  attn_unit(lds, WSP(bf16_t, WS_PROJ), WSP(bf16_t, WS_VT2), WSP(bf16_t, WS_BRB), ap->subln_g + l * 128, lam, lam_init, bh >> 3, bh & 7, 31 - s);
                  attn_unit(lds, WSP(bf16_t, WS_PROJ), WSP(bf16_t, WS_VT2), WSP(bf16_t, WS_BRB), ap->subln_g + l * 128, lam, lam_init, bh >> 3, bh & 7, s); } }
#endif
            GSYNC();
#if !defined(ONLY) || ONLY == 2
            { ARGS(); const bf16_t* wl = WSP(bf16_t, WS_W) + (size_t)l * LW_TOTAL;
              pg8::Gemm g{WSP(bf16_t, WS_BRA), wl + LW_A, MH, DM, DM}; pg8::StaticOrder S; S.init(MH, DM, G, bx);
              pg8::Epi E{2, WSP(bf16_t, WS_PROJ) + 2048, NP1, nullptr, 0, nullptr, 0, WSP(bf16_t, WS_PROJ) + 5120, nullptr, nullptr, nullptr, nullptr, nullptr, 0};
              pg8::gemm_phase<pg8::Epi, pg8::StaticOrder, true, true>(lds, g, S, E); }
#endif
#if !defined(ONLY) || ONLY == 3
            { ARGS(); const bf16_t* wl = WSP(bf16_t, WS_W) + (size_t)l * LW_TOTAL;
              pg8::Gemm g{WSP(bf16_t, WS_BRB), wl + LW_B, MH, DM, DM}; pg8::StaticOrder S; S.init(MH, DM, G, bx);
              pg8::Epi E{3, XBP(1 - c), DM, nullptr, 0, nullptr, 0, WSP(bf16_t, WS_PROJ) + 6144, nullptr, nullptr, WSP(bf16_t, WS_PROJ) + 2048, nullptr, nullptr, 0};
              pg8::gemm_phase<pg8::Epi, pg8::StaticOrder, true, true>(lds, g, S, E); }
#endif
            GSYNC();
#if defined(STOP_AFTER) && STOP_AFTER == 3
            if (c == 0) DUMP_BF16(WS_X1, (size_t)MH * DM); else DUMP_BF16(WS_X0, (size_t)MH * DM); return;
#endif
#if !defined(ONLY) || ONLY == 4
            { ARGS(); const bf16_t* wl = WSP(bf16_t, WS_W) + (size_t)l * LW_TOTAL; float* out = ap->out + (size_t)hf * MH * DM;
              pg8::Gemm g{XBP(1 - c), wl + LW_O, MH, DM, DM}; pg8::StaticOrder S; S.init(MH, DM, G, bx);
              pg8::Epi E{4, XBP(c), DM, nullptr, 0, l == 0 ? ap->x + (size_t)hf * MH * DM : (const float*)nullptr, DM, nullptr, nullptr, SXP(c), nullptr, XBP(c), nullptr, 0};
              pg8::gemm_phase<pg8::Epi, pg8::StaticOrder, true, true>(lds, g, S, E); }
#endif
            GSYNC();
#if defined(STOP_AFTER) && STOP_AFTER == 4
            if (c == 0) DUMP_BF16(WS_X0, (size_t)MH * DM); else DUMP_BF16(WS_X1, (size_t)MH * DM); return;
#endif
#if !defined(ONLY) || ONLY == 5
            { ARGS(); const bf16_t* wl = WSP(bf16_t, WS_W) + (size_t)l * LW_TOTAL;
              pg8::Gemm g{XBP(c), wl + LW_G, MH, DM, DM}; pg8::StaticOrder S; S.init(MH, DM, G, bx);
              pg8::Epi E{5, WSP(bf16_t, WS_PROJ) + 2048, NP1, nullptr, 0, nullptr, 0, nullptr, SXP(c), nullptr, nullptr, nullptr, nullptr, 0};
              pg8::gemm_phase<pg8::Epi, pg8::StaticOrder, true, true>(lds, g, S, E); }
#endif
#if !defined(ONLY) || ONLY == 6
            { ARGS(); const bf16_t* wl = WSP(bf16_t, WS_W) + (size_t)l * LW_TOTAL; float* out = ap->out + (size_t)hf * MH * DM;
              pg8::Gemm g{WSP(bf16_t, WS_PB), wl + LW_P, MH, DM, PLE}; pg8::StaticOrder S; S.init(MH, DM, G, bx);
              pg8::Epi E{6, XBP(1 - c), DM, l == NLAYER - 1 ? out : (float*)nullptr, DM, nullptr, 0, nullptr, nullptr, SXP(1 - c), WSP(bf16_t, WS_PROJ) + 2048, XBP(c), nullptr, 0};
              pg8::gemm_phase<pg8::Epi, pg8::StaticOrder, true, true>(lds, g, S, E); }
#endif
            GSYNC();
#if defined(STOP_AFTER) && STOP_AFTER == 5
            if (c == 0) DUMP_BF16(WS_X1, (size_t)MH * DM); else DUMP_BF16(WS_X0, (size_t)MH * DM); return;
#endif
            c ^= 1;
        }
        { ARGS(); final_rows(ap->out + (size_t)hf * MH * DM, ap->final_g, gw, ngw, lane); }
    }
}

extern "C" void kernel_launch(void* const* d_in, const int* in_sizes, int n_in, void* d_out, int out_size, void* d_ws, size_t ws_size, hipStream_t stream) {
    static int grid = 0;
    if (grid == 0) {
        if (n_in != 18 || ws_size < WS_END) { fprintf(stderr, "kernel_launch: unexpected n_in %d / ws_size %zu (need %zu)\n", n_in, ws_size, (size_t)WS_END); grid = -1; return; }
        int dev = 0, cus = 0, per_cu = 0;
        hipGetDevice(&dev); hipDeviceGetAttribute(&cus, hipDeviceAttributeMultiprocessorCount, dev);
        if (hipFuncSetAttribute((const void*)mega_fwd, hipFuncAttributeMaxDynamicSharedMemorySize, LDS_BYTES) != hipSuccess) { fprintf(stderr, "kernel_launch: hipFuncSetAttribute failed\n"); grid = -1; return; }
        if (hipOccupancyMaxActiveBlocksPerMultiprocessor(&per_cu, (const void*)mega_fwd, NTHREADS, LDS_BYTES) != hipSuccess || per_cu < 1) { fprintf(stderr, "kernel_launch: occupancy query gives %d\n", per_cu); per_cu = 1; }
        (void)hipGetLastError();
        if (cus % 8 != 0) { fprintf(stderr, "kernel_launch: CU count %d is not a multiple of 8\n", cus); grid = -1; return; }
        grid = cus;
    }
    if (grid < 0) return;
    if (hipMemsetAsync(d_ws, 0, 16384, stream) != hipSuccess) { fprintf(stderr, "kernel_launch: memset failed\n"); return; }
    Args a{};
    const float** f = (const float**)&a;
    for (int i = 0; i < 18; ++i) f[i] = (const float*)d_in[i];
    a.out = (float*)d_out; a.ws = (unsigned char*)d_ws;
    void* args[] = {&a};
    hipError_t e = hipLaunchCooperativeKernel((const void*)mega_fwd, dim3(grid), dim3(NTHREADS), args, LDS_BYTES, stream);
    if (e != hipSuccess) fprintf(stderr, "cooperative launch failed: %s (grid %d)\n", hipGetErrorString(e), grid);
}
```
